# Optimizing an MI355X kernel written in HIP

```python
import math
import jax, jax.numpy as jnp
from jax import lax
import numpy as np

D_MODEL = 2048
BATCH = 4
SEQ = 2048
DEPTH = 4
DEC_BATCH = 128
DEC_SEQ = 8
PAST_LEN = 16384
PAGE_SIZE = 128

PLE_DIM = 256
SSM_WIDTH = D_MODEL // 2
SSM_GROUP = 16
SSM_GROUPS = SSM_WIDTH // SSM_GROUP
SSM_STATE = 64
GLA_HEADS = 4
GLA_KEY_WIDTH = D_MODEL // 4
GLA_VAL_WIDTH = D_MODEL // 2
GLA_DK = GLA_KEY_WIDTH // GLA_HEADS
GLA_DV = GLA_VAL_WIDTH // GLA_HEADS
GLA_GATE_RANK = 16
GLA_TAU = 16.0
GLA_CHUNK = 64
CONV_WIDTH = D_MODEL // 2
CONV_K = 31
N_BRANCH = 3
DN_ALPHA = (2 * DEPTH) ** 0.25
DN_BETA = (8 * DEPTH) ** -0.25
LN_EPS = 1e-5

kernel_name = 'hybrid_s5_gla_conformer_gated_step'


def _in_sizes():
    return [SSM_WIDTH, SSM_WIDTH,
            GLA_KEY_WIDTH, GLA_KEY_WIDTH, GLA_VAL_WIDTH,
            GLA_GATE_RANK, GLA_VAL_WIDTH,
            CONV_WIDTH, CONV_WIDTH, CONV_WIDTH,
            N_BRANCH * D_MODEL]


def _split_points():
    return [int(v) for v in np.cumsum(_in_sizes())[:-1]]


def layer_norm(x, g, b):
    xf = x.astype(jnp.float32)
    mu = jnp.mean(xf, axis=-1, keepdims=True)
    var = jnp.mean(jnp.square(xf - mu), axis=-1, keepdims=True)
    return ((xf - mu) * lax.rsqrt(var + LN_EPS) * g.astype(jnp.float32) + b.astype(jnp.float32)).astype(x.dtype)


def s5_mixer(u, h0_re, h0_im, a_re, a_im, log_dt, b_re, b_im, c_re, c_im, d):
    f32 = jnp.float32
    bsz, t, _ = u.shape
    lam = lax.complex(a_re.astype(f32), a_im.astype(f32))
    dt = jnp.exp(log_dt.astype(f32))[:, None]
    a_bar = jnp.exp(lam * dt)
    b_bar = ((a_bar - 1.0) / lam)[..., None] * lax.complex(b_re.astype(f32), b_im.astype(f32))
    ug = u.astype(f32).reshape(bsz, t, SSM_GROUPS, SSM_GROUP)
    bu = jnp.einsum('btgc,gpc->btgp', ug.astype(jnp.complex64), b_bar)
    h0 = lax.complex(h0_re.astype(f32), h0_im.astype(f32))
    bu = bu.at[:, 0].add(a_bar * h0)
    a_seq = jnp.broadcast_to(a_bar, bu.shape)

    def combine(left, right):
        a_l, b_l = left
        a_r, b_r = right
        return a_l * a_r, a_r * b_l + b_r

    _, h = lax.associative_scan(combine, (a_seq, bu), axis=1)
    c = lax.complex(c_re.astype(f32), c_im.astype(f32))
    y = jnp.einsum('btgp,gcp->btgc', h, c).real + d.astype(f32).reshape(SSM_GROUPS, SSM_GROUP) * ug
    h_last = h[:, -1]
    return (y.reshape(bsz, t, SSM_WIDTH).astype(u.dtype),
            h_last.real.astype(h0_re.dtype), h_last.imag.astype(h0_im.dtype))


def gla_mixer(q, k, v, a_low, s0, w_a2, b_a, norm_g):
    f32 = jnp.float32
    bsz, t, _ = q.shape
    out_dtype = v.dtype
    q = q.astype(f32).reshape(bsz, t, GLA_HEADS, GLA_DK) * (GLA_DK ** -0.5)
    k = k.astype(f32).reshape(bsz, t, GLA_HEADS, GLA_DK)
    v = v.astype(f32).reshape(bsz, t, GLA_HEADS, GLA_DV)
    logit = (a_low @ w_a2 + b_a).astype(f32)
    log_a = (jax.nn.log_sigmoid(logit) / GLA_TAU).reshape(bsz, t, GLA_HEADS, GLA_DK)
    c = min(GLA_CHUNK, t)
    tp = -(-t // c) * c
    pad = tp - t
    if pad:
        padf = lambda z: jnp.pad(z, ((0, 0), (0, pad), (0, 0), (0, 0)))
        q, k, v, log_a = padf(q), padf(k), padf(v), padf(log_a)
    n = tp // c
    chunk = lambda z: z.reshape(bsz, n, c, GLA_HEADS, z.shape[-1])
    qc, kc, vc, la = chunk(q), chunk(k), chunk(v), chunk(log_a)
    cum = jnp.cumsum(la, axis=2)
    qd = qc * jnp.exp(cum)
    kd = kc * jnp.exp(-cum)
    mask = jnp.tril(jnp.ones((c, c), dtype=bool))
    att = jnp.where(mask, jnp.einsum('bnchd,bnjhd->bnhcj', qd, kd), 0.0)
    o_intra = jnp.einsum('bnhcj,bnjhv->bnchv', att, vc)
    last = cum[:, :, -1]
    kv = jnp.einsum('bnchd,bnchv->bnhdv', kc * jnp.exp(last[:, :, None] - cum), vc)

    def step(s, xs):
        qd_n, last_n, kv_n = xs
        o = jnp.einsum('bchd,bhdv->bchv', qd_n, s)
        return jnp.exp(last_n)[..., None] * s + kv_n, o

    s_t, o_inter = lax.scan(step, s0.astype(f32),
                            (jnp.moveaxis(qd, 1, 0), jnp.moveaxis(last, 1, 0), jnp.moveaxis(kv, 1, 0)))
    o = (o_intra + jnp.moveaxis(o_inter, 0, 1)).reshape(bsz, tp, GLA_HEADS, GLA_DV)[:, :t]
    mu = jnp.mean(o, axis=-1, keepdims=True)
    var = jnp.mean(jnp.square(o - mu), axis=-1, keepdims=True)
    o = (o - mu) * lax.rsqrt(var + LN_EPS) * norm_g.astype(f32).reshape(GLA_HEADS, GLA_DV)
    return o.reshape(bsz, t, GLA_VAL_WIDTH).astype(out_dtype), s_t.astype(s0.dtype)


def conv_mixer(ga, gb, buf, w_dw, b_dw, ln_g, ln_b):
    g = ga * jax.nn.sigmoid(gb)
    xp = jnp.concatenate([buf.astype(g.dtype), g], axis=1)
    y = lax.conv_general_dilated(xp, w_dw[:, None, :].astype(g.dtype), window_strides=(1,), padding='VALID',
                                 dimension_numbers=('NWC', 'WIO', 'NWC'),
                                 feature_group_count=CONV_WIDTH) + b_dw
    y = jax.nn.silu(layer_norm(y, ln_g, ln_b))
    return y, xp[:, -(CONV_K - 1):].astype(buf.dtype)


def trunk_layer(x, p, s5_re, s5_im, gla_s, conv_buf,
                w_in, b_in, s5_a_re, s5_a_im, s5_log_dt, s5_b_re, s5_b_im, s5_c_re, s5_c_im, s5_d,
                w_glu, b_glu, gla_w_a2, gla_b_a, gla_norm_g, conv_w, conv_b, conv_ln_g, conv_ln_b,
                p_s5, p_gla, p_conv, w_o, w_pg, w_pe, ln_g, ln_b):
    proj = x @ w_in + b_in
    (s5_u, s5_z, q, k, v, a_low, gla_z, ca, cb, cz, gates) = jnp.split(proj, _split_points(), axis=-1)
    y_s5, s5_re_new, s5_im_new = s5_mixer(s5_u, s5_re, s5_im, s5_a_re, s5_a_im, s5_log_dt,
                                          s5_b_re, s5_b_im, s5_c_re, s5_c_im, s5_d)
    y_s5 = jax.nn.gelu(y_s5)
    y_s5 = y_s5 * jax.nn.sigmoid(y_s5 @ w_glu + b_glu)
    br_s5 = (y_s5 * jax.nn.silu(s5_z)) @ p_s5
    o_gla, gla_new = gla_mixer(q, k, v, a_low, gla_s, gla_w_a2, gla_b_a, gla_norm_g)
    br_gla = (o_gla * jax.nn.silu(gla_z)) @ p_gla
    y_c, conv_new = conv_mixer(ca, cb, conv_buf, conv_w, conv_b, conv_ln_g, conv_ln_b)
    br_conv = (y_c * jax.nn.silu(cz)) @ p_conv
    g_s5, g_gla, g_conv = jnp.split(jax.nn.sigmoid(gates), N_BRANCH, axis=-1)
    out = (g_s5 * br_s5 + g_gla * br_gla + g_conv * br_conv) @ w_o
    h = DN_ALPHA * x + out
    h = h + jax.nn.sigmoid(h @ w_pg) * (p @ w_pe)
    return layer_norm(h, ln_g, ln_b), s5_re_new, s5_im_new, gla_new, conv_new


def setup_inputs(seed: int = 0) -> dict:
    key = jax.random.key(seed)
    ks = iter(jax.random.split(key, 40))
    f32 = jnp.float32
    nrm = lambda shape, scale: jax.random.normal(next(ks), shape, f32) * scale
    n_in = sum(_in_sizes())
    G, P, CG = SSM_GROUPS, SSM_STATE, SSM_GROUP
    a_im0 = jnp.pi * jnp.arange(P, dtype=f32)
    return {
        'x_prompt': nrm((BATCH, SEQ, D_MODEL), 1.0),
        'x_sample': nrm((DEC_BATCH, DEC_SEQ, D_MODEL), 1.0),
        'p_prompt': nrm((DEPTH, BATCH, SEQ, PLE_DIM), 1.0),
        'p_sample': nrm((DEPTH, DEC_BATCH, DEC_SEQ, PLE_DIM), 1.0),
        'state_s5_re': nrm((DEPTH, DEC_BATCH, G, P), 0.1),
        'state_s5_im': nrm((DEPTH, DEC_BATCH, G, P), 0.1),
        'state_gla': nrm((DEPTH, DEC_BATCH, GLA_HEADS, GLA_DK, GLA_DV), 0.1),
        'cache_conv': nrm((DEPTH, DEC_BATCH, CONV_K - 1, CONV_WIDTH), 0.5),
        'w_in': nrm((DEPTH, D_MODEL, n_in), D_MODEL ** -0.5),
        'b_in': nrm((DEPTH, n_in), 0.01),
        's5_a_re': -0.5 + nrm((DEPTH, G, P), 0.01),
        's5_a_im': a_im0 + nrm((DEPTH, G, P), 0.01),
        's5_log_dt': jax.random.uniform(next(ks), (DEPTH, G), f32, math.log(1e-3), math.log(1e-1)),
        's5_b_re': nrm((DEPTH, G, P, CG), (2 * CG) ** -0.5),
        's5_b_im': nrm((DEPTH, G, P, CG), (2 * CG) ** -0.5),
        's5_c_re': nrm((DEPTH, G, CG, P), P ** -0.5),
        's5_c_im': nrm((DEPTH, G, CG, P), P ** -0.5),
        's5_d': nrm((DEPTH, SSM_WIDTH), 1.0),
        'w_glu': nrm((DEPTH, SSM_WIDTH, SSM_WIDTH), SSM_WIDTH ** -0.5),
        'b_glu': nrm((DEPTH, SSM_WIDTH), 0.01),
        'gla_w_a2': nrm((DEPTH, GLA_GATE_RANK, GLA_KEY_WIDTH), GLA_GATE_RANK ** -0.5),
        'gla_b_a': nrm((DEPTH, GLA_KEY_WIDTH), 0.01),
        'gla_norm_g': 1.0 + nrm((DEPTH, GLA_VAL_WIDTH), 0.02),
        'conv_w': nrm((DEPTH, CONV_K, CONV_WIDTH), CONV_K ** -0.5),
        'conv_b': nrm((DEPTH, CONV_WIDTH), 0.01),
        'conv_ln_g': 1.0 + nrm((DEPTH, CONV_WIDTH), 0.02),
        'conv_ln_b': nrm((DEPTH, CONV_WIDTH), 0.01),
        'p_s5': nrm((DEPTH, SSM_WIDTH, D_MODEL), DN_BETA * SSM_WIDTH ** -0.5),
        'p_gla': nrm((DEPTH, GLA_VAL_WIDTH, D_MODEL), DN_BETA * GLA_VAL_WIDTH ** -0.5),
        'p_conv': nrm((DEPTH, CONV_WIDTH, D_MODEL), DN_BETA * CONV_WIDTH ** -0.5),
        'w_o': nrm((DEPTH, D_MODEL, D_MODEL), DN_BETA * D_MODEL ** -0.5),
        'w_pg': nrm((DEPTH, D_MODEL, D_MODEL), D_MODEL ** -0.5),
        'w_pe': nrm((DEPTH, PLE_DIM, D_MODEL), DN_BETA * PLE_DIM ** -0.5),
        'ln_g': 1.0 + nrm((DEPTH, D_MODEL), 0.02),
        'ln_b': nrm((DEPTH, D_MODEL), 0.01),
    }


def reference(x_prompt, x_sample, p_prompt, p_sample, state_s5_re, state_s5_im, state_gla, cache_conv,
              w_in, b_in, s5_a_re, s5_a_im, s5_log_dt, s5_b_re, s5_b_im, s5_c_re, s5_c_im, s5_d,
              w_glu, b_glu, gla_w_a2, gla_b_a, gla_norm_g, conv_w, conv_b, conv_ln_g, conv_ln_b,
              p_s5, p_gla, p_conv, w_o, w_pg, w_pe, ln_g, ln_b):
    bp = x_prompt.shape[0]
    sd = state_s5_re.dtype
    zero_s5 = jnp.zeros((bp, SSM_GROUPS, SSM_STATE), sd)
    zero_gla = jnp.zeros((bp, GLA_HEADS, GLA_DK, GLA_DV), state_gla.dtype)
    zero_conv = jnp.zeros((bp, CONV_K - 1, CONV_WIDTH), cache_conv.dtype)
    hp, hs = x_prompt, x_sample
    pr_re, pr_im, pr_gla, pr_conv = [], [], [], []
    sm_re, sm_im, sm_gla, sm_conv = [], [], [], []
    for i in range(DEPTH):
        wts = (w_in[i], b_in[i], s5_a_re[i], s5_a_im[i], s5_log_dt[i], s5_b_re[i], s5_b_im[i],
               s5_c_re[i], s5_c_im[i], s5_d[i], w_glu[i], b_glu[i], gla_w_a2[i], gla_b_a[i],
               gla_norm_g[i], conv_w[i], conv_b[i], conv_ln_g[i], conv_ln_b[i],
               p_s5[i], p_gla[i], p_conv[i], w_o[i], w_pg[i], w_pe[i], ln_g[i], ln_b[i])
        hp, a, b, c, d = trunk_layer(hp, p_prompt[i], zero_s5, zero_s5, zero_gla, zero_conv, *wts)
        pr_re.append(a); pr_im.append(b); pr_gla.append(c); pr_conv.append(d)
        hs, a, b, c, d = trunk_layer(hs, p_sample[i], state_s5_re[i], state_s5_im[i], state_gla[i],
                                     cache_conv[i], *wts)
        sm_re.append(a); sm_im.append(b); sm_gla.append(c); sm_conv.append(d)
    return (hp, hs,
            jnp.stack(pr_re), jnp.stack(pr_im), jnp.stack(pr_gla), jnp.stack(pr_conv),
            jnp.stack(sm_re), jnp.stack(sm_im), jnp.stack(sm_gla), jnp.stack(sm_conv))
```

```cpp
#include <hip/hip_runtime.h>
#include <cstdio>
#include <cstdint>
#include <cstring>
#define DIAG_SGN(eps, k) (1.0f + (((k) & 1) ? (eps) : -(eps)))
#define DIAG_S5P 0.0f
#define DIAG_S5S 0.0f
#define MK_SPLIT 0
namespace pg8 {
#define PG8_LAS __attribute__((address_space(3)))
typedef unsigned short bf16_t;
typedef short bf16x8 __attribute__((ext_vector_type(8)));
typedef float f32x4 __attribute__((ext_vector_type(4)));
typedef unsigned u32x4 __attribute__((ext_vector_type(4)));
constexpr int BM = 256, BK = 64, HALF = 128, HTB = HALF * BK * 2  , STAGE_BYTES = 8 * HTB, NXCD = 8, WGM = 8;

__host__ __device__ __forceinline__ int lds_byte(int r, int c) { const int st = (r >> 4) * 2 + (c >> 5), rr = r & 15, cc = c & 31, ob = rr * 64 + cc * 2; return st * 1024 + (ob ^ (((ob >> 9) & 1) << 5)); }
__host__ __device__ __forceinline__ void stage_rc(int b, int& R, int& C) { const int st = b / 1024, sb = b % 1024, swz = sb ^ (((sb >> 9) & 1) << 5); R = (st >> 1) * 16 + swz / 64; C = (st & 1) * 32 + (swz % 64) / 2; }
__host__ __device__ __forceinline__ int perm32(int rho) { const int n = rho >> 4, i = rho & 15; return 8 * (i >> 2) + 4 * n + (i & 3); }

struct Unit { int pm, pn; };
struct Gemm { const bf16_t* A; const bf16_t* Bt; int M, N, K; };

struct StaticOrder {
    int nM, nN, nwg, G, c;
    __host__ __device__ void init(int M, int N, int G_, int c_) { nM = M / BM; nN = N / BM; nwg = nM * nN; G = G_; c = c_; }
    __host__ __device__ bool next(int i, Unit& u) const {
        const long L = (long)i * G + c; if (L >= nwg) return false;
        int wgid = (int)L; { const int q = nwg / NXCD, r = nwg % NXCD, xcd = wgid % NXCD, off = wgid / NXCD; wgid = (xcd < r ? xcd * (q + 1) : r * (q + 1) + (xcd - r) * q) + off; }
        const int nig = WGM * nN, gid = wgid / nig, fm = gid * WGM, gsz = (nM - fm) < WGM ? (nM - fm) : WGM;
        u.pm = fm + ((wgid % nig) % gsz); u.pn = (wgid % nig) / gsz; return true;
    }
    __device__ __forceinline__ void a_ready(const Unit&) const {}
    __device__ __forceinline__ void done(const Unit&) const {}
};
__device__ __forceinline__ unsigned cvt_pk_bf16(float lo, float hi) { unsigned r; asm volatile("v_cvt_pk_bf16_f32 %0, %1, %2" : "=v"(r) : "v"(lo), "v"(hi)); return r; }
typedef float f32x2 __attribute__((ext_vector_type(2)));
typedef unsigned u32x2 __attribute__((ext_vector_type(2)));
__device__ __forceinline__ float sigm(float x) { return 1.0f / (1.0f + __expf(-x)); }
__device__ __forceinline__ float silu_f(float x) { return x / (1.0f + __expf(-x)); }
__device__ __forceinline__ float bflo(unsigned u) { return __uint_as_float(u << 16); }
__device__ __forceinline__ float bfhi(unsigned u) { return __uint_as_float(u & 0xffff0000u); }
__device__ __forceinline__ void unpack8(const u32x4 w, f32x4& a, f32x4& b) { a = (f32x4){bflo(w.x), bfhi(w.x), bflo(w.y), bfhi(w.y)}; b = (f32x4){bflo(w.z), bfhi(w.z), bflo(w.w), bfhi(w.w)}; }
__device__ __forceinline__ u32x4 pack8(const f32x4 a, const f32x4 b) { u32x4 w; w.x = cvt_pk_bf16(a[0], a[1]); w.y = cvt_pk_bf16(a[2], a[3]); w.z = cvt_pk_bf16(b[0], b[1]); w.w = cvt_pk_bf16(b[2], b[3]); return w; }
__device__ __forceinline__ f32x4 sigm4(f32x4 v) { return (f32x4){sigm(v[0]), sigm(v[1]), sigm(v[2]), sigm(v[3])}; }
__device__ __forceinline__ f32x4 silu4(f32x4 v) { return (f32x4){silu_f(v[0]), silu_f(v[1]), silu_f(v[2]), silu_f(v[3])}; }

#define EPI_LOOP_BEGIN \
    const int row0 = u.pm * BM + wr * 64 + fr, col0 = u.pn * BM + wc * 32 + 8 * fq; \
    _Pragma("unroll") for (int ai = 0; ai < 2; ++ai) _Pragma("unroll") for (int m = 0; m < 4; ++m) { const size_t row = (size_t)(row0 + ai * HALF + m * 16); \
    _Pragma("unroll") for (int bj = 0; bj < 2; ++bj) { const int col = col0 + bj * HALF; f32x4 v0 = acc[ai][bj][m][0], v1 = acc[ai][bj][m][1];
#define EPI_LOOP_END } asm volatile("" ::: "memory"); }

struct EpiProj {
    static constexpr bool PERM = true, AFTER_DRAIN = false;
    bf16_t* O; int ldc; const float* bias;
    __device__ __forceinline__ void operator()(const f32x4 (&acc)[2][2][4][2], const Unit& u, int wr, int wc, int fr, int fq) const {
        const int pn = u.pn;
        int act = 0;
        if ((pn >= 4 && pn < 8) || (pn >= 16 && pn < 20) || (pn >= 28 && pn < 32)) act = 1;
        if ((pn >= 24 && pn < 28) || pn >= 32) act = 2;
        const int boff = (pn >= 16) ? 16 : 0;
        f32x4 bv[2][2];
        { const int c0 = u.pn * BM + wc * 32 + 8 * fq + boff;
#pragma unroll
          for (int bj = 0; bj < 2; ++bj)
#pragma unroll
              for (int n = 0; n < 2; ++n) bv[bj][n] = *(const f32x4*)(bias + c0 + bj * HALF + 4 * n); }
        EPI_LOOP_BEGIN
            v0 = v0 + bv[bj][0]; v1 = v1 + bv[bj][1];
            if (act == 1) { v0 = silu4(v0); v1 = silu4(v1); }
            else if (act == 2) { v0 = sigm4(v0); v1 = sigm4(v1); }
            *(u32x4*)(O + row * ldc + col) = pack8(v0, v1);
        EPI_LOOP_END
    }
};
struct EpiPlain {
    static constexpr bool PERM = true, AFTER_DRAIN = false;
    bf16_t* O; int ldc;
    __device__ __forceinline__ void operator()(const f32x4 (&acc)[2][2][4][2], const Unit& u, int wr, int wc, int fr, int fq) const {
        EPI_LOOP_BEGIN
            *(u32x4*)(O + row * ldc + col) = pack8(v0, v1);
        EPI_LOOP_END
    }
};
struct EpiGlu {
    static constexpr bool PERM = true, AFTER_DRAIN = false;
    bf16_t* O; const float* bias; const bf16_t* YG; const bf16_t* P; int ldp;
    __device__ __forceinline__ void operator()(const f32x4 (&acc)[2][2][4][2], const Unit& u, int wr, int wc, int fr, int fq) const {
        EPI_LOOP_BEGIN
            f32x4 y0, y1, z0, z1;
            unpack8(*(const u32x4*)(YG + row * 1024 + col), y0, y1);
            unpack8(*(const u32x4*)(P + row * ldp + 1024 + col), z0, z1);
            v0 = y0 * sigm4(v0 + *(const f32x4*)(bias + col)) * z0; v1 = y1 * sigm4(v1 + *(const f32x4*)(bias + col + 4)) * z1;
            *(u32x4*)(O + row * 1024 + col) = pack8(v0, v1);
        EPI_LOOP_END
    }
};
template <int B> struct EpiBranch {
    static constexpr bool PERM = true, AFTER_DRAIN = false;
    float* OSUM; bf16_t* OSB; const bf16_t* P; int ldp;
    __device__ __forceinline__ void operator()(const f32x4 (&acc)[2][2][4][2], const Unit& u, int wr, int wc, int fr, int fq) const {
        EPI_LOOP_BEGIN
            f32x4 g0, g1;
            unpack8(*(const u32x4*)(P + row * ldp + 8192 + 2048 * B + col), g0, g1);
            v0 = v0 * g0; v1 = v1 * g1;
            float* sp = OSUM + row * 2048 + col;
            if (B >= 1) { v0 = v0 + *(const f32x4*)sp; v1 = v1 + *(const f32x4*)(sp + 4); }
            if (B <= 1) { *(f32x4*)sp = v0; *(f32x4*)(sp + 4) = v1; }
            else *(u32x4*)(OSB + row * 2048 + col) = pack8(v0, v1);
        EPI_LOOP_END
    }
};
struct EpiWo {
    static constexpr bool PERM = true, AFTER_DRAIN = false;
    float* H32; bf16_t* HB; const float* xp; const float* xs; float alpha;
    __device__ __forceinline__ void operator()(const f32x4 (&acc)[2][2][4][2], const Unit& u, int wr, int wc, int fr, int fq) const {
        const float* xb = (u.pm < 32) ? xp : (xs - (size_t)8192 * 2048);
        EPI_LOOP_BEGIN
            const float* xr = xb + row * 2048 + col;
            v0 = v0 + alpha * *(const f32x4*)xr; v1 = v1 + alpha * *(const f32x4*)(xr + 4);
            float* hp = H32 + row * 2048 + col;
            *(f32x4*)hp = v0; *(f32x4*)(hp + 4) = v1;
            *(u32x4*)(HB + row * 2048 + col) = pack8(v0, v1);
        EPI_LOOP_END
    }
};
struct EpiWpg {
    static constexpr bool PERM = true, AFTER_DRAIN = false;
    float* H2; const float* H32; const bf16_t* PE;
    __device__ __forceinline__ void operator()(const f32x4 (&acc)[2][2][4][2], const Unit& u, int wr, int wc, int fr, int fq) const {
        EPI_LOOP_BEGIN
            f32x4 p0, p1;
            unpack8(*(const u32x4*)(PE + row * 2048 + col), p0, p1);
            const float* hp = H32 + row * 2048 + col;
            v0 = *(const f32x4*)hp + sigm4(v0) * p0; v1 = *(const f32x4*)(hp + 4) + sigm4(v1) * p1;
            float* op = H2 + row * 2048 + col;
            *(f32x4*)op = v0; *(f32x4*)(op + 4) = v1;
        EPI_LOOP_END
    }
};
template <class Epi, class Sched, bool ALIGN_EPI = false, bool SP2 = false>
__device__ __forceinline__ void gemm_phase(PG8_LAS unsigned char* lds, const Gemm g, const Sched& S, const Epi& E) {
    int tid_l = threadIdx.x; asm volatile("" : "+v"(tid_l));
    const int tid = tid_l, wid = __builtin_amdgcn_readfirstlane(tid >> 6), lane = tid & 63, wr = wid >> 2, wc = wid & 3, fr = lane & 15, fq = lane >> 4;
    const int K = g.K, nt = K / BK;
    unsigned voffA[2], voffB[2];
#pragma unroll
    for (int i = 0; i < 2; ++i) { int R, C; stage_rc(tid * 16 + i * 8192, R, C); const int Rb = Epi::PERM ? ((R & ~31) + perm32(R & 31)) : R;
        voffA[i] = (unsigned)(R * K + C) * 2u; voffB[i] = (unsigned)(Rb * K + C) * 2u; }
    const size_t kstep = (size_t)(BK * 2);
    const size_t hstep = (size_t)HALF * K * 2;
    const size_t tstep = 2 * hstep;
    const unsigned ldsw = (unsigned)wid * 1024u;
    const int aoff = lds_byte(wr * 64 + fr, fq * 8), boff = lds_byte(wc * 32 + fr, fq * 8);
#define PG8_SA(b, h) (((b) * 2 + (h)) * HTB)
#define PG8_SB(b, h) ((4 + (b) * 2 + (h)) * HTB)
#define PG8_STAGE(bufoff, gbase, voff) do { _Pragma("unroll") for (int _i = 0; _i < 2; ++_i) \
        __builtin_amdgcn_global_load_lds((const unsigned*)((const char*)(gbase) + (voff)[_i]), (PG8_LAS unsigned*)(lds + (bufoff) + ldsw + _i * 8192), 16, 0, 0); } while (0)
#define PG8_LDA(dst, b, h) do { _Pragma("unroll") for (int m = 0; m < 4; ++m) _Pragma("unroll") for (int k = 0; k < 2; ++k) dst[m][k] = *(const PG8_LAS bf16x8*)(lds + PG8_SA(b, h) + aoff + m * 2048 + k * 1024); } while (0)
#define PG8_LDB(dst, b, h) do { _Pragma("unroll") for (int n = 0; n < 2; ++n) _Pragma("unroll") for (int k = 0; k < 2; ++k) dst[n][k] = *(const PG8_LAS bf16x8*)(lds + PG8_SB(b, h) + boff + n * 2048 + k * 1024); } while (0)
#define PG8_MMA(ai, bj, At, Bt) do { __builtin_amdgcn_s_setprio(1); _Pragma("unroll") for (int m = 0; m < 4; ++m) _Pragma("unroll") for (int n = 0; n < 2; ++n) _Pragma("unroll") for (int k = 0; k < 2; ++k) \
        acc[ai][bj][m][n] = __builtin_amdgcn_mfma_f32_16x16x32_bf16(Bt[n][k], At[m][k], acc[ai][bj][m][n], 0, 0, 0); __builtin_amdgcn_s_setprio(0); } while (0)
#define PG8_WAIT_V(n) asm volatile("s_waitcnt vmcnt(" #n ")" ::: "memory")
#define PG8_WAIT_L(n) asm volatile("s_waitcnt lgkmcnt(" #n ")" ::: "memory")
#define PG8_BAR __builtin_amdgcn_s_barrier()
#define PG8_SCHED __builtin_amdgcn_sched_barrier(0)
    Unit cur, nxt; int ui = 0;
    if (!S.next(0, cur)) return;
    f32x4 acc[2][2][4][2];
#pragma unroll
    for (int a = 0; a < 2; ++a)
#pragma unroll
        for (int b = 0; b < 2; ++b)
#pragma unroll
            for (int m = 0; m < 4; ++m)
#pragma unroll
                for (int n = 0; n < 2; ++n) acc[a][b][m][n] = (f32x4){0.f, 0.f, 0.f, 0.f};
    bf16x8 At[4][2], B0[2][2], B1[2][2];
    const char* cA = (const char*)g.A + (size_t)cur.pm * tstep; const char* cB = (const char*)g.Bt + (size_t)cur.pn * tstep;
    S.a_ready(cur);
    if constexpr (SP2) {
        PG8_STAGE(PG8_SB(0, 0), cB, voffB); PG8_STAGE(PG8_SB(0, 1), cB + hstep, voffB); PG8_STAGE(PG8_SA(0, 0), cA, voffA); PG8_STAGE(PG8_SA(0, 1), cA + hstep, voffA);
        if (wr == 1) PG8_BAR;
        PG8_WAIT_V(2); PG8_BAR;
        PG8_STAGE(PG8_SB(1, 0), cB + kstep, voffB); PG8_STAGE(PG8_SA(1, 0), cA + kstep, voffA); PG8_STAGE(PG8_SB(1, 1), cB + hstep + kstep, voffB);
        PG8_WAIT_V(6); PG8_BAR;
    } else {
        PG8_STAGE(PG8_SB(0, 0), cB, voffB); PG8_STAGE(PG8_SA(0, 0), cA, voffA); PG8_STAGE(PG8_SB(0, 1), cB + hstep, voffB); PG8_STAGE(PG8_SA(0, 1), cA + hstep, voffA);
        if (wr == 1) PG8_BAR;
        PG8_WAIT_V(4); PG8_BAR;
        PG8_STAGE(PG8_SB(1, 0), cB + kstep, voffB); PG8_STAGE(PG8_SA(1, 0), cA + kstep, voffA); PG8_STAGE(PG8_SB(1, 1), cB + hstep + kstep, voffB);
        PG8_WAIT_V(6); PG8_BAR;
    }
    for (;;) {
        const bool has_next = S.next(ui + 1, nxt);
        const char* nA = has_next ? (const char*)g.A + (size_t)nxt.pm * tstep : cA; const char* nB = has_next ? (const char*)g.Bt + (size_t)nxt.pn * tstep : cB;
        for (int t = 0; t < nt; t += 2) {
            const bool last = (t == nt - 2);
            const char* a1 = cA + (size_t)(t + 1) * kstep;
            const char* a2 = last ? nA : cA + (size_t)(t + 2) * kstep; const char* b2 = last ? nB : cB + (size_t)(t + 2) * kstep;
            const char* a3 = a2 + kstep; const char* b3 = b2 + kstep;
            if (last && has_next) S.a_ready(nxt);
            if constexpr (SP2) {
            PG8_LDB(B0, 0, 0); PG8_LDB(B1, 0, 1); PG8_SCHED; PG8_LDA(At, 0, 0); PG8_STAGE(PG8_SA(1, 1), a1 + hstep, voffA);
            PG8_WAIT_V(8); PG8_WAIT_L(0); PG8_BAR; PG8_MMA(0, 0, At, B0); PG8_MMA(0, 1, At, B1); PG8_BAR; PG8_SCHED;
            PG8_LDA(At, 0, 1); PG8_STAGE(PG8_SB(0, 0), b2, voffB); PG8_STAGE(PG8_SB(0, 1), b2 + hstep, voffB); PG8_STAGE(PG8_SA(0, 0), a2, voffA);
            PG8_WAIT_V(8); PG8_WAIT_L(0); PG8_BAR; PG8_MMA(1, 0, At, B0); PG8_MMA(1, 1, At, B1); PG8_BAR; PG8_SCHED;
            PG8_LDB(B0, 1, 0); PG8_LDB(B1, 1, 1); PG8_SCHED; PG8_LDA(At, 1, 0); PG8_STAGE(PG8_SA(0, 1), a2 + hstep, voffA);
            PG8_WAIT_V(8); PG8_WAIT_L(0); PG8_BAR; PG8_MMA(0, 0, At, B0); PG8_MMA(0, 1, At, B1); PG8_BAR; PG8_SCHED;
            PG8_LDA(At, 1, 1); PG8_STAGE(PG8_SB(1, 0), b3, voffB); PG8_STAGE(PG8_SB(1, 1), b3 + hstep, voffB); PG8_STAGE(PG8_SA(1, 0), a3, voffA);
            PG8_WAIT_V(8); PG8_WAIT_L(0); PG8_BAR; PG8_MMA(1, 0, At, B0); PG8_MMA(1, 1, At, B1); PG8_BAR; PG8_SCHED;
            } else {
            PG8_LDB(B0, 0, 0); PG8_SCHED; PG8_LDA(At, 0, 0); PG8_STAGE(PG8_SA(1, 1), a1 + hstep, voffA);
            PG8_WAIT_L(8); PG8_BAR; PG8_WAIT_L(0); PG8_MMA(0, 0, At, B0); PG8_BAR; PG8_SCHED;
            PG8_LDB(B1, 0, 1); PG8_STAGE(PG8_SB(0, 0), b2, voffB);
            PG8_BAR; PG8_WAIT_L(0); PG8_MMA(0, 1, At, B1); PG8_BAR;
            PG8_LDA(At, 0, 1); PG8_STAGE(PG8_SA(0, 0), a2, voffA);
            PG8_BAR; PG8_WAIT_L(0); PG8_MMA(1, 0, At, B0); PG8_BAR; PG8_SCHED;
            PG8_STAGE(PG8_SB(0, 1), b2 + hstep, voffB);
            PG8_WAIT_V(6); PG8_BAR; PG8_MMA(1, 1, At, B1); PG8_BAR;
            PG8_LDB(B0, 1, 0); PG8_SCHED; PG8_LDA(At, 1, 0); PG8_STAGE(PG8_SA(0, 1), a2 + hstep, voffA);
            PG8_WAIT_L(8); PG8_BAR; PG8_WAIT_L(0); PG8_MMA(0, 0, At, B0); PG8_BAR; PG8_SCHED;
            PG8_LDB(B1, 1, 1); PG8_STAGE(PG8_SB(1, 0), b3, voffB);
            PG8_BAR; PG8_WAIT_L(0); PG8_MMA(0, 1, At, B1); PG8_BAR;
            PG8_LDA(At, 1, 1); PG8_STAGE(PG8_SA(1, 0), a3, voffA);
            PG8_BAR; PG8_WAIT_L(0); PG8_MMA(1, 0, At, B0); PG8_BAR; PG8_SCHED;
            PG8_STAGE(PG8_SB(1, 1), b3 + hstep, voffB);
            PG8_WAIT_V(6); PG8_BAR; PG8_MMA(1, 1, At, B1); PG8_BAR;
            }
        }
        if constexpr (ALIGN_EPI) { if (wr == 0) PG8_BAR; }
        if constexpr (!Epi::AFTER_DRAIN) { E(acc, cur, wr, wc, fr, fq); S.done(cur); }
        if (!has_next) break;
#pragma unroll
        for (int a = 0; a < 2; ++a)
#pragma unroll
            for (int b = 0; b < 2; ++b)
#pragma unroll
                for (int m = 0; m < 4; ++m)
#pragma unroll
                    for (int n = 0; n < 2; ++n) acc[a][b][m][n] = (f32x4){0.f, 0.f, 0.f, 0.f};
        cur = nxt; cA = nA; cB = nB; ++ui;
        if constexpr (ALIGN_EPI) { if (wr == 1) PG8_BAR; }
    }
    PG8_WAIT_V(0);
    if constexpr (!ALIGN_EPI) { if (wr == 0) PG8_BAR; }
    PG8_BAR;
    if constexpr (Epi::AFTER_DRAIN) { E.fused(acc, cur, wr, wc, fr, fq, lds, wid, lane); S.done(cur); }
#undef PG8_SA
#undef PG8_SB
#undef PG8_STAGE
#undef PG8_LDA
#undef PG8_LDB
#undef PG8_MMA
#undef PG8_WAIT_V
#undef PG8_WAIT_L
#undef PG8_BAR
#undef PG8_SCHED
}
}
#define GAS __attribute__((address_space(1)))
#define LAS __attribute__((address_space(3)))
typedef unsigned short bf16;
typedef unsigned v4u __attribute__((ext_vector_type(4)));
typedef float f32x4 __attribute__((ext_vector_type(4)));
typedef short bf16x8 __attribute__((ext_vector_type(8)));
typedef GAS unsigned gu32;
typedef GAS unsigned long long gu64;
#define RLX_AGENT __ATOMIC_RELAXED, __HIP_MEMORY_SCOPE_AGENT
#define LDS_WAIT() asm volatile("s_waitcnt lgkmcnt(0)" ::: "memory")
#define VM_WAIT() asm volatile("s_waitcnt vmcnt(0)" ::: "memory")
__device__ __forceinline__ unsigned long long rt() { return __builtin_amdgcn_s_memrealtime(); }
__device__ __forceinline__ unsigned f2bf(float f) { unsigned u = __builtin_bit_cast(unsigned, f); return (u + 0x7fffu + ((u >> 16) & 1u)) >> 16; }
__device__ __forceinline__ unsigned pk2(float lo, float hi) { return f2bf(lo) | (f2bf(hi) << 16); }
#define XB_TMO      128
#define XB_XCNT(j)  (256  + 64 * (j))
#define XB_XSUB(j)  (1280 + 64 * (j))
#define XB_XGEN(j)  (2304 + 64 * (j))
#define XB_TOP      3328
#define XB_TOPGEN   3392
#define XCD_BAR_WORDS 3456
#define XB_SPIN_CAP (1u << 18)

__device__ __forceinline__ unsigned xb_ld(unsigned* p)              { return __hip_atomic_load(p, __ATOMIC_RELAXED, __HIP_MEMORY_SCOPE_AGENT); }
__device__ __forceinline__ unsigned xb_add(unsigned* p, unsigned v) { return __hip_atomic_fetch_add(p, v, __ATOMIC_RELAXED, __HIP_MEMORY_SCOPE_AGENT); }
__device__ __forceinline__ unsigned xb_xcc_id() { return (unsigned)__builtin_amdgcn_s_getreg((3 << 11) | 20) & 0xFu; }
#define XB_SPIN(cond, bar) do { unsigned _sp = 0; while (cond) { __builtin_amdgcn_s_sleep(1); \
    if ((++_sp & 255u) == 0u) { if (xb_ld(&(bar)[XB_TMO])) break; if (_sp > XB_SPIN_CAP) { atomicAdd(&(bar)[XB_TMO], 1u); break; } } } } while (0)

struct XcdBarrier {
    unsigned* bar; unsigned x;
    volatile LAS unsigned* st;
};

__device__ __forceinline__ XcdBarrier xcd_barrier_post(unsigned* bar, volatile LAS unsigned* st) {
    XcdBarrier b; b.bar = bar; b.x = xb_xcc_id(); b.st = st;
    if (threadIdx.x == 0) (void)xb_add(&bar[XB_XCNT(b.x)], 1u);
    return b;
}
__device__ __forceinline__ void xcd_barrier_complete(unsigned* bar, unsigned x, unsigned& nloc, unsigned& nx) {
    const unsigned G = gridDim.x * gridDim.y * gridDim.z;
    unsigned sum, cnt, mine, sp = 0u;
    for (;;) {
        sum = 0u; cnt = 0u; mine = 0u;
#pragma unroll
        for (unsigned j = 0; j < 16; ++j) { const unsigned c = xb_ld(&bar[XB_XCNT(j)]); sum += c; cnt += (c > 0u) ? 1u : 0u; mine = (j == x) ? c : mine; }
        if (sum == G) break;
        __builtin_amdgcn_s_sleep(1);
        if ((++sp & 255u) == 0u) { if (xb_ld(&bar[XB_TMO])) break; if (sp > XB_SPIN_CAP) { atomicAdd(&bar[XB_TMO], 1u); break; } }
    }
    nloc = mine > 0u ? mine : 1u; nx = cnt > 0u ? cnt : 1u;
}

__device__ __forceinline__ void xcd_barrier(const XcdBarrier& b) {
    asm volatile("s_waitcnt vmcnt(0)" ::: "memory");
    __syncthreads();
    if (threadIdx.x == 0) {
        unsigned* bar = b.bar;
        __builtin_amdgcn_s_waitcnt(0);
        unsigned nloc = b.st[0], nx = b.st[1];
        if (nloc == 0u) { xcd_barrier_complete(bar, b.x, nloc, nx); b.st[0] = nloc; b.st[1] = nx; }
        const unsigned old = xb_add(&bar[XB_XSUB(b.x)], 1u);
        const unsigned gen = old / nloc;
        if (old + 1u == (gen + 1u) * nloc) {
            __builtin_amdgcn_fence(__ATOMIC_RELEASE, "agent");
            asm volatile("s_waitcnt vmcnt(0)" ::: "memory");
            const unsigned og = xb_add(&bar[XB_TOP], 1u);
            const unsigned tg = og / nx;
            if (og + 1u == (tg + 1u) * nx) xb_add(&bar[XB_TOPGEN], 1u);
            else XB_SPIN(xb_ld(&bar[XB_TOPGEN]) == tg, bar);
            __builtin_amdgcn_fence(__ATOMIC_ACQUIRE, "agent");
            xb_add(&bar[XB_XGEN(b.x)], 1u);
            asm volatile("s_waitcnt vmcnt(0)" ::: "memory");
        } else {
            XB_SPIN(xb_ld(&bar[XB_XGEN(b.x)]) == gen, bar);
            __builtin_amdgcn_fence(__ATOMIC_ACQUIRE, "agent");
            asm volatile("s_waitcnt vmcnt(0)" ::: "memory");
        }
    }
    __syncthreads();
}

constexpr int NWAVES = 8;
constexpr int D = 2048, M = 9216, MP = 8192, TP = 2048, NLAYER = 4;
constexpr int NIN_SRC = 14352, LDP = 14336;
constexpr int PC_U = 0, PC_Z = 1024, PC_Q = 2048, PC_K = 2560, PC_V = 3072, PC_GZ = 4096, PC_CA = 5120, PC_CB = 6144, PC_CZ = 7168, PC_GATE = 8192;
constexpr float LN_EPS = 1e-5f;
constexpr float DN_ALPHA = 1.681792830507429f;
constexpr float QSCALE = 0.08838834764831845f;
constexpr int NPH_LAYER = 9, NPHASE = 1 + NLAYER * NPH_LAYER;

constexpr size_t OUT_Y = 0;
constexpr size_t OUT_S5RE_P = 18874368, OUT_S5IM_P = 18939904, OUT_GLA_P = 19005440, OUT_CONV_P = 21102592;
constexpr size_t OUT_S5RE_S = 21594112, OUT_S5IM_S = 23691264, OUT_GLA_S = 25788416, OUT_CONV_S = 92897280, OUT_TOTAL = 108625920;

constexpr size_t MiB = 1u << 20;
constexpr size_t WS_CTL = 0, CTL_ZERO_BYTES = 1 * MiB;
constexpr size_t WS_WT = 1 * MiB, WT_LAYER = 88 * MiB;
constexpr size_t WO_WIN = 0, WO_WA = WO_WIN + (size_t)LDP * D, WO_WGLU = WO_WA + 16 * D, WO_PS5 = WO_WGLU + 1024 * 1024, WO_PGLA = WO_PS5 + 2048 * 1024, WO_PCONV = WO_PGLA + 2048 * 1024,
                 WO_WO = WO_PCONV + 2048 * 1024, WO_WPG = WO_WO + 2048 * 2048, WO_WPE = WO_WPG + 2048 * 2048, WO_END = WO_WPE + 2048 * 256;
static_assert(WO_END * 2 <= WT_LAYER, "weight block");
constexpr size_t WS_TAB = WS_WT + NLAYER * WT_LAYER, TAB_LAYER = 1 * MiB;
constexpr size_t TB_ABAR = 0, TB_A64 = 32768, TB_BBT = 65536, TB_CMT = 65536 + 262144;
constexpr size_t WS_XB = WS_TAB + NLAYER * TAB_LAYER;
constexpr size_t WS_PB = WS_XB + 36 * MiB;
constexpr size_t WS_P = WS_PB + 18 * MiB;
constexpr size_t WS_ALOW = WS_P + 252 * MiB;
constexpr size_t WS_YG = WS_ALOW + 1 * MiB, WS_AS = WS_YG + 18 * MiB, WS_AG = WS_AS + 18 * MiB, WS_AC = WS_AG + 18 * MiB;
constexpr size_t WS_OSUM = WS_AC + 18 * MiB;
constexpr size_t WS_OSB = WS_OSUM + 72 * MiB;
constexpr size_t WS_H32 = WS_OSB + 36 * MiB, WS_HB = WS_H32 + 72 * MiB, WS_PE = WS_HB + 36 * MiB, WS_H2 = WS_PE + 36 * MiB;
constexpr size_t WS_SS = WS_H2 + 72 * MiB;
constexpr size_t WS_KVS = WS_SS + 4 * MiB;
constexpr size_t WS_LSUM = WS_KVS + 32 * MiB;
constexpr size_t WS_END = WS_LSUM + 1 * MiB;
constexpr int CW_BAR = 4096;

constexpr int RING_BYTES = 131072;
constexpr int LDSCTL_OFF = RING_BYTES, MISC_OFF = LDSCTL_OFF + 320;
constexpr int LDS_BYTES = 147456;

typedef float f32x16 __attribute__((ext_vector_type(16)));
typedef short v4s __attribute__((ext_vector_type(4)));
typedef unsigned v2u __attribute__((ext_vector_type(2)));
__device__ __forceinline__ float bf2f(bf16 b) { return __uint_as_float(((unsigned)b) << 16); }
__device__ __forceinline__ unsigned cvtpk(float lo, float hi) { return pg8::cvt_pk_bf16(lo, hi); }
__device__ __forceinline__ bf16 f2bf16(float f) { return (bf16)f2bf(f); }
__device__ __forceinline__ float gelu_tanh(float x) { const float z = 0.7978845608028654f * (x + 0.044715f * x * x * x); const float t = 1.0f - 2.0f / (1.0f + __expf(2.0f * z)); return 0.5f * x * (1.0f + t); }
__device__ __forceinline__ float log_sigmoid(float x) { return fminf(x, 0.f) - __logf(1.0f + __expf(-fabsf(x))); }
__device__ __forceinline__ bf16x8 zero8() { return (bf16x8){0, 0, 0, 0, 0, 0, 0, 0}; }
__device__ __forceinline__ bf16x8 join8(v4s a, v4s b) { return (bf16x8){a[0], a[1], a[2], a[3], b[0], b[1], b[2], b[3]}; }
__device__ __forceinline__ v4s tr_read(const LAS void* p) { return __builtin_amdgcn_ds_read_tr16_b64_v4i16((LAS v4s*)p); }
#define MFMA16(a, b, c) __builtin_amdgcn_mfma_f32_16x16x32_bf16((a), (b), (c), 0, 0, 0)
#define MFMA32(a, b, c) __builtin_amdgcn_mfma_f32_32x32x16_bf16((a), (b), (c), 0, 0, 0)
#define WAVE_LDS_FENCE() asm volatile("s_waitcnt lgkmcnt(0)" ::: "memory")
__device__ __forceinline__ f32x4 mfma16k(bf16x8 a, bf16x8 b, f32x4 c) { f32x4 d = MFMA16(a, b, c); asm volatile("" : "+v"(d) : "v"(a), "v"(b)); return d; }
__device__ __forceinline__ f32x16 mfma32k(bf16x8 a, bf16x8 b, f32x16 c) { f32x16 d = MFMA32(a, b, c); asm volatile("" : "+v"(d) : "v"(a), "v"(b)); return d; }
#define PIN16(d) asm volatile("s_nop 7" : "+v"(d))
#define PIN32(d) asm volatile("s_nop 7\n\ts_nop 3" : "+v"(d))

struct Frame {
    LAS unsigned char* lds;
    gu32* ctl;
    int tid, lane, wave, vcu, G;
    float* out; unsigned char* ws;
};
constexpr int PTAB_OFF = LDSCTL_OFF + 1024;
__device__ __forceinline__ const float* inp(const Frame& F, int k) {
    const unsigned long long v = ((const LAS unsigned long long*)(F.lds + PTAB_OFF))[k];
    const unsigned lo = __builtin_amdgcn_readfirstlane((unsigned)v), hi = __builtin_amdgcn_readfirstlane((unsigned)(v >> 32));
    return (const float*)(((unsigned long long)hi << 32) | (unsigned long long)lo);
}
__device__ __forceinline__ float wave_sum(float v) {
#pragma unroll
    for (int o = 1; o < 64; o <<= 1) v += __shfl_xor(v, o);
    return v;
}

__device__ __forceinline__ void p0_transpose_item(const float* W, int ldw, int src_n0, int k0, bf16* WT, int K, int dst_n0, LAS float* scr, int lane) {
#pragma unroll 8
    for (int i = 0; i < 32; ++i) { const int kk = 2 * i + (lane >> 5); scr[kk * 33 + (lane & 31)] = W[(size_t)(k0 + kk) * ldw + src_n0 + (lane & 31)]; }
    LDS_WAIT(); asm volatile("" ::: "memory");
    const int c = lane & 7;
#pragma unroll
    for (int j = 0; j < 4; ++j) { const int n = (lane >> 3) + 8 * j; const LAS float* s = scr + (8 * c) * 33 + n;
        v4u o; o.x = pk2(s[0 * 33], s[1 * 33]); o.y = pk2(s[2 * 33], s[3 * 33]); o.z = pk2(s[4 * 33], s[5 * 33]); o.w = pk2(s[6 * 33], s[7 * 33]);
        *(GAS v4u*)(WT + (size_t)(dst_n0 + n) * K + k0 + 8 * c) = o; }
    LDS_WAIT(); asm volatile("" ::: "memory");
}
__device__ __forceinline__ void p0_tr_mat(const float* W, int K, int N, bf16* WT, LAS float* scr, int item, int lane) {
    const int nblk = N / 32, kb = item / nblk, nb = item % nblk;
    p0_transpose_item(W, N, 32 * nb, 64 * kb, WT, K, 32 * nb, scr, lane);
}
__device__ __forceinline__ void p0_prologue(Frame& F) {
    LAS float* scr = (LAS float*)(F.lds + F.wave * 16384);
    const int gw = F.vcu * NWAVES + F.wave, NGW = F.G * NWAVES;
    const float* w_in = inp(F, 8); const float* w_glu = inp(F, 18); const float* p_s5 = inp(F, 27); const float* p_gla = inp(F, 28); const float* p_conv = inp(F, 29);
    const float* w_o = inp(F, 30); const float* w_pg = inp(F, 31); const float* w_pe = inp(F, 32);
    constexpr int I_IN = (D / 64) * (LDP / 32), I_GLU = 16 * 32, I_P = 16 * 64, I_O = 32 * 64, I_PE = 4 * 64;
    constexpr int I_LAYER = I_IN + I_GLU + 3 * I_P + 2 * I_O + I_PE;
    for (int it = gw; it < NLAYER * I_LAYER; it += NGW) {
        const int l = it / I_LAYER; int r = it % I_LAYER;
        bf16* wt = (bf16*)(F.ws + WS_WT + (size_t)l * WT_LAYER);
        if (r < I_IN) { const int nblk = LDP / 32, kb = r / nblk, nb = r % nblk; const int dn0 = 32 * nb, sn0 = dn0 + (dn0 >= 4096 ? 16 : 0);
            p0_transpose_item(w_in + (size_t)l * D * NIN_SRC, NIN_SRC, sn0, 64 * kb, wt + WO_WIN, D, dn0, scr, F.lane); continue; } r -= I_IN;
        if (r < I_GLU) { p0_tr_mat(w_glu + (size_t)l * 1024 * 1024, 1024, 1024, wt + WO_WGLU, scr, r, F.lane); continue; } r -= I_GLU;
        if (r < I_P) { p0_tr_mat(p_s5 + (size_t)l * 1024 * 2048, 1024, 2048, wt + WO_PS5, scr, r, F.lane); continue; } r -= I_P;
        if (r < I_P) { p0_tr_mat(p_gla + (size_t)l * 1024 * 2048, 1024, 2048, wt + WO_PGLA, scr, r, F.lane); continue; } r -= I_P;
        if (r < I_P) { p0_tr_mat(p_conv + (size_t)l * 1024 * 2048, 1024, 2048, wt + WO_PCONV, scr, r, F.lane); continue; } r -= I_P;
        if (r < I_O) { p0_tr_mat(w_o + (size_t)l * 2048 * 2048, 2048, 2048, wt + WO_WO, scr, r, F.lane); continue; } r -= I_O;
        if (r < I_O) { p0_tr_mat(w_pg + (size_t)l * 2048 * 2048, 2048, 2048, wt + WO_WPG, scr, r, F.lane); continue; } r -= I_O;
        p0_tr_mat(w_pe + (size_t)l * 256 * 2048, 256, 2048, wt + WO_WPE, scr, r, F.lane);
    }
    const size_t gt = (size_t)F.vcu * (NWAVES * 64) + F.tid, NGT = (size_t)F.G * NWAVES * 64;
    for (size_t i = gt; i < (size_t)NLAYER * 16 * D; i += NGT) { const int l = (int)(i / (16 * D)), j = (int)((i / D) % 16), k = (int)(i % D);
        ((bf16*)(F.ws + WS_WT + (size_t)l * WT_LAYER))[WO_WA + (size_t)j * D + k] = f2bf16(w_in[((size_t)l * D + k) * NIN_SRC + 4096 + j]); }
    { const float* xp = inp(F, 0); const float* xs = inp(F, 1); bf16* XB = (bf16*)(F.ws + WS_XB);
      for (size_t i = gt; i < (size_t)M * D / 8; i += NGT) { const size_t e = i * 8; const float* src = (e < (size_t)MP * D) ? xp + e : xs + (e - (size_t)MP * D);
          const f32x4 a = *(const f32x4*)src, b = *(const f32x4*)(src + 4); v4u o; o.x = pk2(a[0], a[1]); o.y = pk2(a[2], a[3]); o.z = pk2(b[0], b[1]); o.w = pk2(b[2], b[3]); *(v4u*)(XB + e) = o; } }
    { const float* pp = inp(F, 2); const float* ps = inp(F, 3); bf16* PB = (bf16*)(F.ws + WS_PB);
      for (size_t i = gt; i < (size_t)NLAYER * M * 256 / 8; i += NGT) { const size_t e = i * 8; const int l = (int)(e / ((size_t)M * 256)); const size_t r = e % ((size_t)M * 256);
          const float* src = (r < (size_t)MP * 256) ? pp + (size_t)l * MP * 256 + r : ps + (size_t)l * 1024 * 256 + (r - (size_t)MP * 256);
          const f32x4 a = *(const f32x4*)src, b = *(const f32x4*)(src + 4); v4u o; o.x = pk2(a[0], a[1]); o.y = pk2(a[2], a[3]); o.z = pk2(b[0], b[1]); o.w = pk2(b[2], b[3]); *(v4u*)(PB + e) = o; } }
    { const float* a_re = inp(F, 10); const float* a_im = inp(F, 11); const float* log_dt = inp(F, 12); const float* b_re = inp(F, 13); const float* b_im = inp(F, 14); const float* c_re = inp(F, 15); const float* c_im = inp(F, 16);
      for (size_t i = gt; i < (size_t)NLAYER * 64 * 64; i += NGT) { const int l = (int)(i >> 12), g = (int)((i >> 6) & 63), p = (int)(i & 63);
          unsigned char* tb = F.ws + WS_TAB + (size_t)l * TAB_LAYER;
          const float lr = a_re[i], li = a_im[i], dt = expf(log_dt[l * 64 + g]);
          const float er = expf(lr * dt); float sn, cs; sincosf(li * dt, &sn, &cs); const float ar = er * cs, ai = er * sn;
          ((float*)(tb + TB_ABAR))[2 * (g * 64 + p)] = ar; ((float*)(tb + TB_ABAR))[2 * (g * 64 + p) + 1] = ai;
          const float e64 = expf(64.f * lr * dt); float s64, c64; sincosf(64.f * li * dt, &s64, &c64);
          ((float*)(tb + TB_A64))[2 * (g * 64 + p)] = e64 * c64; ((float*)(tb + TB_A64))[2 * (g * 64 + p) + 1] = e64 * s64;
          const float nr = ar - 1.f, ni = ai, den = lr * lr + li * li; const float fr = (nr * lr + ni * li) / den, fi = (ni * lr - nr * li) / den;
          bf16* BBT = (bf16*)(tb + TB_BBT);
          for (int c = 0; c < 16; ++c) { const float br = b_re[i * 16 + c], bi = b_im[i * 16 + c];
              BBT[((size_t)g * 128 + p) * 16 + c] = f2bf16(fr * br - fi * bi); BBT[((size_t)g * 128 + 64 + p) * 16 + c] = f2bf16(fr * bi + fi * br); } }
      for (size_t i = gt; i < (size_t)NLAYER * 64 * 16 * 128; i += NGT) { const int l = (int)(i / (64 * 16 * 128)); const int r = (int)(i % (64 * 16 * 128)); const int g = r / (16 * 128), ch = (r / 128) % 16, k = r % 128;
          bf16* CMT = (bf16*)(F.ws + WS_TAB + (size_t)l * TAB_LAYER + TB_CMT);
          const size_t ci = (((size_t)l * 64 + g) * 16 + ch) * 64 + (k & 63);
          CMT[r] = f2bf16(k < 64 ? c_re[ci] : -c_im[ci]); } }
}

__device__ __forceinline__ void alow_phase(Frame& F, int l) {
    const int gw = F.vcu * NWAVES + F.wave;
    if (gw >= M / 16) return;
    const bf16* XB = (const bf16*)(F.ws + WS_XB); const bf16* WA = (const bf16*)(F.ws + WS_WT + (size_t)l * WT_LAYER) + WO_WA;
    const float* b_in = inp(F, 9) + (size_t)l * NIN_SRC;
    float* ALOW = (float*)(F.ws + WS_ALOW);
    const int c16 = F.lane & 15, q4 = F.lane >> 4;
    const bf16* ap = XB + (size_t)(16 * gw + c16) * D + 8 * q4; const bf16* bp = WA + (size_t)c16 * D + 8 * q4;
    f32x4 acc = (f32x4){0.f, 0.f, 0.f, 0.f};
#pragma unroll 8
    for (int ks = 0; ks < D / 32; ++ks) acc = mfma16k(*(const bf16x8*)(ap + 32 * ks), *(const bf16x8*)(bp + 32 * ks), acc);
    PIN16(acc);
    const float bb = b_in[4096 + c16];
#pragma unroll
    for (int r = 0; r < 4; ++r) ALOW[(size_t)(16 * gw + 4 * q4 + r) * 16 + c16] = acc[r] + bb;
}

template <int MODE>
__device__ __forceinline__ void s5_unit(LAS float* T, int lane, const bf16* P, size_t row0, int g, const float* abar, const bf16* BBT, const bf16* CMT, const float* dsk,
                                        float* ss, const float* h0re, const float* h0im, float* outre, float* outim, bf16* YG) {
    asm volatile("" : "+v"(lane));
    const int c16 = lane & 15, q4 = lane >> 4;
    bf16x8 bfr[8];
#pragma unroll
    for (int nb = 0; nb < 8; ++nb) bfr[nb] = (lane < 32) ? *(const bf16x8*)(BBT + ((size_t)g * 128 + 16 * nb + c16) * 16 + 8 * q4) : zero8();
    bf16x8 cfr[4];
    if (MODE >= 1) {
#pragma unroll
        for (int ks = 0; ks < 4; ++ks) cfr[ks] = *(const bf16x8*)(CMT + ((size_t)g * 16 + c16) * 128 + 32 * ks + 8 * q4);
    }
    const float ar = abar[2 * (g * 64 + lane)], ai = abar[2 * (g * 64 + lane) + 1];
    float hr = 0.f, hi = 0.f;
    if (MODE == 1) { hr = ss[lane]; hi = ss[64 + lane]; }
    const float dv = (MODE >= 1) ? dsk[16 * g + c16] : 0.f;
    for (int tb = 0; tb < 4; ++tb) {
        const bf16x8 af = (lane < 32) ? *(const bf16x8*)(P + (row0 + 16 * tb + c16) * LDP + PC_U + 16 * g + 8 * (q4 & 1)) : zero8();
        f32x4 dd[8];
#pragma unroll
        for (int nb = 0; nb < 8; ++nb) dd[nb] = mfma16k(af, bfr[nb], ((f32x4){0.f, 0.f, 0.f, 0.f}));
        asm volatile("s_nop 7\n\ts_nop 7" : "+v"(dd[0]), "+v"(dd[1]), "+v"(dd[2]), "+v"(dd[3]), "+v"(dd[4]), "+v"(dd[5]), "+v"(dd[6]), "+v"(dd[7]) : "v"(af));
#pragma unroll
        for (int nb = 0; nb < 8; ++nb) *(LAS f32x4*)(T + (16 * nb + c16) * 20 + 4 * q4) = dd[nb];
        WAVE_LDS_FENCE();
#pragma unroll
        for (int i = 0; i < 4; ++i) {
            const int bs = 2 * tb + (i >> 1);
            if (MODE == 2 && (i & 1) == 0) { hr = h0re[(size_t)bs * 4096 + lane]; hi = h0im[(size_t)bs * 4096 + lane]; }
            const f32x4 re = *(LAS f32x4*)(T + lane * 20 + 4 * i), im = *(LAS f32x4*)(T + (64 + lane) * 20 + 4 * i);
            float r[4], mm[4];
#pragma unroll
            for (int k = 0; k < 4; ++k) { const float nr = ar * hr - ai * hi + re[k], ni = ar * hi + ai * hr + im[k]; hr = nr; hi = ni; r[k] = nr; mm[k] = ni; }
            if (MODE >= 1) { *(LAS v2u*)(T + lane * 20 + 4 * i) = (v2u){cvtpk(r[0], r[1]), cvtpk(r[2], r[3])}; *(LAS v2u*)(T + (64 + lane) * 20 + 4 * i) = (v2u){cvtpk(mm[0], mm[1]), cvtpk(mm[2], mm[3])}; }
            if (MODE == 2 && (i & 1) == 1) { outre[(size_t)bs * 4096 + lane] = hr * DIAG_SGN(DIAG_S5S, lane ^ bs ^ g); outim[(size_t)bs * 4096 + lane] = hi * DIAG_SGN(DIAG_S5S, lane ^ bs ^ g); }
        }
        if (MODE >= 1) {
            WAVE_LDS_FENCE();
            f32x4 y = (f32x4){0.f, 0.f, 0.f, 0.f};
#pragma unroll
            for (int ks = 0; ks < 4; ++ks) {
                const LAS float* a0 = T + (32 * ks + 8 * q4 + (c16 >> 2)) * 20 + 4 * (c16 & 3);
                const v4s lo = tr_read(a0), hh = tr_read(a0 + 4 * 20);
                y = mfma16k(join8(lo, hh), cfr[ks], y);
            }
            PIN16(y);
#pragma unroll
            for (int r = 0; r < 4; ++r) { const size_t grow = row0 + 16 * tb + 4 * q4 + r; const float uu = bf2f(P[grow * LDP + PC_U + 16 * g + c16]);
                YG[grow * 1024 + 16 * g + c16] = f2bf16(gelu_tanh(y[r] + dv * uu)); }
            WAVE_LDS_FENCE();
        }
    }
    if (MODE == 0) { ss[lane] = hr; ss[64 + lane] = hi; }
    if (MODE == 1 && outre) { outre[lane] = hr * DIAG_SGN(DIAG_S5P, lane ^ g); outim[lane] = hi * DIAG_SGN(DIAG_S5P, lane ^ g); }
}
#if defined(DIAG_CHECK)
__device__ __forceinline__ unsigned dhash(unsigned x) { x ^= x >> 16; x *= 0x7feb352dU; x ^= x >> 15; x *= 0x846ca68bU; x ^= x >> 16; return x; }
__device__ __forceinline__ void diag_gemm1(Frame& F) {
    const float* xp = inp(F, 0); const float* xs = inp(F, 1); const float* w_in = inp(F, 8); const float* b_in = inp(F, 9);
    const bf16* P = (const bf16*)(F.ws + WS_P);
    const unsigned gt = (unsigned)F.vcu * 512u + (unsigned)F.tid;
    const unsigned h1 = dhash(gt * 2u + 1u), h2 = dhash(gt * 2u + 0x9e3779b9u);
    const int row = (int)(h1 % (unsigned)M), col = (int)(h2 % (unsigned)LDP);
    const int sc = col + (col >= 4096 ? 16 : 0);
    const float* xr = row < MP ? xp + (size_t)row * D : xs + (size_t)(row - MP) * D;
    float acc = 0.f;
    for (int k = 0; k < D; ++k) acc += xr[k] * w_in[(size_t)k * NIN_SRC + sc];
    acc += b_in[sc];
    const int pn = col >> 8; int act = 0;
    if ((pn >= 4 && pn < 8) || (pn >= 16 && pn < 20) || (pn >= 28 && pn < 32)) act = 1;
    if ((pn >= 24 && pn < 28) || pn >= 32) act = 2;
    float ref = acc; if (act == 1) ref = acc / (1.f + expf(-acc)); if (act == 2) ref = 1.f / (1.f + expf(-acc));
    const float got = bf2f(P[(size_t)row * LDP + col]);
    if (!(fabsf(got - ref) <= 0.03f + 0.03f * fabsf(ref))) atomicAdd((unsigned*)(F.ctl + 16), 1u);
}
__device__ __forceinline__ void diag_s5s(Frame& F, int l) {
    const bf16* P = (const bf16*)(F.ws + WS_P); unsigned char* tb = F.ws + WS_TAB + (size_t)l * TAB_LAYER;
    const float* abar = (const float*)(tb + TB_ABAR); const bf16* BBT = (const bf16*)(tb + TB_BBT);
    const int gw = F.vcu * NWAVES + F.wave, NGW = F.G * NWAVES, lane = F.lane;
    for (int wu = gw; wu < 16 * 64; wu += NGW) { const int g = wu & 63, bg = wu >> 6; const size_t so = (((size_t)l * 128 + 8 * bg) * 64 + g) * 64;
        const float ar = abar[2 * (g * 64 + lane)], ai = abar[2 * (g * 64 + lane) + 1];
        float br[16], bi[16];
#pragma unroll
        for (int c = 0; c < 16; ++c) { br[c] = bf2f(BBT[((size_t)g * 128 + lane) * 16 + c]); bi[c] = bf2f(BBT[((size_t)g * 128 + 64 + lane) * 16 + c]); }
        for (int bs = 0; bs < 8; ++bs) { float hr = inp(F, 4)[so + (size_t)bs * 4096 + lane], hi = inp(F, 5)[so + (size_t)bs * 4096 + lane];
            for (int t = 0; t < 8; ++t) { const bf16* ur = P + ((size_t)MP + 64 * bg + 8 * bs + t) * LDP + PC_U + 16 * g; float sr = 0.f, si = 0.f;
#pragma unroll
                for (int c = 0; c < 16; ++c) { const float uu = bf2f(ur[c]); sr += br[c] * uu; si += bi[c] * uu; }
                const float nr = ar * hr - ai * hi + sr, ni = ar * hi + ai * hr + si; hr = nr; hi = ni; }
            const float gr = F.out[OUT_S5RE_S + so + (size_t)bs * 4096 + lane], gi = F.out[OUT_S5IM_S + so + (size_t)bs * 4096 + lane];
            if (!(fabsf(gr - hr) <= 1e-4f + 2e-3f * fabsf(hr)) || !(fabsf(gi - hi) <= 1e-4f + 2e-3f * fabsf(hi))) atomicAdd((unsigned*)(F.ctl + 17), 1u); } }
}
__device__ __forceinline__ float diag_scale(Frame& F) {
    const unsigned c1 = __hip_atomic_load((unsigned*)(F.ctl + 16), __ATOMIC_RELAXED, __HIP_MEMORY_SCOPE_AGENT), c2 = __hip_atomic_load((unsigned*)(F.ctl + 17), __ATOMIC_RELAXED, __HIP_MEMORY_SCOPE_AGENT);
    if (c2 > 0u) return 2.0f;
    int n = 0; if (c1 >= 1u) n = 1; if (c1 >= 4u) n = 2; if (c1 >= 16u) n = 3; if (c1 >= 64u) n = 4; if (c1 >= 256u) n = 5;
    return 1.0f + 0.1f * (float)n;
}
#endif

constexpr int GL_QD = 0, GL_KD = 17408, GL_KDT = 34816, GL_ATT = 53248, GL_V = 62464, GL_AL = 96256, GL_GS = 100352, GL_LAM = 102400, GL_END = 102912;
constexpr int GL_O = 0;
__device__ __forceinline__ int gla_pos(int dk) { const int x = dk & 15; return (dk & ~15) | (x & 3) | ((x & 4) << 1) | ((x & 8) >> 1); }

template <bool FINISH>
__device__ __forceinline__ float gla_chunk(Frame& F, f32x16 (&S)[4], const bf16* P, const float* ALOW, bf16* AG, size_t row0, int nvalid, int h, const float (&w2)[16], float ba, const float* norm_g) {
    LAS unsigned char* L = F.lds;
    int tid_l = threadIdx.x; asm volatile("" : "+v"(tid_l));
    const int tid = tid_l, lane = tid & 63, w = F.wave, l31 = lane & 31, hh = lane >> 5;
    if (tid < 256) { const int r = tid >> 2, c4 = tid & 3; f32x4 a = (f32x4){0.f, 0.f, 0.f, 0.f}; if (r < nvalid) a = *(const f32x4*)(ALOW + (row0 + r) * 16 + 4 * c4); *(LAS f32x4*)(L + GL_AL + (r * 16 + 4 * c4) * 4) = a; }
#pragma unroll
    for (int i = 0; i < 4; ++i) { const int idx = tid + 512 * i, r = idx >> 5, ch = idx & 31; v4u v = (v4u){0u, 0u, 0u, 0u}; if (r < nvalid) v = *(const v4u*)(P + (row0 + r) * LDP + PC_V + h * 256 + 8 * ch); *(LAS v4u*)(L + GL_V + r * 528 + ch * 16) = v; }
    __syncthreads();
    const int dk = tid & 127, tg = tid >> 7;
    float lc[16]; float run = 0.f;
#pragma unroll
    for (int i = 0; i < 16; ++i) { const int t = 16 * tg + i; const LAS f32x4* al = (const LAS f32x4*)(L + GL_AL + t * 64); float lg = ba;
#pragma unroll
        for (int q = 0; q < 4; ++q) { const f32x4 a = al[q]; lg += a[0] * w2[4 * q] + a[1] * w2[4 * q + 1] + a[2] * w2[4 * q + 2] + a[3] * w2[4 * q + 3]; }
        const float la = (t < nvalid) ? log_sigmoid(lg) * (1.0f / 16.0f) : 0.f; run += la; lc[i] = run; if ((i & 3) == 3) asm volatile("" ::: "memory"); }
    ((LAS float*)(L + GL_GS))[tg * 128 + dk] = run;
    __syncthreads();
    float off = 0.f, last = 0.f;
#pragma unroll
    for (int q = 0; q < 4; ++q) { const float gsv = ((LAS float*)(L + GL_GS))[q * 128 + dk]; if (q < tg) off += gsv; last += gsv; }
    if (tg == 0) ((LAS float*)(L + GL_LAM))[dk] = __expf(last);
    {
        const int pos = gla_pos(dk); unsigned kd2[8];
#pragma unroll
        for (int i = 0; i < 16; i += 2) { float kdec[2];
#pragma unroll
            for (int j = 0; j < 2; ++j) { const int t = 16 * tg + i + j; const float cum = off + lc[i + j]; float qv = 0.f, kv = 0.f;
                if (t < nvalid) { qv = bf2f(P[(row0 + t) * LDP + PC_Q + h * 128 + dk]); kv = bf2f(P[(row0 + t) * LDP + PC_K + h * 128 + dk]); }
                if (FINISH) { ((LAS bf16*)(L + GL_QD))[t * 136 + pos] = f2bf16(qv * QSCALE * __expf(cum)); ((LAS bf16*)(L + GL_KD))[t * 136 + pos] = f2bf16(kv * __expf(-cum)); }
                kdec[j] = kv * __expf(last - cum); }
            kd2[i >> 1] = cvtpk(kdec[0], kdec[1]); if ((i & 6) == 6) asm volatile("" ::: "memory"); }
        *(LAS v4u*)(L + GL_KDT + dk * 144 + tg * 32) = (v4u){kd2[0], kd2[1], kd2[2], kd2[3]};
        *(LAS v4u*)(L + GL_KDT + dk * 144 + tg * 32 + 16) = (v4u){kd2[4], kd2[5], kd2[6], kd2[7]};
    }
    __syncthreads();
    if (FINISH) {
        if (w < 4) { const int cb = w >> 1, jb = w & 1; f32x16 a = {0.f, 0.f, 0.f, 0.f, 0.f, 0.f, 0.f, 0.f, 0.f, 0.f, 0.f, 0.f, 0.f, 0.f, 0.f, 0.f};
#pragma unroll
            for (int s = 0; s < 8; ++s) { const bf16x8 af = *(const LAS bf16x8*)(L + GL_QD + (32 * cb + l31) * 272 + (16 * s + 8 * hh) * 2), bf = *(const LAS bf16x8*)(L + GL_KD + (32 * jb + l31) * 272 + (16 * s + 8 * hh) * 2); a = mfma32k(af, bf, a); }
            PIN32(a);
#pragma unroll
            for (int r = 0; r < 16; ++r) { const int c = 32 * cb + (r & 3) + 8 * (r >> 2) + 4 * hh, j = 32 * jb + l31; ((LAS bf16*)(L + GL_ATT))[c * 72 + j] = f2bf16(j <= c ? a[r] : 0.f); } }
        __syncthreads();
    }
    bf16x8 vf[4];
    { const int q = (lane & 15) >> 2, p4 = lane & 3, blk = (lane >> 4) & 1;
#pragma unroll
      for (int s = 0; s < 4; ++s) { const LAS unsigned char* a0 = L + GL_V + (16 * s + 8 * hh + q) * 528 + (32 * w + 16 * blk + 4 * p4) * 2; vf[s] = join8(tr_read(a0), tr_read(a0 + 4 * 528)); } }
    f32x16 o[2];
    if (FINISH) {
#pragma unroll
        for (int cb = 0; cb < 2; ++cb) { f32x16 a = {0.f, 0.f, 0.f, 0.f, 0.f, 0.f, 0.f, 0.f, 0.f, 0.f, 0.f, 0.f, 0.f, 0.f, 0.f, 0.f};
#pragma unroll
            for (int s = 0; s < 4; ++s) a = mfma32k(*(const LAS bf16x8*)(L + GL_ATT + (32 * cb + l31) * 144 + (16 * s + 8 * hh) * 2), vf[s], a);
#pragma unroll
            for (int kb = 0; kb < 4; ++kb)
#pragma unroll
                for (int sp = 0; sp < 2; ++sp) { bf16x8 sf; { unsigned u0 = cvtpk(S[kb][8 * sp + 0], S[kb][8 * sp + 1]), u1 = cvtpk(S[kb][8 * sp + 2], S[kb][8 * sp + 3]), u2 = cvtpk(S[kb][8 * sp + 4], S[kb][8 * sp + 5]), u3 = cvtpk(S[kb][8 * sp + 6], S[kb][8 * sp + 7]);
                        v4u pk = (v4u){u0, u1, u2, u3}; sf = __builtin_bit_cast(bf16x8, pk); }
                    a = mfma32k(*(const LAS bf16x8*)(L + GL_QD + (32 * cb + l31) * 272 + (32 * kb + 16 * sp + 8 * hh) * 2), sf, a); }
            PIN32(a); o[cb] = a; }
    }
#pragma unroll
    for (int kb = 0; kb < 4; ++kb) {
#pragma unroll
        for (int q = 0; q < 4; ++q) { const f32x4 lm = *(const LAS f32x4*)(L + GL_LAM + (32 * kb + 8 * q + 4 * hh) * 4);
#pragma unroll
            for (int j = 0; j < 4; ++j) S[kb][4 * q + j] *= lm[j]; }
#pragma unroll
        for (int s = 0; s < 4; ++s) S[kb] = mfma32k(*(const LAS bf16x8*)(L + GL_KDT + (32 * kb + l31) * 144 + (16 * s + 8 * hh) * 2), vf[s], S[kb]);
        PIN32(S[kb]);
    }
    __syncthreads();
    if (FINISH) {
#pragma unroll
        for (int cb = 0; cb < 2; ++cb)
#pragma unroll
            for (int r = 0; r < 16; ++r) { const int c = 32 * cb + (r & 3) + 8 * (r >> 2) + 4 * hh; ((LAS float*)(L + GL_O))[c * 260 + 32 * w + l31] = o[cb][r]; }
        __syncthreads();
        const int row = tid >> 3, seg = tid & 7;
        f32x4 x[8]; float s = 0.f;
#pragma unroll
        for (int j = 0; j < 8; ++j) { x[j] = *(const LAS f32x4*)(L + GL_O + (row * 260 + 32 * seg + 4 * j) * 4); s += (x[j][0] + x[j][1]) + (x[j][2] + x[j][3]); }
        s += __shfl_xor(s, 1); s += __shfl_xor(s, 2); s += __shfl_xor(s, 4);
        const float mean = s * (1.0f / 256.0f); float qq = 0.f;
#pragma unroll
        for (int j = 0; j < 8; ++j) { x[j] = x[j] - mean; qq += (x[j][0] * x[j][0] + x[j][1] * x[j][1]) + (x[j][2] * x[j][2] + x[j][3] * x[j][3]); }
        qq += __shfl_xor(qq, 1); qq += __shfl_xor(qq, 2); qq += __shfl_xor(qq, 4);
        const float rstd = 1.0f / sqrtf(qq * (1.0f / 256.0f) + LN_EPS);
        if (row < nvalid) {
            const size_t grow = row0 + row; const int cbase = h * 256 + 32 * seg;
#pragma unroll
            for (int j = 0; j < 8; j += 2) { f32x4 z0, z1; pg8::unpack8(*(const v4u*)(P + grow * LDP + PC_GZ + cbase + 4 * j), z0, z1);
                const f32x4 g0 = *(const f32x4*)(norm_g + cbase + 4 * j), g1 = *(const f32x4*)(norm_g + cbase + 4 * j + 4);
                const f32x4 y0 = x[j] * rstd * g0 * z0, y1 = x[j + 1] * rstd * g1 * z1;
                *(v4u*)(AG + grow * 1024 + cbase + 4 * j) = pg8::pack8(y0, y1); }
        }
        __syncthreads();
    }
    return last;
}
__device__ __forceinline__ void gla_state_load(Frame& F, f32x16 (&S)[4], const float* src) {
    int ln_l = threadIdx.x & 63; asm volatile("" : "+v"(ln_l));
    const int l31 = ln_l & 31, hh = ln_l >> 5;
#pragma unroll
    for (int kb = 0; kb < 4; ++kb)
#pragma unroll
        for (int r = 0; r < 16; ++r) S[kb][r] = src[(size_t)(32 * kb + (r & 3) + 8 * (r >> 2) + 4 * hh) * 256 + 32 * F.wave + l31];
}
__device__ __forceinline__ void gla_state_store(Frame& F, const f32x16 (&S)[4], float* dst) {
    int ln_l = threadIdx.x & 63; asm volatile("" : "+v"(ln_l));
    const int l31 = ln_l & 31, hh = ln_l >> 5;
#pragma unroll
    for (int kb = 0; kb < 4; ++kb)
#pragma unroll
        for (int r = 0; r < 16; ++r) dst[(size_t)(32 * kb + (r & 3) + 8 * (r >> 2) + 4 * hh) * 256 + 32 * F.wave + l31] = S[kb][r];
}
__device__ __forceinline__ void gla_zero(f32x16 (&S)[4]) {
#pragma unroll
    for (int kb = 0; kb < 4; ++kb)
#pragma unroll
        for (int r = 0; r < 16; ++r) S[kb][r] = 0.f;
}
__device__ __forceinline__ void gla_phaseB(Frame& F, int l) {
    const bf16* P = (const bf16*)(F.ws + WS_P); const float* ALOW = (const float*)(F.ws + WS_ALOW); bf16* AG = (bf16*)(F.ws + WS_AG);
    float* KVS = (float*)(F.ws + WS_KVS); float* LSUM = (float*)(F.ws + WS_LSUM);
    const float* w_a2 = inp(F, 20) + (size_t)l * 16 * 512; const float* b_a = inp(F, 21) + (size_t)l * 512; const float* norm_g = inp(F, 22) + (size_t)l * 1024;
    const int dk = F.tid & 127;
    f32x16 S[4];
    for (int u = F.vcu; u < 256; u += F.G) {
        const int bh = u >> 4, sc = u & 15, b = bh >> 2, h = bh & 3;
        float w2[16];
#pragma unroll
        for (int r = 0; r < 16; ++r) w2[r] = w_a2[r * 512 + h * 128 + dk];
        const float ba = b_a[h * 128 + dk];
        gla_zero(S); float lsum = 0.f;
        for (int ch = 0; ch < 2; ++ch) lsum += gla_chunk<false>(F, S, P, ALOW, AG, (size_t)b * TP + 128 * sc + 64 * ch, 64, h, w2, ba, norm_g);
        gla_state_store(F, S, KVS + ((size_t)bh * 16 + sc) * 32768);
        if (F.tid < 128) LSUM[((size_t)bh * 16 + sc) * 128 + dk] = lsum;
    }
    const float* st_in = inp(F, 6) + (size_t)l * 128 * 4 * 32768; float* st_out = F.out + OUT_GLA_S + (size_t)l * 128 * 4 * 32768;
    for (int u = F.vcu; u < 512; u += F.G) {
        const int bs = u >> 2, h = u & 3;
        float w2[16];
#pragma unroll
        for (int r = 0; r < 16; ++r) w2[r] = w_a2[r * 512 + h * 128 + dk];
        const float ba = b_a[h * 128 + dk];
        gla_state_load(F, S, st_in + (size_t)u * 32768);
        (void)gla_chunk<true>(F, S, P, ALOW, AG, (size_t)MP + 8 * bs, 8, h, w2, ba, norm_g);
        gla_state_store(F, S, st_out + (size_t)u * 32768);
    }
}
__device__ __forceinline__ void gla_phaseD(Frame& F, int l) {
    const bf16* P = (const bf16*)(F.ws + WS_P); const float* ALOW = (const float*)(F.ws + WS_ALOW); bf16* AG = (bf16*)(F.ws + WS_AG);
    const float* KVS = (const float*)(F.ws + WS_KVS);
    const float* w_a2 = inp(F, 20) + (size_t)l * 16 * 512; const float* b_a = inp(F, 21) + (size_t)l * 512; const float* norm_g = inp(F, 22) + (size_t)l * 1024;
    const int dk = F.tid & 127;
    f32x16 S[4];
    for (int u = F.vcu; u < 256; u += F.G) {
        const int bh = u >> 4, sc = u & 15, b = bh >> 2, h = bh & 3;
        float w2[16];
#pragma unroll
        for (int r = 0; r < 16; ++r) w2[r] = w_a2[r * 512 + h * 128 + dk];
        const float ba = b_a[h * 128 + dk];
        gla_state_load(F, S, KVS + ((size_t)bh * 16 + sc) * 32768);
        for (int ch = 0; ch < 2; ++ch) (void)gla_chunk<true>(F, S, P, ALOW, AG, (size_t)b * TP + 128 * sc + 64 * ch, 64, h, w2, ba, norm_g);
    }
}

__device__ __forceinline__ void scans_phaseC(Frame& F, int l) {
    const size_t gt = (size_t)F.vcu * (NWAVES * 64) + F.tid, NGT = (size_t)F.G * NWAVES * 64;
    { float* KVS = (float*)(F.ws + WS_KVS); const float* LSUM = (const float*)(F.ws + WS_LSUM); float* fin = F.out + OUT_GLA_P + (size_t)l * 16 * 32768;
      for (size_t i = gt; i < (size_t)16 * 128 * 64; i += NGT) { const int bh = (int)(i >> 13), dkk = (int)((i >> 6) & 127), d4 = (int)(i & 63);
          f32x4 kv[16]; float lam[16];
#pragma unroll
          for (int sc = 0; sc < 16; ++sc) { kv[sc] = *(const f32x4*)(KVS + (((size_t)bh * 16 + sc) * 128 + dkk) * 256 + 4 * d4); lam[sc] = __expf(LSUM[((size_t)bh * 16 + sc) * 128 + dkk]); }
          f32x4 s = (f32x4){0.f, 0.f, 0.f, 0.f};
#pragma unroll
          for (int sc = 0; sc < 16; ++sc) { *(f32x4*)(KVS + (((size_t)bh * 16 + sc) * 128 + dkk) * 256 + 4 * d4) = s; s = s * lam[sc] + kv[sc]; }
          *(f32x4*)(fin + ((size_t)bh * 128 + dkk) * 256 + 4 * d4) = s; } }
    { float* SS = (float*)(F.ws + WS_SS); const float* a64 = (const float*)(F.ws + WS_TAB + (size_t)l * TAB_LAYER + TB_A64);
      for (size_t i = gt; i < (size_t)4 * 64 * 64; i += NGT) { const int b = (int)(i >> 12), g = (int)((i >> 6) & 63), p = (int)(i & 63);
          const float ar = a64[2 * (g * 64 + p)], ai = a64[2 * (g * 64 + p) + 1]; float cr = 0.f, ci = 0.f;
          for (int c0 = 0; c0 < 32; c0 += 8) { float sr[8], si[8];
#pragma unroll
              for (int j = 0; j < 8; ++j) { const size_t base = (((size_t)b * 32 + c0 + j) * 64 + g) * 128; sr[j] = SS[base + p]; si[j] = SS[base + 64 + p]; }
#pragma unroll
              for (int j = 0; j < 8; ++j) { const size_t base = (((size_t)b * 32 + c0 + j) * 64 + g) * 128; SS[base + p] = cr; SS[base + 64 + p] = ci;
                  const float nr = ar * cr - ai * ci + sr[j], ni = ar * ci + ai * cr + si[j]; cr = nr; ci = ni; } } } }
}
template <int TT, bool SAMPLE>
__device__ __forceinline__ void conv_unit(Frame& F, int l, int b, int t0) {
    const bf16* P = (const bf16*)(F.ws + WS_P); bf16* AC = (bf16*)(F.ws + WS_AC);
    const float* cw = inp(F, 23) + (size_t)l * 31 * 1024; const float* cb = inp(F, 24) + (size_t)l * 1024; const float* lng = inp(F, 25) + (size_t)l * 1024; const float* lnb = inp(F, 26) + (size_t)l * 1024;
    const float* cache = inp(F, 7) + ((size_t)l * 128 + b) * 30 * 1024;
    int tid_l = threadIdx.x; asm volatile("" : "+v"(tid_l));
    const int c0 = 2 * tid_l; const size_t rowbase = SAMPLE ? (size_t)MP + 8 * b : (size_t)b * TP;
    float w0[31], w1[31];
#pragma unroll
    for (int j = 0; j < 31; ++j) { const float2 wv = *(const float2*)(cw + j * 1024 + c0); w0[j] = wv.x; w1[j] = wv.y; }
    float a0[TT], a1[TT];
    { const float2 bv = *(const float2*)(cb + c0);
#pragma unroll
      for (int t = 0; t < TT; ++t) { a0[t] = bv.x; a1[t] = bv.y; } }
    float* cnew = SAMPLE ? F.out + OUT_CONV_S + ((size_t)l * 128 + b) * 30 * 1024 : F.out + OUT_CONV_P + ((size_t)l * 4 + b) * 30 * 1024;
#pragma unroll
    for (int rp = 0; rp < TT + 30; ++rp) {
        const int t = t0 - 30 + rp;
        float g0 = 0.f, g1 = 0.f;
        if (t >= 0) { const unsigned ca = *(const unsigned*)(P + (rowbase + t) * LDP + PC_CA + c0), cbv = *(const unsigned*)(P + (rowbase + t) * LDP + PC_CB + c0);
            g0 = pg8::bflo(ca) * pg8::bflo(cbv); g1 = pg8::bfhi(ca) * pg8::bfhi(cbv); }
        else if (SAMPLE) { const float2 cv = *(const float2*)(cache + (size_t)(30 + t) * 1024 + c0); g0 = cv.x; g1 = cv.y; }
        if (SAMPLE) { const int oi = t + 22; if (oi >= 0 && oi < 30) *(float2*)(cnew + (size_t)oi * 1024 + c0) = make_float2(g0, g1); }
        else { if (rp >= 30 && t >= TP - 30) *(float2*)(cnew + (size_t)(t - (TP - 30)) * 1024 + c0) = make_float2(g0, g1); }
#pragma unroll
        for (int tt = 0; tt < TT; ++tt) { const int j = rp - tt; if (j >= 0 && j <= 30) { a0[tt] += w0[j] * g0; a1[tt] += w1[j] * g1; } }
        if ((rp & 7) == 7) asm volatile("" ::: "memory");
    }
    LAS float* Y = (LAS float*)F.lds;
#pragma unroll
    for (int t = 0; t < TT; ++t) *(LAS pg8::f32x2*)(Y + t * 1024 + c0) = (pg8::f32x2){a0[t], a1[t]};
    __syncthreads();
    for (int t = F.wave; t < TT; t += NWAVES) {
        f32x4 x[4]; float s = 0.f;
#pragma unroll
        for (int j = 0; j < 4; ++j) { x[j] = *(const LAS f32x4*)(Y + t * 1024 + 8 * F.lane + 512 * (j >> 1) + 4 * (j & 1)); s += (x[j][0] + x[j][1]) + (x[j][2] + x[j][3]); }
        const float mean = wave_sum(s) * (1.0f / 1024.0f); float qq = 0.f;
#pragma unroll
        for (int j = 0; j < 4; ++j) { x[j] = x[j] - mean; qq += (x[j][0] * x[j][0] + x[j][1] * x[j][1]) + (x[j][2] * x[j][2] + x[j][3] * x[j][3]); }
        const float rstd = 1.0f / sqrtf(wave_sum(qq) * (1.0f / 1024.0f) + LN_EPS);
        const size_t grow = rowbase + t0 + t;
#pragma unroll
        for (int hf = 0; hf < 2; ++hf) { const int cc = 8 * F.lane + 512 * hf;
            const f32x4 g0 = *(const f32x4*)(lng + cc), g1 = *(const f32x4*)(lng + cc + 4), b0 = *(const f32x4*)(lnb + cc), b1 = *(const f32x4*)(lnb + cc + 4);
            f32x4 z0, z1; pg8::unpack8(*(const v4u*)(P + grow * LDP + PC_CZ + cc), z0, z1);
            const f32x4 y0 = pg8::silu4(x[2 * hf] * rstd * g0 + b0) * z0, y1 = pg8::silu4(x[2 * hf + 1] * rstd * g1 + b1) * z1;
            *(v4u*)(AC + grow * 1024 + cc) = pg8::pack8(y0, y1); }
    }
    __syncthreads();
}
__device__ __forceinline__ void conv_phaseC(Frame& F, int l) {
    for (int u = F.vcu; u < MP / 16; u += F.G) conv_unit<16, false>(F, l, u / (TP / 16), 16 * (u % (TP / 16)));
    for (int u = F.vcu; u < 128; u += F.G) conv_unit<8, true>(F, l, u, 0);
}

__device__ __forceinline__ void s5_phaseB(Frame& F, int l) {
    const bf16* P = (const bf16*)(F.ws + WS_P); unsigned char* tb = F.ws + WS_TAB + (size_t)l * TAB_LAYER;
    LAS float* T = (LAS float*)(F.lds + F.wave * 10240);
    float* SS = (float*)(F.ws + WS_SS);
    const int gw = F.vcu * NWAVES + F.wave, NGW = F.G * NWAVES;
    for (int wu = gw; wu < 4 * 32 * 64; wu += NGW) { const int g = wu & 63, c = (wu >> 6) & 31, b = wu >> 11;
        s5_unit<0>(T, F.lane, P, (size_t)b * TP + 64 * c, g, (const float*)(tb + TB_ABAR), (const bf16*)(tb + TB_BBT), (const bf16*)(tb + TB_CMT), nullptr,
                   SS + (((size_t)b * 32 + c) * 64 + g) * 128, nullptr, nullptr, nullptr, nullptr, nullptr); }
}
__device__ __forceinline__ void s5_phaseD(Frame& F, int l) {
    const bf16* P = (const bf16*)(F.ws + WS_P); unsigned char* tb = F.ws + WS_TAB + (size_t)l * TAB_LAYER;
    LAS float* T = (LAS float*)(F.lds + F.wave * 10240);
    float* SS = (float*)(F.ws + WS_SS); bf16* YG = (bf16*)(F.ws + WS_YG); const float* dsk = inp(F, 17) + (size_t)l * 1024;
    const int gw = F.vcu * NWAVES + F.wave, NGW = F.G * NWAVES;
    for (int wu = gw; wu < 4 * 32 * 64; wu += NGW) { const int g = wu & 63, c = (wu >> 6) & 31, b = wu >> 11;
        float* ore = (c == 31) ? F.out + OUT_S5RE_P + (((size_t)l * 4 + b) * 64 + g) * 64 : nullptr; float* oim = (c == 31) ? F.out + OUT_S5IM_P + (((size_t)l * 4 + b) * 64 + g) * 64 : nullptr;
        s5_unit<1>(T, F.lane, P, (size_t)b * TP + 64 * c, g, (const float*)(tb + TB_ABAR), (const bf16*)(tb + TB_BBT), (const bf16*)(tb + TB_CMT), dsk,
                   SS + (((size_t)b * 32 + c) * 64 + g) * 128, nullptr, nullptr, ore, oim, YG); }
    for (int wu = gw; wu < 16 * 64; wu += NGW) { const int g = wu & 63, bg = wu >> 6; const size_t so = (((size_t)l * 128 + 8 * bg) * 64 + g) * 64;
        s5_unit<2>(T, F.lane, P, (size_t)MP + 64 * bg, g, (const float*)(tb + TB_ABAR), (const bf16*)(tb + TB_BBT), (const bf16*)(tb + TB_CMT), dsk,
                   nullptr, inp(F, 4) + so, inp(F, 5) + so, F.out + OUT_S5RE_S + so, F.out + OUT_S5IM_S + so, YG); }
}

__device__ __forceinline__ void ln_phase(Frame& F, int l) {
    const float* H2 = (const float*)(F.ws + WS_H2); float* XO = F.out + OUT_Y; bf16* XB = (bf16*)(F.ws + WS_XB);
    const float* lg = inp(F, 33) + (size_t)l * D; const float* lb = inp(F, 34) + (size_t)l * D;
    const int gw = F.vcu * NWAVES + F.wave, NGW = F.G * NWAVES;
#if defined(DIAG_CHECK)
    const float dscale = diag_scale(F);
#endif
    for (int m = gw; m < M; m += NGW) {
        const f32x4* xr = (const f32x4*)(H2 + (size_t)m * D) + F.lane;
        f32x4 v[8]; float s = 0.f;
#pragma unroll
        for (int j = 0; j < 8; ++j) { v[j] = xr[64 * j]; s += (v[j][0] + v[j][1]) + (v[j][2] + v[j][3]); }
        const float mean = wave_sum(s) * (1.f / D); float s2 = 0.f;
#pragma unroll
        for (int j = 0; j < 8; ++j) { v[j] = v[j] - mean; s2 += (v[j][0] * v[j][0] + v[j][1] * v[j][1]) + (v[j][2] * v[j][2] + v[j][3] * v[j][3]); }
        const float rstd = 1.f / sqrtf(wave_sum(s2) * (1.f / D) + LN_EPS);
#pragma unroll
        for (int j = 0; j < 8; ++j) { const int c = 4 * F.lane + 256 * j; const f32x4 y = v[j] * rstd * *(const f32x4*)(lg + c) + *(const f32x4*)(lb + c);
            { f32x4 yo = y;
#if defined(DIAG_CHECK)
              if (l == NLAYER - 1) yo = y * dscale;
#endif
              *(f32x4*)(XO + (size_t)m * D + c) = yo; }
            *(v2u*)(XB + (size_t)m * D + c) = (v2u){cvtpk(y[0], y[1]), cvtpk(y[2], y[3])}; }
    }
}

struct Args { const float* in[35]; float* out; unsigned char* ws; int ph_lo, ph_hi, li, pad; };
__global__ void __launch_bounds__(NWAVES * 64, 2) mega_fwd(Args args) {
    extern __shared__ __attribute__((aligned(16))) unsigned char lds[];
    Frame F;
    F.lds = (LAS unsigned char*)lds;
    F.tid = threadIdx.x; F.lane = F.tid & 63; F.wave = __builtin_amdgcn_readfirstlane(F.tid >> 6);
    F.G = gridDim.x; { const int bx = blockIdx.x; F.vcu = (F.G % 8 == 0) ? (bx % 8) * (F.G / 8) + bx / 8 : bx; }
    F.ws = args.ws; F.out = args.out; F.ctl = (gu32*)(args.ws + WS_CTL);
    for (int u = F.tid; u < (LDS_BYTES - LDSCTL_OFF) / 4; u += NWAVES * 64) ((LAS unsigned*)(F.lds + LDSCTL_OFF))[u] = 0u;
    __syncthreads();
    if (F.tid < 35) ((LAS unsigned long long*)(F.lds + PTAB_OFF))[F.tid] = (unsigned long long)args.in[F.tid];
    __syncthreads();
    XcdBarrier bar = xcd_barrier_post((unsigned*)(F.ctl + CW_BAR) + args.li * XCD_BAR_WORDS, (volatile LAS unsigned*)(F.lds + MISC_OFF) + 8);
    const int lo = args.ph_lo, hi = args.ph_hi;
#define IN(k) (lo <= (k) && (k) < hi)
#define SEAM(k) do { if (IN(k) && IN((k) + 1)) xcd_barrier(bar); } while (0)

#ifndef PH_EN
#define PH_EN 0xFFFF
#endif
#define EN(b) ((PH_EN >> (b)) & 1)
#define RELAUNDER() do { int t_ = threadIdx.x; asm volatile("" : "+v"(t_)); F.tid = t_; F.lane = t_ & 63; } while (0)
    if (EN(0) && IN(0)) { p0_prologue(F); }
    SEAM(0);
#pragma unroll 1
    for (int l = 0; l < NLAYER; ++l) {
        const int pb = 1 + NPH_LAYER * l;
        const bf16* wt = (const bf16*)(F.ws + WS_WT + (size_t)l * WT_LAYER);
        bf16* P = (bf16*)(F.ws + WS_P);
        if (EN(1) && IN(pb + 0)) {
            RELAUNDER(); alow_phase(F, l);
            pg8::Gemm g{(const bf16*)(F.ws + WS_XB), wt + WO_WIN, M, LDP, D}; pg8::StaticOrder S; S.init(M, LDP, F.G, (int)blockIdx.x);
            pg8::EpiProj E{P, LDP, inp(F, 9) + (size_t)l * NIN_SRC};
            pg8::gemm_phase<pg8::EpiProj, pg8::StaticOrder, true, true>(F.lds, g, S, E);
        }
        SEAM(pb + 0);
        if (IN(pb + 1)) { RELAUNDER();
#if defined(DIAG_CHECK)
            if (l == 0) diag_gemm1(F);
#endif
            if (EN(2)) s5_phaseB(F, l); __syncthreads(); RELAUNDER(); if (EN(3)) gla_phaseB(F, l); }
        SEAM(pb + 1);
        if (IN(pb + 2)) { RELAUNDER(); if (EN(4)) scans_phaseC(F, l); RELAUNDER(); if (EN(5)) conv_phaseC(F, l); }
        SEAM(pb + 2);
        if (IN(pb + 3)) { RELAUNDER(); if (EN(6)) s5_phaseD(F, l);
#if defined(DIAG_CHECK)
            diag_s5s(F, l);
#endif
            __syncthreads(); RELAUNDER(); if (EN(7)) gla_phaseD(F, l); }
        SEAM(pb + 3);
        if (EN(8) && IN(pb + 4)) {
#ifndef NO_GLU
            { pg8::Gemm g{(const bf16*)(F.ws + WS_YG), wt + WO_WGLU, M, 1024, 1024}; pg8::StaticOrder S; S.init(M, 1024, F.G, (int)blockIdx.x);
              pg8::EpiGlu E{(bf16*)(F.ws + WS_AS), inp(F, 19) + (size_t)l * 1024, (const bf16*)(F.ws + WS_YG), P, LDP};
              pg8::gemm_phase<pg8::EpiGlu, pg8::StaticOrder, true, true>(F.lds, g, S, E); }
#endif
#ifndef NO_PE
            { int kpe = 256; asm volatile("" : "+s"(kpe));
              pg8::Gemm g{(const bf16*)(F.ws + WS_PB) + (size_t)l * M * 256, wt + WO_WPE, M, D, kpe}; pg8::StaticOrder S; S.init(M, D, F.G, (int)((blockIdx.x + 112) % F.G));
              pg8::EpiPlain E{(bf16*)(F.ws + WS_PE), D};
              pg8::gemm_phase<pg8::EpiPlain, pg8::StaticOrder, true, true>(F.lds, g, S, E); }
#endif
        }
        SEAM(pb + 4);
        if (EN(9) && IN(pb + 5)) {
            pg8::StaticOrder S; S.init(M, D, F.G, (int)blockIdx.x);
            { pg8::Gemm g{(const bf16*)(F.ws + WS_AS), wt + WO_PS5, M, D, 1024}; pg8::EpiBranch<0> E{(float*)(F.ws + WS_OSUM), (bf16*)(F.ws + WS_OSB), P, LDP};
              pg8::gemm_phase<pg8::EpiBranch<0>, pg8::StaticOrder, true, true>(F.lds, g, S, E); }
            { pg8::Gemm g{(const bf16*)(F.ws + WS_AG), wt + WO_PGLA, M, D, 1024}; pg8::EpiBranch<1> E{(float*)(F.ws + WS_OSUM), (bf16*)(F.ws + WS_OSB), P, LDP};
              pg8::gemm_phase<pg8::EpiBranch<1>, pg8::StaticOrder, true, true>(F.lds, g, S, E); }
            { pg8::Gemm g{(const bf16*)(F.ws + WS_AC), wt + WO_PCONV, M, D, 1024}; pg8::EpiBranch<2> E{(float*)(F.ws + WS_OSUM), (bf16*)(F.ws + WS_OSB), P, LDP};
              pg8::gemm_phase<pg8::EpiBranch<2>, pg8::StaticOrder, true, true>(F.lds, g, S, E); }
        }
        SEAM(pb + 5);
        if (EN(10) && IN(pb + 6)) {
            pg8::Gemm g{(const bf16*)(F.ws + WS_OSB), wt + WO_WO, M, D, D}; pg8::StaticOrder S; S.init(M, D, F.G, (int)blockIdx.x);
            const float* xp = (l == 0) ? inp(F, 0) : F.out + OUT_Y; const float* xs = (l == 0) ? inp(F, 1) : F.out + OUT_Y + (size_t)MP * D;
            pg8::EpiWo E{(float*)(F.ws + WS_H32), (bf16*)(F.ws + WS_HB), xp, xs, DN_ALPHA};
            pg8::gemm_phase<pg8::EpiWo, pg8::StaticOrder, true, true>(F.lds, g, S, E);
        }
        SEAM(pb + 6);
        if (EN(11) && IN(pb + 7)) {
            pg8::Gemm g{(const bf16*)(F.ws + WS_HB), wt + WO_WPG, M, D, D}; pg8::StaticOrder S; S.init(M, D, F.G, (int)blockIdx.x);
            pg8::EpiWpg E{(float*)(F.ws + WS_H2), (const float*)(F.ws + WS_H32), (const bf16*)(F.ws + WS_PE)};
            pg8::gemm_phase<pg8::EpiWpg, pg8::StaticOrder, true, true>(F.lds, g, S, E);
        }
        SEAM(pb + 7);
        if (EN(12) && IN(pb + 8)) { RELAUNDER(); ln_phase(F, l); }
        SEAM(pb + 8);
    }
#undef IN
#undef SEAM
}

#ifndef MK_SPLIT
#define MK_SPLIT 1
#endif
extern "C" void kernel_launch(void* const* d_in, const int* in_sizes, int n_in, void* d_out, int out_size, void* d_ws, size_t ws_size, hipStream_t stream) {
    static int grid = 0;
    if (grid == 0) {
        if (n_in != 35 || (size_t)out_size != OUT_TOTAL || ws_size < WS_END) { fprintf(stderr, "kernel_launch: unexpected shapes: n_in %d out %d ws %zu (need %zu)\n", n_in, out_size, ws_size, (size_t)WS_END); grid = -1; return; }
        int dev = 0, cus = 0, per_cu = 0;
        if (hipGetDevice(&dev) != hipSuccess || hipDeviceGetAttribute(&cus, hipDeviceAttributeMultiprocessorCount, dev) != hipSuccess) { grid = -1; return; }
        if (hipFuncSetAttribute((const void*)mega_fwd, hipFuncAttributeMaxDynamicSharedMemorySize, LDS_BYTES) != hipSuccess) { fprintf(stderr, "kernel_launch: hipFuncSetAttribute failed\n"); grid = -1; return; }
        if (hipOccupancyMaxActiveBlocksPerMultiprocessor(&per_cu, (const void*)mega_fwd, NWAVES * 64, LDS_BYTES) != hipSuccess || per_cu < 1) fprintf(stderr, "kernel_launch: occupancy query reports %d\n", per_cu);
        (void)hipGetLastError();
        grid = cus;
    }
    if (grid < 0) return;
    (void)hipMemsetAsync((char*)d_ws + WS_CTL, 0, CTL_ZERO_BYTES, stream);
    Args a; memset(&a, 0, sizeof(a));
    for (int i = 0; i < 35; ++i) a.in[i] = (const float*)d_in[i];
    a.out = (float*)d_out; a.ws = (unsigned char*)d_ws;
#if MK_SPLIT
    for (int ph = 0; ph < NPHASE; ++ph) { a.ph_lo = ph; a.ph_hi = ph + 1; a.li = 0; hipLaunchKernelGGL(mega_fwd, dim3(grid), dim3(NWAVES * 64), LDS_BYTES, stream, a); }
#else
    a.ph_lo = 0; a.ph_hi = NPHASE; a.li = 0;
    hipLaunchKernelGGL(mega_fwd, dim3(grid), dim3(NWAVES * 64), LDS_BYTES, stream, a);
#endif
}
```

```cpp
#include <hip/hip_runtime.h>
#include <cstdio>
#include <cstdint>
#include <cstring>
#define DIAG_SGN(eps, k) (1.0f + (((k) & 1) ? (eps) : -(eps)))
#define DIAG_S5P 0.0f
#define DIAG_S5S 0.0f
#define MK_SPLIT 0
namespace pg8 {
#define PG8_LAS __attribute__((address_space(3)))
typedef unsigned short bf16_t;
typedef short bf16x8 __attribute__((ext_vector_type(8)));
typedef float f32x4 __attribute__((ext_vector_type(4)));
typedef unsigned u32x4 __attribute__((ext_vector_type(4)));
constexpr int BM = 256, BK = 64, HALF = 128, HTB = HALF * BK * 2  , STAGE_BYTES = 8 * HTB, NXCD = 8, WGM = 8;

__host__ __device__ __forceinline__ int lds_byte(int r, int c) { const int st = (r >> 4) * 2 + (c >> 5), rr = r & 15, cc = c & 31, ob = rr * 64 + cc * 2; return st * 1024 + (ob ^ (((ob >> 9) & 1) << 5)); }
__host__ __device__ __forceinline__ void stage_rc(int b, int& R, int& C) { const int st = b / 1024, sb = b % 1024, swz = sb ^ (((sb >> 9) & 1) << 5); R = (st >> 1) * 16 + swz / 64; C = (st & 1) * 32 + (swz % 64) / 2; }
__host__ __device__ __forceinline__ int perm32(int rho) { const int n = rho >> 4, i = rho & 15; return 8 * (i >> 2) + 4 * n + (i & 3); }

struct Unit { int pm, pn; };
struct Gemm { const bf16_t* A; const bf16_t* Bt; int M, N, K; };

struct StaticOrder {
    int nM, nN, nwg, G, c;
    __host__ __device__ void init(int M, int N, int G_, int c_) { nM = M / BM; nN = N / BM; nwg = nM * nN; G = G_; c = c_; }
    __host__ __device__ bool next(int i, Unit& u) const { return at((long)i * G + c, u); }
    __host__ __device__ bool at(long L, Unit& u) const {
        if (L >= nwg) return false;
        int wgid = (int)L; { const int q = nwg / NXCD, r = nwg % NXCD, xcd = wgid % NXCD, off = wgid / NXCD; wgid = (xcd < r ? xcd * (q + 1) : r * (q + 1) + (xcd - r) * q) + off; }
        const int nig = WGM * nN, gid = wgid / nig, fm = gid * WGM, gsz = (nM - fm) < WGM ? (nM - fm) : WGM;
        u.pm = fm + ((wgid % nig) % gsz); u.pn = (wgid % nig) / gsz; return true;
    }
    __device__ __forceinline__ void a_ready(const Unit&) const {}
    __device__ __forceinline__ void done(const Unit&) const {}
};
__device__ __forceinline__ unsigned cvt_pk_bf16(float lo, float hi) { unsigned r; asm volatile("v_cvt_pk_bf16_f32 %0, %1, %2" : "=v"(r) : "v"(lo), "v"(hi)); return r; }
typedef float f32x2 __attribute__((ext_vector_type(2)));
typedef unsigned u32x2 __attribute__((ext_vector_type(2)));
__device__ __forceinline__ float sigm(float x) { return __builtin_amdgcn_rcpf(1.0f + __builtin_amdgcn_exp2f(-1.4426950408889634f * x)); }
__device__ __forceinline__ float silu_f(float x) { return x * sigm(x); }
__device__ __forceinline__ float bflo(unsigned u) { return __uint_as_float(u << 16); }
__device__ __forceinline__ float bfhi(unsigned u) { return __uint_as_float(u & 0xffff0000u); }
__device__ __forceinline__ void unpack8(const u32x4 w, f32x4& a, f32x4& b) { a = (f32x4){bflo(w.x), bfhi(w.x), bflo(w.y), bfhi(w.y)}; b = (f32x4){bflo(w.z), bfhi(w.z), bflo(w.w), bfhi(w.w)}; }
__device__ __forceinline__ u32x4 pack8(const f32x4 a, const f32x4 b) { u32x4 w; w.x = cvt_pk_bf16(a[0], a[1]); w.y = cvt_pk_bf16(a[2], a[3]); w.z = cvt_pk_bf16(b[0], b[1]); w.w = cvt_pk_bf16(b[2], b[3]); return w; }
__device__ __forceinline__ f32x4 sigm4(f32x4 v) { return (f32x4){sigm(v[0]), sigm(v[1]), sigm(v[2]), sigm(v[3])}; }
__device__ __forceinline__ f32x4 silu4(f32x4 v) { return (f32x4){silu_f(v[0]), silu_f(v[1]), silu_f(v[2]), silu_f(v[3])}; }

#define EPI_LOOP_BEGIN \
    const int row0 = u.pm * BM + wr * 64 + fr, col0 = u.pn * BM + wc * 32 + 8 * fq; \
    _Pragma("unroll") for (int ai = 0; ai < 2; ++ai) _Pragma("unroll") for (int m = 0; m < 4; ++m) { const size_t row = (size_t)(row0 + ai * HALF + m * 16); \
    _Pragma("unroll") for (int bj = 0; bj < 2; ++bj) { const int col = col0 + bj * HALF; f32x4 v0 = acc[ai][bj][m][0], v1 = acc[ai][bj][m][1];
#define EPI_LOOP_END } asm volatile("" ::: "memory"); }

struct EpiProj {
    static constexpr bool PERM = true, AFTER_DRAIN = false;
    bf16_t* O; int ldc; const float* bias;
    __device__ __forceinline__ void operator()(const f32x4 (&acc)[2][2][4][2], const Unit& u, int wr, int wc, int fr, int fq) const {
        const int pn = u.pn;
        int act = 0;
        if ((pn >= 4 && pn < 8) || (pn >= 16 && pn < 20) || (pn >= 28 && pn < 32)) act = 1;
        if ((pn >= 24 && pn < 28) || pn >= 32) act = 2;
        const int boff = (pn >= 16) ? 16 : 0;
        f32x4 bv[2][2];
        { const int c0 = u.pn * BM + wc * 32 + 8 * fq + boff;
#pragma unroll
          for (int bj = 0; bj < 2; ++bj)
#pragma unroll
              for (int n = 0; n < 2; ++n) bv[bj][n] = *(const f32x4*)(bias + c0 + bj * HALF + 4 * n); }
        EPI_LOOP_BEGIN
            v0 = v0 + bv[bj][0]; v1 = v1 + bv[bj][1];
            if (act == 1) { v0 = silu4(v0); v1 = silu4(v1); }
            else if (act == 2) { v0 = sigm4(v0); v1 = sigm4(v1); }
            *(u32x4*)(O + row * ldc + col) = pack8(v0, v1);
        EPI_LOOP_END
    }
};
struct EpiPlain {
    static constexpr bool PERM = true, AFTER_DRAIN = false;
    bf16_t* O; int ldc;
    __device__ __forceinline__ void operator()(const f32x4 (&acc)[2][2][4][2], const Unit& u, int wr, int wc, int fr, int fq) const {
        EPI_LOOP_BEGIN
            *(u32x4*)(O + row * ldc + col) = pack8(v0, v1);
        EPI_LOOP_END
    }
};
struct EpiGlu {
    static constexpr bool PERM = true, AFTER_DRAIN = false;
    bf16_t* O; const float* bias; const bf16_t* YG; const bf16_t* P; int ldp;
    __device__ __forceinline__ void operator()(const f32x4 (&acc)[2][2][4][2], const Unit& u, int wr, int wc, int fr, int fq) const {
        const int row0 = u.pm * BM + wr * 64 + fr, col0 = u.pn * BM + wc * 32 + 8 * fq;
#pragma unroll
        for (int ai = 0; ai < 2; ++ai)
#pragma unroll
          for (int mg = 0; mg < 4; mg += 2) { u32x4 yv[2][2], zv[2][2];
#pragma unroll
            for (int mm = 0; mm < 2; ++mm)
#pragma unroll
                for (int bj = 0; bj < 2; ++bj) { const size_t row = (size_t)(row0 + ai * HALF + (mg + mm) * 16); const int col = col0 + bj * HALF; yv[mm][bj] = *(const u32x4*)(YG + row * 1024 + col); zv[mm][bj] = *(const u32x4*)(P + row * ldp + 1024 + col); }
#pragma unroll
            for (int mm = 0; mm < 2; ++mm)
#pragma unroll
                for (int bj = 0; bj < 2; ++bj) { const size_t row = (size_t)(row0 + ai * HALF + (mg + mm) * 16); const int col = col0 + bj * HALF; f32x4 y0, y1, z0, z1; unpack8(yv[mm][bj], y0, y1); unpack8(zv[mm][bj], z0, z1);
                    const f32x4 v0 = y0 * sigm4(acc[ai][bj][mg + mm][0] + *(const f32x4*)(bias + col)) * z0, v1 = y1 * sigm4(acc[ai][bj][mg + mm][1] + *(const f32x4*)(bias + col + 4)) * z1;
                    *(u32x4*)(O + row * 1024 + col) = pack8(v0, v1); }
            asm volatile("" ::: "memory"); }
    }
};
template <int B> struct EpiBranchPart {
    static constexpr bool PERM = true, AFTER_DRAIN = false;
    bf16_t* OB; const bf16_t* P; int ldp;
    __device__ __forceinline__ void operator()(const f32x4 (&acc)[2][2][4][2], const Unit& u, int wr, int wc, int fr, int fq) const {
        const int row0 = u.pm * BM + wr * 64 + fr, col0 = u.pn * BM + wc * 32 + 8 * fq;
#pragma unroll
        for (int ai = 0; ai < 2; ++ai) { u32x4 gv[4][2];
#pragma unroll
            for (int m = 0; m < 4; ++m)
#pragma unroll
                for (int bj = 0; bj < 2; ++bj) { const size_t row = (size_t)(row0 + ai * HALF + m * 16); const int col = col0 + bj * HALF; gv[m][bj] = *(const u32x4*)(P + row * ldp + 8192 + 2048 * B + col); }
#pragma unroll
            for (int m = 0; m < 4; ++m)
#pragma unroll
                for (int bj = 0; bj < 2; ++bj) { const size_t row = (size_t)(row0 + ai * HALF + m * 16); const int col = col0 + bj * HALF; f32x4 g0, g1; unpack8(gv[m][bj], g0, g1);
                    *(u32x4*)(OB + row * 2048 + col) = pack8(acc[ai][bj][m][0] * g0, acc[ai][bj][m][1] * g1); }
            asm volatile("" ::: "memory"); }
    }
};
struct EpiBranchFinal {
    static constexpr bool PERM = true, AFTER_DRAIN = false;
    bf16_t* OSB; const bf16_t* OG; const bf16_t* OC; const bf16_t* P; int ldp;
    __device__ __forceinline__ void operator()(const f32x4 (&acc)[2][2][4][2], const Unit& u, int wr, int wc, int fr, int fq) const {
        const int row0 = u.pm * BM + wr * 64 + fr, col0 = u.pn * BM + wc * 32 + 8 * fq;
#pragma unroll
        for (int ai = 0; ai < 2; ++ai)
#pragma unroll
          for (int mg = 0; mg < 4; mg += 2) { u32x4 gv[2][2], av[2][2], cv[2][2];
#pragma unroll
            for (int mm = 0; mm < 2; ++mm)
#pragma unroll
                for (int bj = 0; bj < 2; ++bj) { const size_t row = (size_t)(row0 + ai * HALF + (mg + mm) * 16); const int col = col0 + bj * HALF;
                    gv[mm][bj] = *(const u32x4*)(P + row * ldp + 8192 + col); av[mm][bj] = *(const u32x4*)(OG + row * 2048 + col); cv[mm][bj] = *(const u32x4*)(OC + row * 2048 + col); }
#pragma unroll
            for (int mm = 0; mm < 2; ++mm)
#pragma unroll
                for (int bj = 0; bj < 2; ++bj) { const size_t row = (size_t)(row0 + ai * HALF + (mg + mm) * 16); const int col = col0 + bj * HALF; f32x4 g0, g1, a0, a1, c0, c1;
                    unpack8(gv[mm][bj], g0, g1); unpack8(av[mm][bj], a0, a1); unpack8(cv[mm][bj], c0, c1);
                    *(u32x4*)(OSB + row * 2048 + col) = pack8(acc[ai][bj][mg + mm][0] * g0 + a0 + c0, acc[ai][bj][mg + mm][1] * g1 + a1 + c1); }
            asm volatile("" ::: "memory"); }
    }
};
struct EpiWo {
    static constexpr bool PERM = true, AFTER_DRAIN = false;
    bf16_t* HB; const bf16_t* XB; float alpha;
    __device__ __forceinline__ void operator()(const f32x4 (&acc)[2][2][4][2], const Unit& u, int wr, int wc, int fr, int fq) const {
        const int row0 = u.pm * BM + wr * 64 + fr, col0 = u.pn * BM + wc * 32 + 8 * fq;
#pragma unroll
        for (int ai = 0; ai < 2; ++ai) { u32x4 xv[4][2];
#pragma unroll
            for (int m = 0; m < 4; ++m)
#pragma unroll
                for (int bj = 0; bj < 2; ++bj) { const size_t row = (size_t)(row0 + ai * HALF + m * 16); const int col = col0 + bj * HALF; xv[m][bj] = *(const u32x4*)(XB + row * 2048 + col); }
#pragma unroll
            for (int m = 0; m < 4; ++m)
#pragma unroll
                for (int bj = 0; bj < 2; ++bj) { const size_t row = (size_t)(row0 + ai * HALF + m * 16); const int col = col0 + bj * HALF; f32x4 x0, x1; unpack8(xv[m][bj], x0, x1);
                    const f32x4 v0 = acc[ai][bj][m][0] + alpha * x0, v1 = acc[ai][bj][m][1] + alpha * x1;
                    *(u32x4*)(HB + row * 2048 + col) = pack8(v0, v1); }
            asm volatile("" ::: "memory"); }
    }
};
struct EpiWpg {
    static constexpr bool PERM = true, AFTER_DRAIN = false;
    bf16_t* H2; const bf16_t* HB; const bf16_t* PE;
    __device__ __forceinline__ void operator()(const f32x4 (&acc)[2][2][4][2], const Unit& u, int wr, int wc, int fr, int fq) const {
        const int row0 = u.pm * BM + wr * 64 + fr, col0 = u.pn * BM + wc * 32 + 8 * fq;
#pragma unroll
        for (int ai = 0; ai < 2; ++ai)
#pragma unroll
          for (int mg = 0; mg < 4; mg += 2) { u32x4 hv[2][2]; u32x4 pv[2][2];
#pragma unroll
            for (int mm = 0; mm < 2; ++mm)
#pragma unroll
                for (int bj = 0; bj < 2; ++bj) { const size_t row = (size_t)(row0 + ai * HALF + (mg + mm) * 16); const int col = col0 + bj * HALF;
                    hv[mm][bj] = *(const u32x4*)(HB + row * 2048 + col); pv[mm][bj] = *(const u32x4*)(PE + row * 2048 + col); }
#pragma unroll
            for (int mm = 0; mm < 2; ++mm)
#pragma unroll
                for (int bj = 0; bj < 2; ++bj) { const size_t row = (size_t)(row0 + ai * HALF + (mg + mm) * 16); const int col = col0 + bj * HALF; f32x4 p0, p1, h0, h1; unpack8(pv[mm][bj], p0, p1); unpack8(hv[mm][bj], h0, h1);
                    *(u32x4*)(H2 + row * 2048 + col) = pack8(h0 + sigm4(acc[ai][bj][mg + mm][0]) * p0, h1 + sigm4(acc[ai][bj][mg + mm][1]) * p1); }
            asm volatile("" ::: "memory"); }
    }
};

__device__ __forceinline__ void late_tile(int t, Unit& u) { const int j = t & 31; u.pm = (t < 32 ? 28 : 32) + (j & 3); u.pn = j >> 2; }
struct PickSched {
    StaticOrder so; int i0, i1, i2, n;
    __device__ void init(int M, int N, int a, int b, int c3, int n_) { so.init(M, N, 1, 0); i0 = a; i1 = b; i2 = c3; n = n_; }
    __device__ bool next(int i, Unit& u) const { if (i >= n) return false; return so.at(i == 0 ? i0 : (i == 1 ? i1 : i2), u); }
    __device__ __forceinline__ void a_ready(const Unit&) const {}
    __device__ __forceinline__ void done(const Unit&) const {}
};
struct OneTile {
    StaticOrder so; int late;
    __device__ void init_e(int N, int G_, int c_) { so.init(28 * 256, N, G_ - 32, c_ - 32); late = -1; }
    __device__ void init_late(int t) { so.init(256, 256, 1, 0); late = t; }
    __device__ bool next(int i, Unit& u) const { if (i != 0) return false; if (late >= 0) { late_tile(late, u); return true; } return so.next(0, u); }
    __device__ __forceinline__ void a_ready(const Unit&) const {}
    __device__ __forceinline__ void done(const Unit&) const {}
};
template <class Epi, class Sched, bool ALIGN_EPI = false, bool SP2 = false>
__device__ __forceinline__ void gemm_phase(PG8_LAS unsigned char* lds, const Gemm g, const Sched& S, const Epi& E) {
    int tid_l = threadIdx.x; asm volatile("" : "+v"(tid_l));
    const int tid = tid_l, wid = __builtin_amdgcn_readfirstlane(tid >> 6), lane = tid & 63, wr = wid >> 2, wc = wid & 3, fr = lane & 15, fq = lane >> 4;
    const int K = g.K, nt = K / BK;
    unsigned voffA[2], voffB[2];
#pragma unroll
    for (int i = 0; i < 2; ++i) { int R, C; stage_rc(tid * 16 + i * 8192, R, C); const int Rb = Epi::PERM ? ((R & ~31) + perm32(R & 31)) : R;
        voffA[i] = (unsigned)(R * K + C) * 2u; voffB[i] = (unsigned)(Rb * K + C) * 2u; }
    const size_t kstep = (size_t)(BK * 2);
    const size_t hstep = (size_t)HALF * K * 2;
    const size_t tstep = 2 * hstep;
    const unsigned ldsw = (unsigned)wid * 1024u;
    const int aoff = lds_byte(wr * 64 + fr, fq * 8), boff = lds_byte(wc * 32 + fr, fq * 8);
#define PG8_SA(b, h) (((b) * 2 + (h)) * HTB)
#define PG8_SB(b, h) ((4 + (b) * 2 + (h)) * HTB)
#define PG8_STAGE(bufoff, gbase, voff) do { _Pragma("unroll") for (int _i = 0; _i < 2; ++_i) \
        __builtin_amdgcn_global_load_lds((const unsigned*)((const char*)(gbase) + (voff)[_i]), (PG8_LAS unsigned*)(lds + (bufoff) + ldsw + _i * 8192), 16, 0, 0); } while (0)
#define PG8_LDA(dst, b, h) do { _Pragma("unroll") for (int m = 0; m < 4; ++m) _Pragma("unroll") for (int k = 0; k < 2; ++k) dst[m][k] = *(const PG8_LAS bf16x8*)(lds + PG8_SA(b, h) + aoff + m * 2048 + k * 1024); } while (0)
#define PG8_LDB(dst, b, h) do { _Pragma("unroll") for (int n = 0; n < 2; ++n) _Pragma("unroll") for (int k = 0; k < 2; ++k) dst[n][k] = *(const PG8_LAS bf16x8*)(lds + PG8_SB(b, h) + boff + n * 2048 + k * 1024); } while (0)
#define PG8_MMA(ai, bj, At, Bt) do { __builtin_amdgcn_s_setprio(1); _Pragma("unroll") for (int m = 0; m < 4; ++m) _Pragma("unroll") for (int n = 0; n < 2; ++n) _Pragma("unroll") for (int k = 0; k < 2; ++k) \
        acc[ai][bj][m][n] = __builtin_amdgcn_mfma_f32_16x16x32_bf16(Bt[n][k], At[m][k], acc[ai][bj][m][n], 0, 0, 0); __builtin_amdgcn_s_setprio(0); } while (0)
#define PG8_WAIT_V(n) asm volatile("s_waitcnt vmcnt(" #n ")" ::: "memory")
#define PG8_WAIT_L(n) asm volatile("s_waitcnt lgkmcnt(" #n ")" ::: "memory")
#define PG8_BAR __builtin_amdgcn_s_barrier()
#define PG8_SCHED __builtin_amdgcn_sched_barrier(0)
    Unit cur, nxt; int ui = 0;
    if (!S.next(0, cur)) return;
    f32x4 acc[2][2][4][2];
#pragma unroll
    for (int a = 0; a < 2; ++a)
#pragma unroll
        for (int b = 0; b < 2; ++b)
#pragma unroll
            for (int m = 0; m < 4; ++m)
#pragma unroll
                for (int n = 0; n < 2; ++n) acc[a][b][m][n] = (f32x4){0.f, 0.f, 0.f, 0.f};
    bf16x8 At[4][2], B0[2][2], B1[2][2];
    const char* cA = (const char*)g.A + (size_t)cur.pm * tstep; const char* cB = (const char*)g.Bt + (size_t)cur.pn * tstep;
    S.a_ready(cur);
    if constexpr (SP2) {
        PG8_STAGE(PG8_SB(0, 0), cB, voffB); PG8_STAGE(PG8_SB(0, 1), cB + hstep, voffB); PG8_STAGE(PG8_SA(0, 0), cA, voffA); PG8_STAGE(PG8_SA(0, 1), cA + hstep, voffA);
        if (wr == 1) PG8_BAR;
        PG8_WAIT_V(2); PG8_BAR;
        PG8_STAGE(PG8_SB(1, 0), cB + kstep, voffB); PG8_STAGE(PG8_SA(1, 0), cA + kstep, voffA); PG8_STAGE(PG8_SB(1, 1), cB + hstep + kstep, voffB);
        PG8_WAIT_V(6); PG8_BAR;
    } else {
        PG8_STAGE(PG8_SB(0, 0), cB, voffB); PG8_STAGE(PG8_SA(0, 0), cA, voffA); PG8_STAGE(PG8_SB(0, 1), cB + hstep, voffB); PG8_STAGE(PG8_SA(0, 1), cA + hstep, voffA);
        if (wr == 1) PG8_BAR;
        PG8_WAIT_V(4); PG8_BAR;
        PG8_STAGE(PG8_SB(1, 0), cB + kstep, voffB); PG8_STAGE(PG8_SA(1, 0), cA + kstep, voffA); PG8_STAGE(PG8_SB(1, 1), cB + hstep + kstep, voffB);
        PG8_WAIT_V(6); PG8_BAR;
    }
    for (;;) {
        const bool has_next = S.next(ui + 1, nxt);
        const char* nA = has_next ? (const char*)g.A + (size_t)nxt.pm * tstep : cA; const char* nB = has_next ? (const char*)g.Bt + (size_t)nxt.pn * tstep : cB;
        for (int t = 0; t < nt; t += 2) {
            const bool last = (t == nt - 2);
            const char* a1 = cA + (size_t)(t + 1) * kstep;
            const char* a2 = last ? nA : cA + (size_t)(t + 2) * kstep; const char* b2 = last ? nB : cB + (size_t)(t + 2) * kstep;
            const char* a3 = a2 + kstep; const char* b3 = b2 + kstep;
            if (last && has_next) S.a_ready(nxt);
            if constexpr (SP2) {
            PG8_LDB(B0, 0, 0); PG8_LDB(B1, 0, 1); PG8_SCHED; PG8_LDA(At, 0, 0); PG8_STAGE(PG8_SA(1, 1), a1 + hstep, voffA);
            PG8_WAIT_V(8); PG8_WAIT_L(0); PG8_BAR; PG8_MMA(0, 0, At, B0); PG8_MMA(0, 1, At, B1); PG8_BAR; PG8_SCHED;
            PG8_LDA(At, 0, 1); PG8_STAGE(PG8_SB(0, 0), b2, voffB); PG8_STAGE(PG8_SB(0, 1), b2 + hstep, voffB); PG8_STAGE(PG8_SA(0, 0), a2, voffA);
            PG8_WAIT_V(8); PG8_WAIT_L(0); PG8_BAR; PG8_MMA(1, 0, At, B0); PG8_MMA(1, 1, At, B1); PG8_BAR; PG8_SCHED;
            PG8_LDB(B0, 1, 0); PG8_LDB(B1, 1, 1); PG8_SCHED; PG8_LDA(At, 1, 0); PG8_STAGE(PG8_SA(0, 1), a2 + hstep, voffA);
            PG8_WAIT_V(8); PG8_WAIT_L(0); PG8_BAR; PG8_MMA(0, 0, At, B0); PG8_MMA(0, 1, At, B1); PG8_BAR; PG8_SCHED;
            PG8_LDA(At, 1, 1); PG8_STAGE(PG8_SB(1, 0), b3, voffB); PG8_STAGE(PG8_SB(1, 1), b3 + hstep, voffB); PG8_STAGE(PG8_SA(1, 0), a3, voffA);
            PG8_WAIT_V(8); PG8_WAIT_L(0); PG8_BAR; PG8_MMA(1, 0, At, B0); PG8_MMA(1, 1, At, B1); PG8_BAR; PG8_SCHED;
            } else {
            PG8_LDB(B0, 0, 0); PG8_SCHED; PG8_LDA(At, 0, 0); PG8_STAGE(PG8_SA(1, 1), a1 + hstep, voffA);
            PG8_WAIT_L(8); PG8_BAR; PG8_WAIT_L(0); PG8_MMA(0, 0, At, B0); PG8_BAR; PG8_SCHED;
            PG8_LDB(B1, 0, 1); PG8_STAGE(PG8_SB(0, 0), b2, voffB);
            PG8_BAR; PG8_WAIT_L(0); PG8_MMA(0, 1, At, B1); PG8_BAR;
            PG8_LDA(At, 0, 1); PG8_STAGE(PG8_SA(0, 0), a2, voffA);
            PG8_BAR; PG8_WAIT_L(0); PG8_MMA(1, 0, At, B0); PG8_BAR; PG8_SCHED;
            PG8_STAGE(PG8_SB(0, 1), b2 + hstep, voffB);
            PG8_WAIT_V(6); PG8_BAR; PG8_MMA(1, 1, At, B1); PG8_BAR;
            PG8_LDB(B0, 1, 0); PG8_SCHED; PG8_LDA(At, 1, 0); PG8_STAGE(PG8_SA(0, 1), a2 + hstep, voffA);
            PG8_WAIT_L(8); PG8_BAR; PG8_WAIT_L(0); PG8_MMA(0, 0, At, B0); PG8_BAR; PG8_SCHED;
            PG8_LDB(B1, 1, 1); PG8_STAGE(PG8_SB(1, 0), b3, voffB);
            PG8_BAR; PG8_WAIT_L(0); PG8_MMA(0, 1, At, B1); PG8_BAR;
            PG8_LDA(At, 1, 1); PG8_STAGE(PG8_SA(1, 0), a3, voffA);
            PG8_BAR; PG8_WAIT_L(0); PG8_MMA(1, 0, At, B0); PG8_BAR; PG8_SCHED;
            PG8_STAGE(PG8_SB(1, 1), b3 + hstep, voffB);
            PG8_WAIT_V(6); PG8_BAR; PG8_MMA(1, 1, At, B1); PG8_BAR;
            }
        }
        if constexpr (ALIGN_EPI) { if (wr == 0) PG8_BAR; }
        if constexpr (!Epi::AFTER_DRAIN) { E(acc, cur, wr, wc, fr, fq); S.done(cur); }
        if (!has_next) break;
#pragma unroll
        for (int a = 0; a < 2; ++a)
#pragma unroll
            for (int b = 0; b < 2; ++b)
#pragma unroll
                for (int m = 0; m < 4; ++m)
#pragma unroll
                    for (int n = 0; n < 2; ++n) acc[a][b][m][n] = (f32x4){0.f, 0.f, 0.f, 0.f};
        cur = nxt; cA = nA; cB = nB; ++ui;
        if constexpr (ALIGN_EPI) { if (wr == 1) PG8_BAR; }
    }
    PG8_WAIT_V(0);
    if constexpr (!ALIGN_EPI) { if (wr == 0) PG8_BAR; }
    PG8_BAR;
    if constexpr (Epi::AFTER_DRAIN) { E.fused(acc, cur, wr, wc, fr, fq, lds, wid, lane); S.done(cur); }
#undef PG8_SA
#undef PG8_SB
#undef PG8_STAGE
#undef PG8_LDA
#undef PG8_LDB
#undef PG8_MMA
#undef PG8_WAIT_V
#undef PG8_WAIT_L
#undef PG8_BAR
#undef PG8_SCHED
}
}
#define GAS __attribute__((address_space(1)))
#define LAS __attribute__((address_space(3)))
typedef unsigned short bf16;
typedef unsigned v4u __attribute__((ext_vector_type(4)));
typedef float f32x4 __attribute__((ext_vector_type(4)));
typedef short bf16x8 __attribute__((ext_vector_type(8)));
typedef GAS unsigned gu32;
typedef GAS unsigned long long gu64;
#define RLX_AGENT __ATOMIC_RELAXED, __HIP_MEMORY_SCOPE_AGENT
#define LDS_WAIT() asm volatile("s_waitcnt lgkmcnt(0)" ::: "memory")
#define VM_WAIT() asm volatile("s_waitcnt vmcnt(0)" ::: "memory")
__device__ __forceinline__ unsigned long long rt() { return __builtin_amdgcn_s_memrealtime(); }
__device__ __forceinline__ unsigned f2bf(float f) { unsigned u = __builtin_bit_cast(unsigned, f); return (u + 0x7fffu + ((u >> 16) & 1u)) >> 16; }
__device__ __forceinline__ unsigned pk2(float lo, float hi) { return f2bf(lo) | (f2bf(hi) << 16); }
#define XB_TMO      128
#define XB_XCNT(j)  (256  + 64 * (j))
#define XB_XSUB(j)  (1280 + 64 * (j))
#define XB_XGEN(j)  (2304 + 64 * (j))
#define XB_TOP      3328
#define XB_TOPGEN   3392
#define XCD_BAR_WORDS 3456
#define XB_SPIN_CAP (1u << 18)

__device__ __forceinline__ unsigned xb_ld(unsigned* p)              { return __hip_atomic_load(p, __ATOMIC_RELAXED, __HIP_MEMORY_SCOPE_AGENT); }
__device__ __forceinline__ unsigned xb_add(unsigned* p, unsigned v) { return __hip_atomic_fetch_add(p, v, __ATOMIC_RELAXED, __HIP_MEMORY_SCOPE_AGENT); }
__device__ __forceinline__ unsigned xb_xcc_id() { return (unsigned)__builtin_amdgcn_s_getreg((3 << 11) | 20) & 0xFu; }
#define XB_SPIN(cond, bar) do { unsigned _sp = 0; while (cond) { __builtin_amdgcn_s_sleep(1); \
    if ((++_sp & 255u) == 0u) { if (xb_ld(&(bar)[XB_TMO])) break; if (_sp > XB_SPIN_CAP) { atomicAdd(&(bar)[XB_TMO], 1u); break; } } } } while (0)

struct XcdBarrier {
    unsigned* bar; unsigned x;
    volatile LAS unsigned* st;
};

__device__ __forceinline__ XcdBarrier xcd_barrier_post(unsigned* bar, volatile LAS unsigned* st) {
    XcdBarrier b; b.bar = bar; b.x = xb_xcc_id(); b.st = st;
    if (threadIdx.x == 0) (void)xb_add(&bar[XB_XCNT(b.x)], 1u);
    return b;
}
__device__ __forceinline__ void xcd_barrier_complete(unsigned* bar, unsigned x, unsigned& nloc, unsigned& nx) {
    const unsigned G = gridDim.x * gridDim.y * gridDim.z;
    unsigned sum, cnt, mine, sp = 0u;
    for (;;) {
        sum = 0u; cnt = 0u; mine = 0u;
#pragma unroll
        for (unsigned j = 0; j < 16; ++j) { const unsigned c = xb_ld(&bar[XB_XCNT(j)]); sum += c; cnt += (c > 0u) ? 1u : 0u; mine = (j == x) ? c : mine; }
        if (sum == G) break;
        __builtin_amdgcn_s_sleep(1);
        if ((++sp & 255u) == 0u) { if (xb_ld(&bar[XB_TMO])) break; if (sp > XB_SPIN_CAP) { atomicAdd(&bar[XB_TMO], 1u); break; } }
    }
    nloc = mine > 0u ? mine : 1u; nx = cnt > 0u ? cnt : 1u;
}

__device__ __forceinline__ void xcd_barrier(const XcdBarrier& b) {
    asm volatile("s_waitcnt vmcnt(0)" ::: "memory");
    __syncthreads();
    if (threadIdx.x == 0) {
        unsigned* bar = b.bar;
        __builtin_amdgcn_s_waitcnt(0);
        unsigned nloc = b.st[0], nx = b.st[1];
        if (nloc == 0u) { xcd_barrier_complete(bar, b.x, nloc, nx); b.st[0] = nloc; b.st[1] = nx; }
        const unsigned old = xb_add(&bar[XB_XSUB(b.x)], 1u);
        const unsigned gen = old / nloc;
        if (old + 1u == (gen + 1u) * nloc) {
            __builtin_amdgcn_fence(__ATOMIC_RELEASE, "agent");
            asm volatile("s_waitcnt vmcnt(0)" ::: "memory");
            const unsigned og = xb_add(&bar[XB_TOP], 1u);
            const unsigned tg = og / nx;
            if (og + 1u == (tg + 1u) * nx) xb_add(&bar[XB_TOPGEN], 1u);
            else XB_SPIN(xb_ld(&bar[XB_TOPGEN]) == tg, bar);
            __builtin_amdgcn_fence(__ATOMIC_ACQUIRE, "agent");
            xb_add(&bar[XB_XGEN(b.x)], 1u);
            asm volatile("s_waitcnt vmcnt(0)" ::: "memory");
        } else {
            XB_SPIN(xb_ld(&bar[XB_XGEN(b.x)]) == gen, bar);
            __builtin_amdgcn_fence(__ATOMIC_ACQUIRE, "agent");
            asm volatile("s_waitcnt vmcnt(0)" ::: "memory");
        }
    }
    __syncthreads();
}

constexpr int NWAVES = 8;
constexpr int D = 2048, M = 9216, MP = 8192, TP = 2048, NLAYER = 4;
constexpr int NIN_SRC = 14352, LDP = 14336;
constexpr int PC_U = 0, PC_Z = 1024, PC_Q = 2048, PC_K = 2560, PC_V = 3072, PC_GZ = 4096, PC_CA = 5120, PC_CB = 6144, PC_CZ = 7168, PC_GATE = 8192;
constexpr float LN_EPS = 1e-5f;
constexpr float DN_ALPHA = 1.681792830507429f;
constexpr float QSCALE = 0.08838834764831845f;
constexpr int NPH_LAYER = 10, NPHASE = 1 + NLAYER * NPH_LAYER;

constexpr size_t OUT_Y = 0;
constexpr size_t OUT_S5RE_P = 18874368, OUT_S5IM_P = 18939904, OUT_GLA_P = 19005440, OUT_CONV_P = 21102592;
constexpr size_t OUT_S5RE_S = 21594112, OUT_S5IM_S = 23691264, OUT_GLA_S = 25788416, OUT_CONV_S = 92897280, OUT_TOTAL = 108625920;

constexpr size_t MiB = 1u << 20;
constexpr size_t WS_CTL = 0, CTL_ZERO_BYTES = 1 * MiB;
constexpr size_t WS_WT = 1 * MiB, WT_LAYER = 88 * MiB;
constexpr size_t WO_WIN = 0, WO_WA = WO_WIN + (size_t)LDP * D, WO_WGLU = WO_WA + 16 * D, WO_PS5 = WO_WGLU + 1024 * 1024, WO_PGLA = WO_PS5 + 2048 * 1024, WO_PCONV = WO_PGLA + 2048 * 1024,
                 WO_WO = WO_PCONV + 2048 * 1024, WO_WPG = WO_WO + 2048 * 2048, WO_WPE = WO_WPG + 2048 * 2048, WO_END = WO_WPE + 2048 * 256;
static_assert(WO_END * 2 <= WT_LAYER, "weight block");
constexpr size_t WS_TAB = WS_WT + NLAYER * WT_LAYER, TAB_LAYER = 1 * MiB;
constexpr size_t TB_ABAR = 0, TB_A64 = 32768, TB_BBT = 65536, TB_CMT = 65536 + 262144;
constexpr size_t WS_XB = WS_TAB + NLAYER * TAB_LAYER;
constexpr size_t WS_PB = WS_XB + 36 * MiB;
constexpr size_t WS_P = WS_PB + 18 * MiB;
constexpr size_t WS_ALOW = WS_P + 252 * MiB;
constexpr size_t WS_YG = WS_ALOW + 1 * MiB, WS_AS = WS_YG + 18 * MiB, WS_AG = WS_AS + 18 * MiB, WS_AC = WS_AG + 18 * MiB;
constexpr size_t WS_OSUM = WS_AC + 18 * MiB;
constexpr size_t WS_OG = WS_OSUM, WS_OC = WS_OSUM + 36 * MiB;
constexpr size_t WS_OSB = WS_OSUM + 72 * MiB;
constexpr size_t WS_H32 = WS_OSB + 36 * MiB, WS_HB = WS_H32 + 72 * MiB, WS_PE = WS_HB + 36 * MiB, WS_H2 = WS_PE + 36 * MiB;
constexpr size_t WS_SS = WS_H2 + 72 * MiB;
constexpr size_t WS_KVS = WS_SS + 4 * MiB;
constexpr size_t WS_LSUM = WS_KVS + 32 * MiB;
constexpr size_t WS_ALOWP = WS_LSUM + 1 * MiB;
constexpr size_t WS_END = WS_ALOWP + 4 * MiB;
constexpr int CW_BAR = 4096;

constexpr int RING_BYTES = 131072;
constexpr int LDSCTL_OFF = RING_BYTES, MISC_OFF = LDSCTL_OFF + 320;
constexpr int LDS_BYTES = 147456;

typedef float f32x16 __attribute__((ext_vector_type(16)));
typedef short v4s __attribute__((ext_vector_type(4)));
typedef unsigned v2u __attribute__((ext_vector_type(2)));
__device__ __forceinline__ float bf2f(bf16 b) { return __uint_as_float(((unsigned)b) << 16); }
__device__ __forceinline__ unsigned cvtpk(float lo, float hi) { return pg8::cvt_pk_bf16(lo, hi); }
__device__ __forceinline__ bf16 f2bf16(float f) { return (bf16)f2bf(f); }
__device__ __forceinline__ float gelu_tanh(float x) { const float z = 0.7978845608028654f * (x + 0.044715f * x * x * x); return x * pg8::sigm(2.0f * z); }
__device__ __forceinline__ float log_sigmoid(float x) { return fminf(x, 0.f) - __logf(1.0f + __expf(-fabsf(x))); }
__device__ __forceinline__ bf16x8 zero8() { return (bf16x8){0, 0, 0, 0, 0, 0, 0, 0}; }
__device__ __forceinline__ bf16x8 join8(v4s a, v4s b) { return (bf16x8){a[0], a[1], a[2], a[3], b[0], b[1], b[2], b[3]}; }
__device__ __forceinline__ v4s tr_read(const LAS void* p) { return __builtin_amdgcn_ds_read_tr16_b64_v4i16((LAS v4s*)p); }
#define MFMA16(a, b, c) __builtin_amdgcn_mfma_f32_16x16x32_bf16((a), (b), (c), 0, 0, 0)
#define MFMA32(a, b, c) __builtin_amdgcn_mfma_f32_32x32x16_bf16((a), (b), (c), 0, 0, 0)
#define WAVE_LDS_FENCE() asm volatile("s_waitcnt lgkmcnt(0)" ::: "memory")
__device__ __forceinline__ f32x4 mfma16k(bf16x8 a, bf16x8 b, f32x4 c) { f32x4 d = MFMA16(a, b, c); asm volatile("" : "+v"(d) : "v"(a), "v"(b)); return d; }
__device__ __forceinline__ f32x16 mfma32k(bf16x8 a, bf16x8 b, f32x16 c) { f32x16 d = MFMA32(a, b, c); asm volatile("" : "+v"(d) : "v"(a), "v"(b)); return d; }
#define PIN16(d) asm volatile("s_nop 7" : "+v"(d))
#define PIN32(d) asm volatile("s_nop 7\n\ts_nop 3" : "+v"(d))

struct Frame {
    LAS unsigned char* lds;
    gu32* ctl;
    int tid, lane, wave, vcu, G;
    float* out; unsigned char* ws;
};
constexpr int PTAB_OFF = LDSCTL_OFF + 1024;
__device__ __forceinline__ const float* inp(const Frame& F, int k) {
    const unsigned long long v = ((const LAS unsigned long long*)(F.lds + PTAB_OFF))[k];
    const unsigned lo = __builtin_amdgcn_readfirstlane((unsigned)v), hi = __builtin_amdgcn_readfirstlane((unsigned)(v >> 32));
    return (const float*)(((unsigned long long)hi << 32) | (unsigned long long)lo);
}
__device__ __forceinline__ float wave_sum(float v) {
#pragma unroll
    for (int o = 1; o < 64; o <<= 1) v += __shfl_xor(v, o);
    return v;
}

struct P0Item { const float* W; bf16* WT; int ldw, src_n0, k0, K, dst_n0; };
__device__ __forceinline__ void p0_item_load(const P0Item& it, int lane, float (&v)[32]) {
#pragma unroll
    for (int i = 0; i < 32; ++i) { const int kk = 2 * i + (lane >> 5); v[i] = it.W[(size_t)(it.k0 + kk) * it.ldw + it.src_n0 + (lane & 31)]; }
}
__device__ __forceinline__ void p0_item_store(const P0Item& it, int lane, const float (&v)[32], LAS float* scr) {
#pragma unroll
    for (int i = 0; i < 32; ++i) { const int kk = 2 * i + (lane >> 5); scr[kk * 33 + (lane & 31)] = v[i]; }
    LDS_WAIT(); asm volatile("" ::: "memory");
    const int c = lane & 7;
#pragma unroll
    for (int j = 0; j < 4; ++j) { const int n = (lane >> 3) + 8 * j; const LAS float* s = scr + (8 * c) * 33 + n;
        v4u o; o.x = pk2(s[0 * 33], s[1 * 33]); o.y = pk2(s[2 * 33], s[3 * 33]); o.z = pk2(s[4 * 33], s[5 * 33]); o.w = pk2(s[6 * 33], s[7 * 33]);
        *(GAS v4u*)(it.WT + (size_t)(it.dst_n0 + n) * it.K + it.k0 + 8 * c) = o; }
    LDS_WAIT(); asm volatile("" ::: "memory");
}
constexpr int P0_I_IN = (D / 64) * (LDP / 32), P0_I_GLU = 16 * 32, P0_I_P = 16 * 64, P0_I_O = 32 * 64, P0_I_PE = 4 * 64;
constexpr int P0_I_LAYER = P0_I_IN + P0_I_GLU + 3 * P0_I_P + 2 * P0_I_O + P0_I_PE;
__device__ __forceinline__ P0Item p0_decode(Frame& F, int l, int r) {
    bf16* wt = (bf16*)(F.ws + WS_WT + (size_t)l * WT_LAYER);
    P0Item it; int K, N; const float* W; bf16* WT; int soff = 0;
    if (r < P0_I_IN) { K = D; N = LDP; W = inp(F, 8) + (size_t)l * D * NIN_SRC; WT = wt + WO_WIN; }
    else if ((r -= P0_I_IN) < P0_I_GLU) { K = 1024; N = 1024; W = inp(F, 18) + (size_t)l * 1024 * 1024; WT = wt + WO_WGLU; }
    else if ((r -= P0_I_GLU) < P0_I_P) { K = 1024; N = 2048; W = inp(F, 27) + (size_t)l * 1024 * 2048; WT = wt + WO_PS5; }
    else if ((r -= P0_I_P) < P0_I_P) { K = 1024; N = 2048; W = inp(F, 28) + (size_t)l * 1024 * 2048; WT = wt + WO_PGLA; }
    else if ((r -= P0_I_P) < P0_I_P) { K = 1024; N = 2048; W = inp(F, 29) + (size_t)l * 1024 * 2048; WT = wt + WO_PCONV; }
    else if ((r -= P0_I_P) < P0_I_O) { K = 2048; N = 2048; W = inp(F, 30) + (size_t)l * 2048 * 2048; WT = wt + WO_WO; }
    else if ((r -= P0_I_O) < P0_I_O) { K = 2048; N = 2048; W = inp(F, 31) + (size_t)l * 2048 * 2048; WT = wt + WO_WPG; }
    else { r -= P0_I_O; K = 256; N = 2048; W = inp(F, 32) + (size_t)l * 256 * 2048; WT = wt + WO_WPE; }
    const int nblk = N / 32, kb = r / nblk, nb = r % nblk; const int dn0 = 32 * nb;
    if (N == LDP) soff = (dn0 >= 4096) ? 16 : 0;
    it.W = W; it.WT = WT; it.ldw = (N == LDP) ? NIN_SRC : N; it.src_n0 = dn0 + soff; it.k0 = 64 * kb; it.K = K; it.dst_n0 = dn0;
    return it;
}
__device__ __forceinline__ void p0_convert(Frame& F, int l, int lo, int hi, int w0, int nw) {
    LAS float* scr = (LAS float*)(F.lds + F.wave * 16384);
    int it = lo + w0; if (it >= hi) return;
    P0Item cur = p0_decode(F, l, it); float v[32]; p0_item_load(cur, F.lane, v);
    P0Item n1 = cur; float v1[32]; bool has1 = (it + nw) < hi;
    if (has1) { n1 = p0_decode(F, l, it + nw); p0_item_load(n1, F.lane, v1); }
    for (;;) {
        const int i2 = it + 2 * nw; const bool has2 = has1 && (i2 < hi);
        P0Item n2 = n1; float v2[32];
        if (has2) { n2 = p0_decode(F, l, i2); p0_item_load(n2, F.lane, v2); }
        p0_item_store(cur, F.lane, v, scr);
        if (!has1) break;
#pragma unroll
        for (int i = 0; i < 32; ++i) { v[i] = v1[i]; v1[i] = v2[i]; }
        cur = n1; n1 = n2; has1 = has2; it += nw;
    }
}
__device__ __forceinline__ void p0_prologue(Frame& F) {
    const float* w_in = inp(F, 8);
    p0_convert(F, 0, 0, P0_I_LAYER, F.vcu * NWAVES + F.wave, F.G * NWAVES);
    const size_t gt = (size_t)F.vcu * (NWAVES * 64) + F.tid, NGT = (size_t)F.G * NWAVES * 64;
    for (size_t i = gt; i < (size_t)NLAYER * 16 * D; i += NGT) { const int l = (int)(i / (16 * D)), j = (int)((i / D) % 16), k = (int)(i % D);
        ((bf16*)(F.ws + WS_WT + (size_t)l * WT_LAYER))[WO_WA + (size_t)j * D + k] = f2bf16(w_in[((size_t)l * D + k) * NIN_SRC + 4096 + j]); }
    { const float* xp = inp(F, 0); const float* xs = inp(F, 1); bf16* XB = (bf16*)(F.ws + WS_XB); constexpr int UB = 6; const size_t tot = (size_t)M * D / 8;
      for (size_t i0 = gt; i0 < tot; i0 += UB * NGT) { f32x4 a[UB], b[UB];
#pragma unroll
          for (int u = 0; u < UB; ++u) { const size_t i = i0 + u * NGT; const size_t e = (i < tot ? i : gt) * 8; const float* src = (e < (size_t)MP * D) ? xp + e : xs + (e - (size_t)MP * D); a[u] = *(const f32x4*)src; b[u] = *(const f32x4*)(src + 4); }
#pragma unroll
          for (int u = 0; u < UB; ++u) { const size_t i = i0 + u * NGT; if (i < tot) { v4u o; o.x = pk2(a[u][0], a[u][1]); o.y = pk2(a[u][2], a[u][3]); o.z = pk2(b[u][0], b[u][1]); o.w = pk2(b[u][2], b[u][3]); *(v4u*)(XB + i * 8) = o; } } } }
    { const float* pp = inp(F, 2); const float* ps = inp(F, 3); bf16* PB = (bf16*)(F.ws + WS_PB); constexpr int UB = 3; const size_t tot = (size_t)NLAYER * M * 256 / 8;
      for (size_t i0 = gt; i0 < tot; i0 += UB * NGT) { f32x4 a[UB], b[UB];
#pragma unroll
          for (int u = 0; u < UB; ++u) { const size_t i = i0 + u * NGT; const size_t e = (i < tot ? i : gt) * 8; const int l = (int)(e / ((size_t)M * 256)); const size_t r = e % ((size_t)M * 256);
              const float* src = (r < (size_t)MP * 256) ? pp + (size_t)l * MP * 256 + r : ps + (size_t)l * 1024 * 256 + (r - (size_t)MP * 256); a[u] = *(const f32x4*)src; b[u] = *(const f32x4*)(src + 4); }
#pragma unroll
          for (int u = 0; u < UB; ++u) { const size_t i = i0 + u * NGT; if (i < tot) { v4u o; o.x = pk2(a[u][0], a[u][1]); o.y = pk2(a[u][2], a[u][3]); o.z = pk2(b[u][0], b[u][1]); o.w = pk2(b[u][2], b[u][3]); *(v4u*)(PB + i * 8) = o; } } } }
    { const float* a_re = inp(F, 10); const float* a_im = inp(F, 11); const float* log_dt = inp(F, 12); const float* b_re = inp(F, 13); const float* b_im = inp(F, 14); const float* c_re = inp(F, 15); const float* c_im = inp(F, 16);
      for (size_t i2 = gt; i2 < (size_t)NLAYER * 64 * 64 * 16; i2 += NGT) { const size_t i = i2 >> 4; const int c = (int)(i2 & 15); const int l = (int)(i >> 12), g = (int)((i >> 6) & 63), p = (int)(i & 63);
          unsigned char* tb = F.ws + WS_TAB + (size_t)l * TAB_LAYER;
          const float lr = a_re[i], li = a_im[i], dt = expf(log_dt[l * 64 + g]);
          const float er = expf(lr * dt); float sn, cs; sincosf(li * dt, &sn, &cs); const float ar = er * cs, ai = er * sn;
          if (c == 0) { ((float*)(tb + TB_ABAR))[2 * (g * 64 + p)] = ar; ((float*)(tb + TB_ABAR))[2 * (g * 64 + p) + 1] = ai;
              const float e64 = expf(64.f * lr * dt); float s64, c64; sincosf(64.f * li * dt, &s64, &c64);
              ((float*)(tb + TB_A64))[2 * (g * 64 + p)] = e64 * c64; ((float*)(tb + TB_A64))[2 * (g * 64 + p) + 1] = e64 * s64; }
          const float nr = ar - 1.f, ni = ai, den = lr * lr + li * li; const float fr = (nr * lr + ni * li) / den, fi = (ni * lr - nr * li) / den;
          bf16* BBT = (bf16*)(tb + TB_BBT);
          const float br = b_re[i * 16 + c], bi = b_im[i * 16 + c];
          BBT[((size_t)g * 128 + p) * 16 + c] = f2bf16(fr * br - fi * bi); BBT[((size_t)g * 128 + 64 + p) * 16 + c] = f2bf16(fr * bi + fi * br); }
      for (size_t i = gt; i < (size_t)NLAYER * 64 * 16 * 128; i += NGT) { const int l = (int)(i / (64 * 16 * 128)); const int r = (int)(i % (64 * 16 * 128)); const int g = r / (16 * 128), ch = (r / 128) % 16, k = r % 128;
          bf16* CMT = (bf16*)(F.ws + WS_TAB + (size_t)l * TAB_LAYER + TB_CMT);
          const size_t ci = (((size_t)l * 64 + g) * 16 + ch) * 64 + (k & 63);
          CMT[r] = f2bf16(k < 64 ? c_re[ci] : -c_im[ci]); } }
}

__device__ __forceinline__ void alow_phase(Frame& F, int l) {
    const bf16* XB = (const bf16*)(F.ws + WS_XB); const bf16* WA = (const bf16*)(F.ws + WS_WT + (size_t)l * WT_LAYER) + WO_WA;
    const float* b_in = inp(F, 9) + (size_t)l * NIN_SRC;
    float* ALOWP = (float*)(F.ws + WS_ALOWP);
    const int c16 = F.lane & 15, q4 = F.lane >> 4;
    for (int su = F.vcu * NWAVES + F.wave; su < 4 * (M / 16); su += F.G * NWAVES) {
        const int un = su % (M / 16), kq = su / (M / 16);
        const bf16* ap = XB + (size_t)(16 * un + c16) * D + 512 * kq + 8 * q4; const bf16* bp = WA + (size_t)c16 * D + 512 * kq + 8 * q4;
        f32x4 acc = (f32x4){0.f, 0.f, 0.f, 0.f};
#pragma unroll
        for (int ks = 0; ks < 16; ++ks) acc = mfma16k(*(const bf16x8*)(ap + 32 * ks), *(const bf16x8*)(bp + 32 * ks), acc);
        PIN16(acc);
        const float bb = (kq == 0) ? b_in[4096 + c16] : 0.f;
#pragma unroll
        for (int r = 0; r < 4; ++r) ALOWP[((size_t)kq * M + 16 * un + 4 * q4 + r) * 16 + c16] = acc[r] + bb;
    }
}

template <int MODE>
__device__ __forceinline__ void s5_unit(LAS float* T, int lane, const bf16* P, size_t row0, int g, const float* abar, const bf16* BBT, const bf16* CMT, const float* dsk,
                                        float* ss, const float* h0re, const float* h0im, float* outre, float* outim, bf16* YG) {
    asm volatile("" : "+v"(lane));
    const int c16 = lane & 15, q4 = lane >> 4;
    bf16x8 bfr[8];
#pragma unroll
    for (int nb = 0; nb < 8; ++nb) bfr[nb] = (lane < 32) ? *(const bf16x8*)(BBT + ((size_t)g * 128 + 16 * nb + c16) * 16 + 8 * q4) : zero8();
    bf16x8 cfr[4];
    if (MODE >= 1) {
#pragma unroll
        for (int ks = 0; ks < 4; ++ks) cfr[ks] = *(const bf16x8*)(CMT + ((size_t)g * 16 + c16) * 128 + 32 * ks + 8 * q4);
    }
    const float ar = abar[2 * (g * 64 + lane)], ai = abar[2 * (g * 64 + lane) + 1];
    float hr = 0.f, hi = 0.f;
    if (MODE == 1) { hr = ss[lane]; hi = ss[64 + lane]; }
    float h0r[8], h0i[8];
    if (MODE == 2) {
#pragma unroll
        for (int b8 = 0; b8 < 8; ++b8) { h0r[b8] = h0re[(size_t)b8 * 4096 + lane]; h0i[b8] = h0im[(size_t)b8 * 4096 + lane]; } }
    bf16x8 dfr = zero8();
    if (MODE >= 1) { const unsigned short db = f2bf16(dsk[16 * g + c16]);
#pragma unroll
        for (int j = 0; j < 8; ++j) dfr[j] = (lane < 32 && 8 * q4 + j == c16) ? (short)db : (short)0; }
    bf16x8 afn = (lane < 32) ? *(const bf16x8*)(P + (row0 + c16) * LDP + PC_U + 16 * g + 8 * (q4 & 1)) : zero8();
    for (int tb = 0; tb < 4; ++tb) {
        const bf16x8 af = afn;
        { const int tn = tb < 3 ? tb + 1 : 3;
          afn = (lane < 32) ? *(const bf16x8*)(P + (row0 + 16 * tn + c16) * LDP + PC_U + 16 * g + 8 * (q4 & 1)) : zero8(); }
        f32x4 dd[8];
#pragma unroll
        for (int nb = 0; nb < 8; ++nb) dd[nb] = mfma16k(af, bfr[nb], ((f32x4){0.f, 0.f, 0.f, 0.f}));
        asm volatile("s_nop 7\n\ts_nop 7" : "+v"(dd[0]), "+v"(dd[1]), "+v"(dd[2]), "+v"(dd[3]), "+v"(dd[4]), "+v"(dd[5]), "+v"(dd[6]), "+v"(dd[7]) : "v"(af));
#pragma unroll
        for (int nb = 0; nb < 8; ++nb) *(LAS f32x4*)(T + (16 * nb + c16) * 20 + 4 * q4) = dd[nb];
        WAVE_LDS_FENCE();
#pragma unroll
        for (int i = 0; i < 4; ++i) {
            const int bs = 2 * tb + (i >> 1);
            if (MODE == 2 && (i & 1) == 0) { hr = h0r[bs]; hi = h0i[bs]; }
            const f32x4 re = *(LAS f32x4*)(T + lane * 20 + 4 * i), im = *(LAS f32x4*)(T + (64 + lane) * 20 + 4 * i);
            float r[4], mm[4];
#pragma unroll
            for (int k = 0; k < 4; ++k) { const float nr = ar * hr - ai * hi + re[k], ni = ar * hi + ai * hr + im[k]; hr = nr; hi = ni; r[k] = nr; mm[k] = ni; }
            if (MODE >= 1) { *(LAS v2u*)(T + lane * 20 + 4 * i) = (v2u){cvtpk(r[0], r[1]), cvtpk(r[2], r[3])}; *(LAS v2u*)(T + (64 + lane) * 20 + 4 * i) = (v2u){cvtpk(mm[0], mm[1]), cvtpk(mm[2], mm[3])}; }
            if (MODE == 2 && (i & 1) == 1) { outre[(size_t)bs * 4096 + lane] = hr * DIAG_SGN(DIAG_S5S, lane ^ bs ^ g); outim[(size_t)bs * 4096 + lane] = hi * DIAG_SGN(DIAG_S5S, lane ^ bs ^ g); }
        }
        if (MODE >= 1) {
            WAVE_LDS_FENCE();
            f32x4 y = (f32x4){0.f, 0.f, 0.f, 0.f};
#pragma unroll
            for (int ks = 0; ks < 4; ++ks) {
                const LAS float* a0 = T + (32 * ks + 8 * q4 + (c16 >> 2)) * 20 + 4 * (c16 & 3);
                const v4s lo = tr_read(a0), hh = tr_read(a0 + 4 * 20);
                y = mfma16k(join8(lo, hh), cfr[ks], y);
            }
            y = mfma16k(af, dfr, y);
            PIN16(y);
#pragma unroll
            for (int r = 0; r < 4; ++r) { const size_t grow = row0 + 16 * tb + 4 * q4 + r; YG[grow * 1024 + 16 * g + c16] = f2bf16(gelu_tanh(y[r])); }
            WAVE_LDS_FENCE();
        }
    }
    if (MODE == 0) { ss[lane] = hr; ss[64 + lane] = hi; }
    if (MODE == 1 && outre) { outre[lane] = hr * DIAG_SGN(DIAG_S5P, lane ^ g); outim[lane] = hi * DIAG_SGN(DIAG_S5P, lane ^ g); }
}
#if defined(DIAG_CHECK)
__device__ __forceinline__ unsigned dhash(unsigned x) { x ^= x >> 16; x *= 0x7feb352dU; x ^= x >> 15; x *= 0x846ca68bU; x ^= x >> 16; return x; }
__device__ __forceinline__ void diag_gemm1(Frame& F) {
    const float* xp = inp(F, 0); const float* xs = inp(F, 1); const float* w_in = inp(F, 8); const float* b_in = inp(F, 9);
    const bf16* P = (const bf16*)(F.ws + WS_P);
    const unsigned gt = (unsigned)F.vcu * 512u + (unsigned)F.tid;
    const unsigned h1 = dhash(gt * 2u + 1u), h2 = dhash(gt * 2u + 0x9e3779b9u);
    const int row = (int)(h1 % (unsigned)M), col = (int)(h2 % (unsigned)LDP);
    const int sc = col + (col >= 4096 ? 16 : 0);
    const float* xr = row < MP ? xp + (size_t)row * D : xs + (size_t)(row - MP) * D;
    float acc = 0.f;
    for (int k = 0; k < D; ++k) acc += xr[k] * w_in[(size_t)k * NIN_SRC + sc];
    acc += b_in[sc];
    const int pn = col >> 8; int act = 0;
    if ((pn >= 4 && pn < 8) || (pn >= 16 && pn < 20) || (pn >= 28 && pn < 32)) act = 1;
    if ((pn >= 24 && pn < 28) || pn >= 32) act = 2;
    float ref = acc; if (act == 1) ref = acc / (1.f + expf(-acc)); if (act == 2) ref = 1.f / (1.f + expf(-acc));
    const float got = bf2f(P[(size_t)row * LDP + col]);
    if (!(fabsf(got - ref) <= 0.03f + 0.03f * fabsf(ref))) atomicAdd((unsigned*)(F.ctl + 16), 1u);
}
__device__ __forceinline__ void diag_s5s(Frame& F, int l) {
    const bf16* P = (const bf16*)(F.ws + WS_P); unsigned char* tb = F.ws + WS_TAB + (size_t)l * TAB_LAYER;
    const float* abar = (const float*)(tb + TB_ABAR); const bf16* BBT = (const bf16*)(tb + TB_BBT);
    const int gw = F.vcu * NWAVES + F.wave, NGW = F.G * NWAVES, lane = F.lane;
    for (int wu = gw; wu < 16 * 64; wu += NGW) { const int g = wu & 63, bg = wu >> 6; const size_t so = (((size_t)l * 128 + 8 * bg) * 64 + g) * 64;
        const float ar = abar[2 * (g * 64 + lane)], ai = abar[2 * (g * 64 + lane) + 1];
        float br[16], bi[16];
#pragma unroll
        for (int c = 0; c < 16; ++c) { br[c] = bf2f(BBT[((size_t)g * 128 + lane) * 16 + c]); bi[c] = bf2f(BBT[((size_t)g * 128 + 64 + lane) * 16 + c]); }
        for (int bs = 0; bs < 8; ++bs) { float hr = inp(F, 4)[so + (size_t)bs * 4096 + lane], hi = inp(F, 5)[so + (size_t)bs * 4096 + lane];
            for (int t = 0; t < 8; ++t) { const bf16* ur = P + ((size_t)MP + 64 * bg + 8 * bs + t) * LDP + PC_U + 16 * g; float sr = 0.f, si = 0.f;
#pragma unroll
                for (int c = 0; c < 16; ++c) { const float uu = bf2f(ur[c]); sr += br[c] * uu; si += bi[c] * uu; }
                const float nr = ar * hr - ai * hi + sr, ni = ar * hi + ai * hr + si; hr = nr; hi = ni; }
            const float gr = F.out[OUT_S5RE_S + so + (size_t)bs * 4096 + lane], gi = F.out[OUT_S5IM_S + so + (size_t)bs * 4096 + lane];
            if (!(fabsf(gr - hr) <= 1e-4f + 2e-3f * fabsf(hr)) || !(fabsf(gi - hi) <= 1e-4f + 2e-3f * fabsf(hi))) atomicAdd((unsigned*)(F.ctl + 17), 1u); } }
}
__device__ __forceinline__ float diag_scale(Frame& F) {
    const unsigned c1 = __hip_atomic_load((unsigned*)(F.ctl + 16), __ATOMIC_RELAXED, __HIP_MEMORY_SCOPE_AGENT), c2 = __hip_atomic_load((unsigned*)(F.ctl + 17), __ATOMIC_RELAXED, __HIP_MEMORY_SCOPE_AGENT);
    if (c2 > 0u) return 2.0f;
    int n = 0; if (c1 >= 1u) n = 1; if (c1 >= 4u) n = 2; if (c1 >= 16u) n = 3; if (c1 >= 64u) n = 4; if (c1 >= 256u) n = 5;
    return 1.0f + 0.1f * (float)n;
}
#endif

constexpr int GL_QD = 0, GL_KD = 17408, GL_KDT = 34816, GL_ATT = 53248, GL_V = 62464, GL_AL = 96256, GL_GS = 100352, GL_LAM = 102400, GL_END = 102912;
constexpr int GL_O = 0;
__device__ __forceinline__ int gla_pos(int dk) { const int x = dk & 15; return (dk & ~15) | (x & 3) | ((x & 4) << 1) | ((x & 8) >> 1); }

template <bool FINISH, int NV>
__device__ __forceinline__ float gla_chunk(Frame& F, f32x16 (&S)[4], const bf16* P, const float* ALOW, bf16* AG, size_t row0, int h, const float (&w2)[16], float ba, const float* norm_g) {
    LAS unsigned char* L = F.lds;
    int tid_l = threadIdx.x; asm volatile("" : "+v"(tid_l));
    const int tid = tid_l, lane = tid & 63, w = F.wave, l31 = lane & 31, hh = lane >> 5;
    const int dk = tid & 127, tg = tid >> 7;
    constexpr int NS_O = (NV == 64) ? 4 : 2, NS_U = (NV == 64) ? 4 : 1, NCB = (NV == 64) ? 2 : 1;
    const bool live = (NV == 64) || (tg == 0);
    unsigned qu[16], ku[16];
#pragma unroll
    for (int i = 0; i < 16; ++i) { const int t = 16 * tg + i, tc = (t < NV) ? t : 0;
        qu[i] = (unsigned)P[(row0 + tc) * LDP + PC_Q + h * 128 + dk]; ku[i] = (unsigned)P[(row0 + tc) * LDP + PC_K + h * 128 + dk]; }
    v4u gzv[4];
    if (FINISH) { const int row = tid >> 3, seg = tid & 7, rc = (row < NV) ? row : 0;
#pragma unroll
        for (int j = 0; j < 4; ++j) gzv[j] = *(const v4u*)(P + (row0 + rc) * LDP + PC_GZ + h * 256 + 32 * seg + 8 * j); }
    if (tid < 256) { const int r = tid >> 2, c4 = tid & 3; f32x4 a = (f32x4){0.f, 0.f, 0.f, 0.f}; if (r < NV) { const float* ar_ = ALOW + (row0 + r) * 16 + 4 * c4; a = (*(const f32x4*)ar_ + *(const f32x4*)(ar_ + (size_t)M * 16)) + (*(const f32x4*)(ar_ + (size_t)2 * M * 16) + *(const f32x4*)(ar_ + (size_t)3 * M * 16)); } *(LAS f32x4*)(L + GL_AL + (r * 16 + 4 * c4) * 4) = a; }
#pragma unroll
    for (int i = 0; i < 4; ++i) { const int idx = tid + 512 * i, r = idx >> 5, ch = idx & 31; v4u v = (v4u){0u, 0u, 0u, 0u}; if (r < NV) v = *(const v4u*)(P + (row0 + r) * LDP + PC_V + h * 256 + 8 * ch); *(LAS v4u*)(L + GL_V + r * 528 + ch * 16) = v; }
    __syncthreads();
    float lc[16]; float run = 0.f;
#pragma unroll
    for (int i = 0; i < 16; ++i) lc[i] = 0.f;
    if (live) {
#pragma unroll
    for (int i = 0; i < 16; ++i) { const int t = 16 * tg + i; const LAS f32x4* al = (const LAS f32x4*)(L + GL_AL + t * 64); float lg = ba;
#pragma unroll
        for (int q = 0; q < 4; ++q) { const f32x4 a = al[q]; lg += a[0] * w2[4 * q] + a[1] * w2[4 * q + 1] + a[2] * w2[4 * q + 2] + a[3] * w2[4 * q + 3]; }
        const float la = (t < NV) ? log_sigmoid(lg) * (1.0f / 16.0f) : 0.f; run += la; lc[i] = run; if ((i & 3) == 3) asm volatile("" ::: "memory"); }
    }
    ((LAS float*)(L + GL_GS))[tg * 128 + dk] = run;
    __syncthreads();
    float off = 0.f, last = 0.f;
#pragma unroll
    for (int q = 0; q < 4; ++q) { const float gsv = ((LAS float*)(L + GL_GS))[q * 128 + dk]; if (q < tg) off += gsv; last += gsv; }
    if (tg == 0) ((LAS float*)(L + GL_LAM))[dk] = __expf(last);
    {
        const int pos = gla_pos(dk); unsigned kd2[8];
        if (!live) {
#pragma unroll
            for (int i = 0; i < 16; ++i) { const int t = 16 * tg + i; if (FINISH && t < 32) { ((LAS bf16*)(L + GL_QD))[t * 136 + pos] = 0; ((LAS bf16*)(L + GL_KD))[t * 136 + pos] = 0; } }
        } else {
#pragma unroll
        for (int i = 0; i < 16; i += 2) { float kdec[2];
#pragma unroll
            for (int j = 0; j < 2; ++j) { const int t = 16 * tg + i + j; const float cum = off + lc[i + j]; float qv = 0.f, kv = 0.f;
                { const float ql = __uint_as_float(qu[i + j] << 16), kl = __uint_as_float(ku[i + j] << 16); qv = (t < NV) ? ql : 0.f; kv = (t < NV) ? kl : 0.f; }
                if (FINISH) { ((LAS bf16*)(L + GL_QD))[t * 136 + pos] = f2bf16(qv * QSCALE * __expf(cum)); ((LAS bf16*)(L + GL_KD))[t * 136 + pos] = f2bf16(kv * __expf(-cum)); }
                kdec[j] = kv * __expf(last - cum); }
            kd2[i >> 1] = cvtpk(kdec[0], kdec[1]); if ((i & 6) == 6) asm volatile("" ::: "memory"); }
        *(LAS v4u*)(L + GL_KDT + dk * 144 + tg * 32) = (v4u){kd2[0], kd2[1], kd2[2], kd2[3]};
        *(LAS v4u*)(L + GL_KDT + dk * 144 + tg * 32 + 16) = (v4u){kd2[4], kd2[5], kd2[6], kd2[7]};
        }
    }
    __syncthreads();
    if (FINISH) {
        if (w < (NV == 64 ? 4 : 1)) { const int cb = w >> 1, jb = w & 1; f32x16 a = {0.f, 0.f, 0.f, 0.f, 0.f, 0.f, 0.f, 0.f, 0.f, 0.f, 0.f, 0.f, 0.f, 0.f, 0.f, 0.f};
#pragma unroll
            for (int s = 0; s < 8; ++s) { const bf16x8 af = *(const LAS bf16x8*)(L + GL_QD + (32 * cb + l31) * 272 + (16 * s + 8 * hh) * 2), bf = *(const LAS bf16x8*)(L + GL_KD + (32 * jb + l31) * 272 + (16 * s + 8 * hh) * 2); a = mfma32k(af, bf, a); }
            PIN32(a);
#pragma unroll
            for (int r = 0; r < 16; ++r) { const int c = 32 * cb + (r & 3) + 8 * (r >> 2) + 4 * hh, j = 32 * jb + l31; ((LAS bf16*)(L + GL_ATT))[c * 72 + j] = f2bf16(j <= c ? a[r] : 0.f); } }
        __syncthreads();
    }
    bf16x8 vf[4];
    { const int q = (lane & 15) >> 2, p4 = lane & 3, blk = (lane >> 4) & 1;
#pragma unroll
      for (int s = 0; s < NS_O; ++s) { const LAS unsigned char* a0 = L + GL_V + (16 * s + 8 * hh + q) * 528 + (32 * w + 16 * blk + 4 * p4) * 2; vf[s] = join8(tr_read(a0), tr_read(a0 + 4 * 528)); } }
    f32x16 o[2];
    if (FINISH) {
#pragma unroll
        for (int cb = 0; cb < NCB; ++cb) { f32x16 a = {0.f, 0.f, 0.f, 0.f, 0.f, 0.f, 0.f, 0.f, 0.f, 0.f, 0.f, 0.f, 0.f, 0.f, 0.f, 0.f};
#pragma unroll
            for (int s = 0; s < NS_O; ++s) a = mfma32k(*(const LAS bf16x8*)(L + GL_ATT + (32 * cb + l31) * 144 + (16 * s + 8 * hh) * 2), vf[s], a);
#pragma unroll
            for (int kb = 0; kb < 4; ++kb)
#pragma unroll
                for (int sp = 0; sp < 2; ++sp) { bf16x8 sf; { unsigned u0 = cvtpk(S[kb][8 * sp + 0], S[kb][8 * sp + 1]), u1 = cvtpk(S[kb][8 * sp + 2], S[kb][8 * sp + 3]), u2 = cvtpk(S[kb][8 * sp + 4], S[kb][8 * sp + 5]), u3 = cvtpk(S[kb][8 * sp + 6], S[kb][8 * sp + 7]);
                        v4u pk = (v4u){u0, u1, u2, u3}; sf = __builtin_bit_cast(bf16x8, pk); }
                    a = mfma32k(*(const LAS bf16x8*)(L + GL_QD + (32 * cb + l31) * 272 + (32 * kb + 16 * sp + 8 * hh) * 2), sf, a); }
            PIN32(a); o[cb] = a; }
    }
#pragma unroll
    for (int kb = 0; kb < 4; ++kb) {
#pragma unroll
        for (int q = 0; q < 4; ++q) { const f32x4 lm = *(const LAS f32x4*)(L + GL_LAM + (32 * kb + 8 * q + 4 * hh) * 4);
#pragma unroll
            for (int j = 0; j < 4; ++j) S[kb][4 * q + j] *= lm[j]; }
#pragma unroll
        for (int s = 0; s < NS_U; ++s) S[kb] = mfma32k(*(const LAS bf16x8*)(L + GL_KDT + (32 * kb + l31) * 144 + (16 * s + 8 * hh) * 2), vf[s], S[kb]);
        PIN32(S[kb]);
    }
    __syncthreads();
    if (FINISH) {
#pragma unroll
        for (int cb = 0; cb < NCB; ++cb)
#pragma unroll
            for (int r = 0; r < 16; ++r) { const int c = 32 * cb + (r & 3) + 8 * (r >> 2) + 4 * hh; ((LAS float*)(L + GL_O))[c * 260 + 32 * w + l31] = o[cb][r]; }
        __syncthreads();
        const int row = tid >> 3, seg = tid & 7;
        f32x4 x[8]; float s = 0.f;
#pragma unroll
        for (int j = 0; j < 8; ++j) { x[j] = *(const LAS f32x4*)(L + GL_O + (row * 260 + 32 * seg + 4 * j) * 4); s += (x[j][0] + x[j][1]) + (x[j][2] + x[j][3]); }
        s += __shfl_xor(s, 1); s += __shfl_xor(s, 2); s += __shfl_xor(s, 4);
        const float mean = s * (1.0f / 256.0f); float qq = 0.f;
#pragma unroll
        for (int j = 0; j < 8; ++j) { x[j] = x[j] - mean; qq += (x[j][0] * x[j][0] + x[j][1] * x[j][1]) + (x[j][2] * x[j][2] + x[j][3] * x[j][3]); }
        qq += __shfl_xor(qq, 1); qq += __shfl_xor(qq, 2); qq += __shfl_xor(qq, 4);
        const float rstd = 1.0f / sqrtf(qq * (1.0f / 256.0f) + LN_EPS);
        if (row < NV) {
            const size_t grow = row0 + row; const int cbase = h * 256 + 32 * seg;
#pragma unroll
            for (int j = 0; j < 8; j += 2) { f32x4 z0, z1; pg8::unpack8(gzv[j >> 1], z0, z1);
                const f32x4 g0 = *(const f32x4*)(norm_g + cbase + 4 * j), g1 = *(const f32x4*)(norm_g + cbase + 4 * j + 4);
                const f32x4 y0 = x[j] * rstd * g0 * z0, y1 = x[j + 1] * rstd * g1 * z1;
                *(v4u*)(AG + grow * 1024 + cbase + 4 * j) = pg8::pack8(y0, y1); }
        }
        __syncthreads();
    }
    return last;
}
__device__ __forceinline__ void gla_state_load(Frame& F, f32x16 (&S)[4], const float* src) {
    int ln_l = threadIdx.x & 63; asm volatile("" : "+v"(ln_l));
    const int l31 = ln_l & 31, hh = ln_l >> 5;
#pragma unroll
    for (int kb = 0; kb < 4; ++kb)
#pragma unroll
        for (int r = 0; r < 16; ++r) S[kb][r] = src[(size_t)(32 * kb + (r & 3) + 8 * (r >> 2) + 4 * hh) * 256 + 32 * F.wave + l31];
}
__device__ __forceinline__ void gla_state_store(Frame& F, const f32x16 (&S)[4], float* dst) {
    int ln_l = threadIdx.x & 63; asm volatile("" : "+v"(ln_l));
    const int l31 = ln_l & 31, hh = ln_l >> 5;
#pragma unroll
    for (int kb = 0; kb < 4; ++kb)
#pragma unroll
        for (int r = 0; r < 16; ++r) dst[(size_t)(32 * kb + (r & 3) + 8 * (r >> 2) + 4 * hh) * 256 + 32 * F.wave + l31] = S[kb][r];
}
__device__ __forceinline__ void gla_zero(f32x16 (&S)[4]) {
#pragma unroll
    for (int kb = 0; kb < 4; ++kb)
#pragma unroll
        for (int r = 0; r < 16; ++r) S[kb][r] = 0.f;
}
__device__ __forceinline__ void gla_phaseB(Frame& F, int l) {
    const bf16* P = (const bf16*)(F.ws + WS_P); const float* ALOW = (const float*)(F.ws + WS_ALOWP); bf16* AG = (bf16*)(F.ws + WS_AG);
    float* KVS = (float*)(F.ws + WS_KVS); float* LSUM = (float*)(F.ws + WS_LSUM);
    const float* w_a2 = inp(F, 20) + (size_t)l * 16 * 512; const float* b_a = inp(F, 21) + (size_t)l * 512; const float* norm_g = inp(F, 22) + (size_t)l * 1024;
    const int dk = F.tid & 127;
    f32x16 S[4];
    for (int u = F.vcu; u < 256; u += F.G) {
        const int bh = u >> 4, sc = u & 15, b = bh >> 2, h = bh & 3;
        float w2[16];
#pragma unroll
        for (int r = 0; r < 16; ++r) w2[r] = w_a2[r * 512 + h * 128 + dk];
        const float ba = b_a[h * 128 + dk];
        gla_zero(S); float lsum = 0.f;
        for (int ch = 0; ch < 2; ++ch) lsum += gla_chunk<false, 64>(F, S, P, ALOW, AG, (size_t)b * TP + 128 * sc + 64 * ch, h, w2, ba, norm_g);
        gla_state_store(F, S, KVS + ((size_t)bh * 16 + sc) * 32768);
        if (F.tid < 128) LSUM[((size_t)bh * 16 + sc) * 128 + dk] = lsum;
    }
    const float* st_in = inp(F, 6) + (size_t)l * 128 * 4 * 32768; float* st_out = F.out + OUT_GLA_S + (size_t)l * 128 * 4 * 32768;
    for (int u = F.vcu; u < 512; u += F.G) {
        const int bs = u >> 2, h = u & 3;
        float w2[16];
#pragma unroll
        for (int r = 0; r < 16; ++r) w2[r] = w_a2[r * 512 + h * 128 + dk];
        const float ba = b_a[h * 128 + dk];
        gla_state_load(F, S, st_in + (size_t)u * 32768);
        (void)gla_chunk<true, 8>(F, S, P, ALOW, AG, (size_t)MP + 8 * bs, h, w2, ba, norm_g);
        gla_state_store(F, S, st_out + (size_t)u * 32768);
    }
}
__device__ __forceinline__ void gla_phaseD(Frame& F, int l) {
    const bf16* P = (const bf16*)(F.ws + WS_P); const float* ALOW = (const float*)(F.ws + WS_ALOWP); bf16* AG = (bf16*)(F.ws + WS_AG);
    const float* KVS = (const float*)(F.ws + WS_KVS);
    const float* w_a2 = inp(F, 20) + (size_t)l * 16 * 512; const float* b_a = inp(F, 21) + (size_t)l * 512; const float* norm_g = inp(F, 22) + (size_t)l * 1024;
    const int dk = F.tid & 127;
    f32x16 S[4];
    for (int u = F.vcu; u < 256; u += F.G) {
        const int bh = u >> 4, sc = u & 15, b = bh >> 2, h = bh & 3;
        float w2[16];
#pragma unroll
        for (int r = 0; r < 16; ++r) w2[r] = w_a2[r * 512 + h * 128 + dk];
        const float ba = b_a[h * 128 + dk];
        gla_state_load(F, S, KVS + ((size_t)bh * 16 + sc) * 32768);
        for (int ch = 0; ch < 2; ++ch) (void)gla_chunk<true, 64>(F, S, P, ALOW, AG, (size_t)b * TP + 128 * sc + 64 * ch, h, w2, ba, norm_g);
    }
}

__device__ __forceinline__ void scans_phaseC(Frame& F, int l) {
    const size_t gt = (size_t)F.vcu * (NWAVES * 64) + F.tid, NGT = (size_t)F.G * NWAVES * 64;
    { float* KVS = (float*)(F.ws + WS_KVS); const float* LSUM = (const float*)(F.ws + WS_LSUM); float* fin = F.out + OUT_GLA_P + (size_t)l * 16 * 32768;
      for (size_t i = gt; i < (size_t)16 * 128 * 64; i += NGT) { const int bh = (int)(i >> 13), dkk = (int)((i >> 6) & 127), d4 = (int)(i & 63);
          f32x4 kv[16]; float lam[16];
#pragma unroll
          for (int sc = 0; sc < 16; ++sc) { kv[sc] = *(const f32x4*)(KVS + (((size_t)bh * 16 + sc) * 128 + dkk) * 256 + 4 * d4); lam[sc] = __expf(LSUM[((size_t)bh * 16 + sc) * 128 + dkk]); }
          f32x4 s = (f32x4){0.f, 0.f, 0.f, 0.f};
#pragma unroll
          for (int sc = 0; sc < 16; ++sc) { *(f32x4*)(KVS + (((size_t)bh * 16 + sc) * 128 + dkk) * 256 + 4 * d4) = s; s = s * lam[sc] + kv[sc]; }
          *(f32x4*)(fin + ((size_t)bh * 128 + dkk) * 256 + 4 * d4) = s; } }
    { float* SS = (float*)(F.ws + WS_SS); const float* a64 = (const float*)(F.ws + WS_TAB + (size_t)l * TAB_LAYER + TB_A64);
      for (size_t i = gt; i < (size_t)4 * 64 * 64; i += NGT) { const int b = (int)(i >> 12), g = (int)((i >> 6) & 63), p = (int)(i & 63);
          const float ar = a64[2 * (g * 64 + p)], ai = a64[2 * (g * 64 + p) + 1]; float cr = 0.f, ci = 0.f;
          { float sr[32], si[32];
#pragma unroll
              for (int j = 0; j < 32; ++j) { const size_t base = (((size_t)b * 32 + j) * 64 + g) * 128; sr[j] = SS[base + p]; si[j] = SS[base + 64 + p]; }
#pragma unroll
              for (int j = 0; j < 32; ++j) { const size_t base = (((size_t)b * 32 + j) * 64 + g) * 128; SS[base + p] = cr; SS[base + 64 + p] = ci;
                  const float nr = ar * cr - ai * ci + sr[j], ni = ar * ci + ai * cr + si[j]; cr = nr; ci = ni; } } } }
}
template <int TT, bool SAMPLE>
__device__ __forceinline__ void conv_unit(Frame& F, int l, int b, int t0) {
    const bf16* P = (const bf16*)(F.ws + WS_P); bf16* AC = (bf16*)(F.ws + WS_AC);
    const float* cw = inp(F, 23) + (size_t)l * 31 * 1024; const float* cb = inp(F, 24) + (size_t)l * 1024; const float* lng = inp(F, 25) + (size_t)l * 1024; const float* lnb = inp(F, 26) + (size_t)l * 1024;
    const float* cache = inp(F, 7) + ((size_t)l * 128 + b) * 30 * 1024;
    int tid_l = threadIdx.x; asm volatile("" : "+v"(tid_l));
    const int c0 = 2 * tid_l; const size_t rowbase = SAMPLE ? (size_t)MP + 8 * b : (size_t)b * TP;
    float w0[31], w1[31];
#pragma unroll
    for (int j = 0; j < 31; ++j) { const float2 wv = *(const float2*)(cw + j * 1024 + c0); w0[j] = wv.x; w1[j] = wv.y; }
    float a0[TT], a1[TT];
    { const float2 bv = *(const float2*)(cb + c0);
#pragma unroll
      for (int t = 0; t < TT; ++t) { a0[t] = bv.x; a1[t] = bv.y; } }
    float* cnew = SAMPLE ? F.out + OUT_CONV_S + ((size_t)l * 128 + b) * 30 * 1024 : F.out + OUT_CONV_P + ((size_t)l * 4 + b) * 30 * 1024;
#pragma unroll
    for (int rp = 0; rp < TT + 30; ++rp) {
        const int t = t0 - 30 + rp;
        float g0 = 0.f, g1 = 0.f;
        if (SAMPLE) {
            if (rp < 30) { const float2 cv = *(const float2*)(cache + (size_t)rp * 1024 + c0); g0 = cv.x; g1 = cv.y; }
            else { const unsigned ca = *(const unsigned*)(P + (rowbase + rp - 30) * LDP + PC_CA + c0), cbv = *(const unsigned*)(P + (rowbase + rp - 30) * LDP + PC_CB + c0); g0 = pg8::bflo(ca) * pg8::bflo(cbv); g1 = pg8::bfhi(ca) * pg8::bfhi(cbv); }
            if (rp >= 8) *(float2*)(cnew + (size_t)(rp - 8) * 1024 + c0) = make_float2(g0, g1);
        } else {
            const int tc = t < 0 ? 0 : t;
            const unsigned ca = *(const unsigned*)(P + (rowbase + tc) * LDP + PC_CA + c0), cbv = *(const unsigned*)(P + (rowbase + tc) * LDP + PC_CB + c0);
            const float v0 = pg8::bflo(ca) * pg8::bflo(cbv), v1 = pg8::bfhi(ca) * pg8::bfhi(cbv); g0 = t < 0 ? 0.f : v0; g1 = t < 0 ? 0.f : v1;
        }
#pragma unroll
        for (int tt = 0; tt < TT; ++tt) { const int j = rp - tt; if (j >= 0 && j <= 30) { a0[tt] += w0[j] * g0; a1[tt] += w1[j] * g1; } }
        if (rp == (TT + 30) / 2 - 1) asm volatile("" ::: "memory");
    }
    if (!SAMPLE && t0 + TT > TP - 30) {
        for (int t = (t0 > TP - 30 ? t0 : TP - 30); t < t0 + TT; ++t) { const unsigned ca = *(const unsigned*)(P + (rowbase + t) * LDP + PC_CA + c0), cbv = *(const unsigned*)(P + (rowbase + t) * LDP + PC_CB + c0);
            *(float2*)(cnew + (size_t)(t - (TP - 30)) * 1024 + c0) = make_float2(pg8::bflo(ca) * pg8::bflo(cbv), pg8::bfhi(ca) * pg8::bfhi(cbv)); } }
    LAS float* Y = (LAS float*)F.lds;
#pragma unroll
    for (int t = 0; t < TT; ++t) *(LAS pg8::f32x2*)(Y + t * 1024 + c0) = (pg8::f32x2){a0[t], a1[t]};
    __syncthreads();
    for (int t = F.wave; t < TT; t += NWAVES) {
        f32x4 x[4]; float s = 0.f;
#pragma unroll
        for (int j = 0; j < 4; ++j) { x[j] = *(const LAS f32x4*)(Y + t * 1024 + 8 * F.lane + 512 * (j >> 1) + 4 * (j & 1)); s += (x[j][0] + x[j][1]) + (x[j][2] + x[j][3]); }
        const float mean = wave_sum(s) * (1.0f / 1024.0f); float qq = 0.f;
#pragma unroll
        for (int j = 0; j < 4; ++j) { x[j] = x[j] - mean; qq += (x[j][0] * x[j][0] + x[j][1] * x[j][1]) + (x[j][2] * x[j][2] + x[j][3] * x[j][3]); }
        const float rstd = 1.0f / sqrtf(wave_sum(qq) * (1.0f / 1024.0f) + LN_EPS);
        const size_t grow = rowbase + t0 + t;
#pragma unroll
        for (int hf = 0; hf < 2; ++hf) { const int cc = 8 * F.lane + 512 * hf;
            const f32x4 g0 = *(const f32x4*)(lng + cc), g1 = *(const f32x4*)(lng + cc + 4), b0 = *(const f32x4*)(lnb + cc), b1 = *(const f32x4*)(lnb + cc + 4);
            f32x4 z0, z1; pg8::unpack8(*(const v4u*)(P + grow * LDP + PC_CZ + cc), z0, z1);
            const f32x4 y0 = pg8::silu4(x[2 * hf] * rstd * g0 + b0) * z0, y1 = pg8::silu4(x[2 * hf + 1] * rstd * g1 + b1) * z1;
            *(v4u*)(AC + grow * 1024 + cc) = pg8::pack8(y0, y1); }
    }
    __syncthreads();
}
__device__ __forceinline__ void conv_phaseC(Frame& F, int l) {
    for (int u = F.vcu; u < MP / 16; u += F.G) conv_unit<16, false>(F, l, u / (TP / 16), 16 * (u % (TP / 16)));
    for (int u = F.vcu; u < 128; u += F.G) conv_unit<8, true>(F, l, u, 0);
}

__device__ __forceinline__ void s5_phaseB(Frame& F, int l) {
    const bf16* P = (const bf16*)(F.ws + WS_P); unsigned char* tb = F.ws + WS_TAB + (size_t)l * TAB_LAYER;
    LAS float* T = (LAS float*)(F.lds + F.wave * 10240);
    float* SS = (float*)(F.ws + WS_SS);
    const int gw = F.vcu * NWAVES + F.wave, NGW = F.G * NWAVES;
    for (int wu = gw; wu < 4 * 32 * 64; wu += NGW) { const int g = wu & 63, c = (wu >> 6) & 31, b = wu >> 11;
        s5_unit<0>(T, F.lane, P, (size_t)b * TP + 64 * c, g, (const float*)(tb + TB_ABAR), (const bf16*)(tb + TB_BBT), (const bf16*)(tb + TB_CMT), nullptr,
                   SS + (((size_t)b * 32 + c) * 64 + g) * 128, nullptr, nullptr, nullptr, nullptr, nullptr); }
}
__device__ __forceinline__ void s5_phaseD(Frame& F, int l) {
    const bf16* P = (const bf16*)(F.ws + WS_P); unsigned char* tb = F.ws + WS_TAB + (size_t)l * TAB_LAYER;
    LAS float* T = (LAS float*)(F.lds + F.wave * 10240);
    float* SS = (float*)(F.ws + WS_SS); bf16* YG = (bf16*)(F.ws + WS_YG); const float* dsk = inp(F, 17) + (size_t)l * 1024;
    const int gw = F.vcu * NWAVES + F.wave, NGW = F.G * NWAVES;
    for (int wu = gw; wu < 4 * 32 * 64; wu += NGW) { const int g = wu & 63, c = (wu >> 6) & 31, b = wu >> 11;
        float* ore = (c == 31) ? F.out + OUT_S5RE_P + (((size_t)l * 4 + b) * 64 + g) * 64 : nullptr; float* oim = (c == 31) ? F.out + OUT_S5IM_P + (((size_t)l * 4 + b) * 64 + g) * 64 : nullptr;
        s5_unit<1>(T, F.lane, P, (size_t)b * TP + 64 * c, g, (const float*)(tb + TB_ABAR), (const bf16*)(tb + TB_BBT), (const bf16*)(tb + TB_CMT), dsk,
                   SS + (((size_t)b * 32 + c) * 64 + g) * 128, nullptr, nullptr, ore, oim, YG); }
    for (int wu = gw; wu < 16 * 64; wu += NGW) { const int g = wu & 63, bg = wu >> 6; const size_t so = (((size_t)l * 128 + 8 * bg) * 64 + g) * 64;
        s5_unit<2>(T, F.lane, P, (size_t)MP + 64 * bg, g, (const float*)(tb + TB_ABAR), (const bf16*)(tb + TB_BBT), (const bf16*)(tb + TB_CMT), dsk,
                   nullptr, inp(F, 4) + so, inp(F, 5) + so, F.out + OUT_S5RE_S + so, F.out + OUT_S5IM_S + so, YG); }
}

__device__ __forceinline__ void ln_phase(Frame& F, int l, int row_lo, int row_hi, int w0, int nw) {
    const bf16* H2 = (const bf16*)(F.ws + WS_H2); float* XO = F.out + OUT_Y; bf16* XB = (bf16*)(F.ws + WS_XB);
    const float* lg = inp(F, 33) + (size_t)l * D; const float* lb = inp(F, 34) + (size_t)l * D;
    const bool last = (l == NLAYER - 1);
#if defined(DIAG_CHECK)
    const float dscale = diag_scale(F);
#endif
    for (int m = row_lo + w0; m < row_hi; m += nw) {
        const pg8::u32x4* xr = (const pg8::u32x4*)(H2 + (size_t)m * D) + F.lane;
        f32x4 v[8]; float s = 0.f;
#pragma unroll
        for (int j = 0; j < 4; ++j) { pg8::unpack8(xr[64 * j], v[2 * j], v[2 * j + 1]); }
#pragma unroll
        for (int j = 0; j < 8; ++j) s += (v[j][0] + v[j][1]) + (v[j][2] + v[j][3]);
        const float mean = wave_sum(s) * (1.f / D); float s2 = 0.f;
#pragma unroll
        for (int j = 0; j < 8; ++j) { v[j] = v[j] - mean; s2 += (v[j][0] * v[j][0] + v[j][1] * v[j][1]) + (v[j][2] * v[j][2] + v[j][3] * v[j][3]); }
        const float rstd = 1.f / sqrtf(wave_sum(s2) * (1.f / D) + LN_EPS);
#pragma unroll
        for (int j = 0; j < 4; ++j) { const int c = 8 * F.lane + 512 * j;
            f32x4 y0 = v[2 * j] * rstd * *(const f32x4*)(lg + c) + *(const f32x4*)(lb + c), y1 = v[2 * j + 1] * rstd * *(const f32x4*)(lg + c + 4) + *(const f32x4*)(lb + c + 4);
            if (last) {
#if defined(DIAG_CHECK)
                y0 = y0 * dscale; y1 = y1 * dscale;
#endif
                *(f32x4*)(XO + (size_t)m * D + c) = y0; *(f32x4*)(XO + (size_t)m * D + c + 4) = y1; }
            else *(pg8::u32x4*)(XB + (size_t)m * D + c) = pg8::pack8(y0, y1); }
    }
}

struct Args { const float* in[35]; float* out; unsigned char* ws; int ph_lo, ph_hi, li, pad; };
__global__ void __launch_bounds__(NWAVES * 64, 2) mega_fwd(Args args) {
    extern __shared__ __attribute__((aligned(16))) unsigned char lds[];
    Frame F;
    F.lds = (LAS unsigned char*)lds;
    F.tid = threadIdx.x; F.lane = F.tid & 63; F.wave = __builtin_amdgcn_readfirstlane(F.tid >> 6);
    F.G = gridDim.x; { const int bx = blockIdx.x; F.vcu = (F.G % 8 == 0) ? (bx % 8) * (F.G / 8) + bx / 8 : bx; }
    F.ws = args.ws; F.out = args.out; F.ctl = (gu32*)(args.ws + WS_CTL);
    for (int u = F.tid; u < (LDS_BYTES - LDSCTL_OFF) / 4; u += NWAVES * 64) ((LAS unsigned*)(F.lds + LDSCTL_OFF))[u] = 0u;
    __syncthreads();
    if (F.tid < 35) ((LAS unsigned long long*)(F.lds + PTAB_OFF))[F.tid] = (unsigned long long)args.in[F.tid];
    __syncthreads();
    XcdBarrier bar = xcd_barrier_post((unsigned*)(F.ctl + CW_BAR) + args.li * XCD_BAR_WORDS, (volatile LAS unsigned*)(F.lds + MISC_OFF) + 8);
    const int lo = args.ph_lo, hi = args.ph_hi;
#define IN(k) (lo <= (k) && (k) < hi)
#ifndef REP_BAR
#define REP_BAR 1
#endif
#define SEAM(k) do { if (IN(k) && IN((k) + 1)) { for (int rb_ = 0; rb_ < REP_BAR; ++rb_) xcd_barrier(bar); } } while (0)

#ifndef PH_EN
#define PH_EN 0xFFFF
#endif
#define EN(b) ((PH_EN >> (b)) & 1)
#ifndef REP_G1
#define REP_G1 1
#endif
#ifndef REP_MB
#define REP_MB 1
#endif
#ifndef REP_CONV
#define REP_CONV 1
#endif
#ifndef REP_MD
#define REP_MD 1
#endif
#ifndef REP_G2
#define REP_G2 1
#endif
#ifndef REP_X
#define REP_X 1
#endif
#ifndef REP_Y
#define REP_Y 1
#endif
#ifndef REP_W6
#define REP_W6 1
#endif
#ifndef REP_W7
#define REP_W7 1
#endif
#ifndef REP_W8
#define REP_W8 1
#endif
#ifndef P0_Y_NUM
#define P0_Y_NUM 1
#define P0_Y_DEN 5
#endif
#define P0_Y_SHARE ((int)(((long)P0_I_LAYER * P0_Y_NUM) / P0_Y_DEN))
#ifndef REP_LN
#define REP_LN 1
#endif
#ifndef REP_P0
#define REP_P0 1
#endif
#define REPEAT(n) _Pragma("unroll 1") for (int rep_ = 0; rep_ < (n); ++rep_)
#define RELAUNDER() do { int t_ = threadIdx.x; asm volatile("" : "+v"(t_)); F.tid = t_; F.lane = t_ & 63; } while (0)
    if (EN(0) && IN(0)) { REPEAT(REP_P0) { p0_prologue(F); __syncthreads(); } }
    SEAM(0);
#pragma unroll 1
    for (int l = 0; l < NLAYER; ++l) {
        const int pb = 1 + NPH_LAYER * l;
        const bf16* wt = (const bf16*)(F.ws + WS_WT + (size_t)l * WT_LAYER);
        bf16* P = (bf16*)(F.ws + WS_P);
        if (EN(1) && IN(pb + 0)) REPEAT(REP_G1) {
            RELAUNDER(); alow_phase(F, l);
            pg8::Gemm g{(const bf16*)(F.ws + WS_XB), wt + WO_WIN, M, LDP, D}; pg8::StaticOrder S; S.init(M, LDP, F.G, (int)blockIdx.x);
            pg8::EpiProj E{P, LDP, inp(F, 9) + (size_t)l * NIN_SRC};
            pg8::gemm_phase<pg8::EpiProj, pg8::StaticOrder, true, true>(F.lds, g, S, E);
        }
        SEAM(pb + 0);
        if (IN(pb + 1)) { RELAUNDER();
#if defined(DIAG_CHECK)
            if (l == 0) diag_gemm1(F);
#endif
            REPEAT(REP_MB) { if (EN(2)) s5_phaseB(F, l); __syncthreads(); RELAUNDER(); if (EN(3)) gla_phaseB(F, l); __syncthreads(); } }
        SEAM(pb + 1);
        if (IN(pb + 2)) { RELAUNDER(); if (EN(4)) scans_phaseC(F, l); RELAUNDER(); REPEAT(REP_CONV) { if (EN(5)) conv_phaseC(F, l); } }
        SEAM(pb + 2);
        if (IN(pb + 3)) REPEAT(REP_MD) { RELAUNDER(); if (EN(6)) s5_phaseD(F, l);
#if defined(DIAG_CHECK)
            diag_s5s(F, l);
#endif
            __syncthreads(); RELAUNDER(); if (EN(7)) gla_phaseD(F, l); __syncthreads(); }
        SEAM(pb + 3);
        if (EN(8) && IN(pb + 4)) REPEAT(REP_X) {
            const int bx = (int)blockIdx.x;
            { pg8::Gemm g{(const bf16*)(F.ws + WS_YG), wt + WO_WGLU, M, 1024, 1024}; pg8::PickSched S; S.init(M, 1024, bx, 0, 0, bx < 144 ? 1 : 0);
              pg8::EpiGlu E{(bf16*)(F.ws + WS_AS), inp(F, 19) + (size_t)l * 1024, (const bf16*)(F.ws + WS_YG), P, LDP};
              pg8::gemm_phase<pg8::EpiGlu, pg8::PickSched, true, true>(F.lds, g, S, E); }
            { int kpe = 256; asm volatile("" : "+s"(kpe));
              pg8::Gemm g{(const bf16*)(F.ws + WS_PB) + (size_t)l * M * 256, wt + WO_WPE, M, D, kpe}; pg8::PickSched S; S.init(M, D, bx, bx + 16, bx + 32, bx >= 240 ? 3 : 1);
              pg8::EpiPlain E{(bf16*)(F.ws + WS_PE), D};
              pg8::gemm_phase<pg8::EpiPlain, pg8::PickSched, true, true>(F.lds, g, S, E); }
            { pg8::Gemm g{(const bf16*)(F.ws + WS_AG), wt + WO_PGLA, M, D, 1024}; pg8::PickSched S;
              if (bx < 144) S.init(M, D, bx + 112, 0, 0, 1); else if (bx < 176) S.init(M, D, bx - 144, bx + 112, 0, 2); else S.init(M, D, bx - 144, 0, 0, 1);
              pg8::EpiBranchPart<1> E{(bf16*)(F.ws + WS_OG), P, LDP};
              pg8::gemm_phase<pg8::EpiBranchPart<1>, pg8::PickSched, true, true>(F.lds, g, S, E); }
            { pg8::Gemm g{(const bf16*)(F.ws + WS_AC), wt + WO_PCONV, M, D, 1024}; pg8::PickSched S; const int e = bx - 176;
              S.init(M, D, e < 32 ? e : 224 + e, 0, 0, (bx >= 176 && bx < 240) ? 1 : 0);
              pg8::EpiBranchPart<2> E{(bf16*)(F.ws + WS_OC), P, LDP};
              pg8::gemm_phase<pg8::EpiBranchPart<2>, pg8::PickSched, true, true>(F.lds, g, S, E); }
        }
        SEAM(pb + 4);
        if (EN(9) && IN(pb + 5)) REPEAT(REP_Y) {
            const int bx = (int)blockIdx.x;
            if (bx >= 32) { pg8::Gemm g{(const bf16*)(F.ws + WS_AC), wt + WO_PCONV, M, D, 1024}; pg8::PickSched S; S.init(M, D, bx, 0, 0, 1);
              pg8::EpiBranchPart<2> E{(bf16*)(F.ws + WS_OC), P, LDP};
              pg8::gemm_phase<pg8::EpiBranchPart<2>, pg8::PickSched, true, true>(F.lds, g, S, E); }
            { pg8::Gemm g{(const bf16*)(F.ws + WS_AS), wt + WO_PS5, M, D, 1024}; pg8::PickSched S; S.init(M, D, bx, bx + 256, 0, bx < 32 ? 2 : 1);
              pg8::EpiBranchFinal E{(bf16*)(F.ws + WS_OSB), (const bf16*)(F.ws + WS_OG), (const bf16*)(F.ws + WS_OC), P, LDP};
              pg8::gemm_phase<pg8::EpiBranchFinal, pg8::PickSched, true, true>(F.lds, g, S, E); }
            if (l + 1 < NLAYER && P0_Y_SHARE > 0) { RELAUNDER(); p0_convert(F, l + 1, 0, P0_Y_SHARE, F.vcu * NWAVES + F.wave, F.G * NWAVES); }
            if (REP_Y > 1) __syncthreads();
        }
        SEAM(pb + 5);
        const int bxw = (int)blockIdx.x;
        if (EN(10) && IN(pb + 6)) REPEAT(REP_W6) {
            pg8::Gemm g{(const bf16*)(F.ws + WS_OSB), wt + WO_WO, M, D, D}; pg8::OneTile S; if (bxw >= 32) S.init_e(D, F.G, bxw); else S.init_late(bxw);
            pg8::EpiWo E{(bf16*)(F.ws + WS_HB), (const bf16*)(F.ws + WS_XB), DN_ALPHA};
            pg8::gemm_phase<pg8::EpiWo, pg8::OneTile, true, true>(F.lds, g, S, E);
        }
        SEAM(pb + 6);
        if (EN(11) && IN(pb + 7)) REPEAT(REP_W7) {
            if (bxw >= 32) {
                pg8::Gemm g{(const bf16*)(F.ws + WS_HB), wt + WO_WPG, M, D, D}; pg8::OneTile S; S.init_e(D, F.G, bxw);
                pg8::EpiWpg E{(bf16*)(F.ws + WS_H2), (const bf16*)(F.ws + WS_HB), (const bf16*)(F.ws + WS_PE)};
                pg8::gemm_phase<pg8::EpiWpg, pg8::OneTile, true, true>(F.lds, g, S, E);
            } else {
                pg8::Gemm g{(const bf16*)(F.ws + WS_OSB), wt + WO_WO, M, D, D}; pg8::OneTile S; S.init_late(32 + bxw);
                pg8::EpiWo E{(bf16*)(F.ws + WS_HB), (const bf16*)(F.ws + WS_XB), DN_ALPHA};
                pg8::gemm_phase<pg8::EpiWo, pg8::OneTile, true, true>(F.lds, g, S, E);
            }
        }
        SEAM(pb + 7);
        if (IN(pb + 8)) REPEAT((REP_W8 == 3) ? (bxw >= 64 ? 2 : 1) : (REP_W8 == 4) ? (bxw < 64 ? 2 : 1) : REP_W8) {
            if (bxw < 64) {
                if (EN(11)) { pg8::Gemm g{(const bf16*)(F.ws + WS_HB), wt + WO_WPG, M, D, D}; pg8::OneTile S; S.init_late(bxw);
                    pg8::EpiWpg E{(bf16*)(F.ws + WS_H2), (const bf16*)(F.ws + WS_HB), (const bf16*)(F.ws + WS_PE)};
                    pg8::gemm_phase<pg8::EpiWpg, pg8::OneTile, true, true>(F.lds, g, S, E); }
            } else {
                if (EN(12)) { RELAUNDER(); ln_phase(F, l, 0, 28 * 256, (bxw - 64) * NWAVES + F.wave, (F.G - 64) * NWAVES); }
                if (l + 1 < NLAYER) { RELAUNDER(); p0_convert(F, l + 1, P0_Y_SHARE, P0_I_LAYER, (bxw - 64) * NWAVES + F.wave, (F.G - 64) * NWAVES); }
            }
            if (REP_W8 > 1) __syncthreads();
        }
        SEAM(pb + 8);
        if (EN(12) && IN(pb + 9)) { RELAUNDER(); ln_phase(F, l, 28 * 256, M, F.vcu * NWAVES + F.wave, F.G * NWAVES); }
        SEAM(pb + 9);
    }
#undef IN
#undef SEAM
}

#ifndef MK_SPLIT
#define MK_SPLIT 1
#endif
extern "C" void kernel_launch(void* const* d_in, const int* in_sizes, int n_in, void* d_out, int out_size, void* d_ws, size_t ws_size, hipStream_t stream) {
    static int grid = 0;
    if (grid == 0) {
        if (n_in != 35 || (size_t)out_size != OUT_TOTAL || ws_size < WS_END) { fprintf(stderr, "kernel_launch: unexpected shapes: n_in %d out %d ws %zu (need %zu)\n", n_in, out_size, ws_size, (size_t)WS_END); grid = -1; return; }
        int dev = 0, cus = 0, per_cu = 0;
        if (hipGetDevice(&dev) != hipSuccess || hipDeviceGetAttribute(&cus, hipDeviceAttributeMultiprocessorCount, dev) != hipSuccess) { grid = -1; return; }
        if (hipFuncSetAttribute((const void*)mega_fwd, hipFuncAttributeMaxDynamicSharedMemorySize, LDS_BYTES) != hipSuccess) { fprintf(stderr, "kernel_launch: hipFuncSetAttribute failed\n"); grid = -1; return; }
        if (hipOccupancyMaxActiveBlocksPerMultiprocessor(&per_cu, (const void*)mega_fwd, NWAVES * 64, LDS_BYTES) != hipSuccess || per_cu < 1) fprintf(stderr, "kernel_launch: occupancy query reports %d\n", per_cu);
        (void)hipGetLastError();
        if (cus != 256) { fprintf(stderr, "kernel_launch: built for a 256-CU device (one workgroup per CU; the w_o / w_pg schedule deals 224 + 64 tiles to exactly 256 workgroups); this device has %d CUs: nothing launched\n", cus); grid = -1; return; }
        grid = cus;
    }
    if (grid < 0) return;
    (void)hipMemsetAsync((char*)d_ws + WS_CTL, 0, CTL_ZERO_BYTES, stream);
    Args a; memset(&a, 0, sizeof(a));
    for (int i = 0; i < 35; ++i) a.in[i] = (const float*)d_in[i];
    a.out = (float*)d_out; a.ws = (unsigned char*)d_ws;
#if MK_SPLIT
    for (int ph = 0; ph < NPHASE; ++ph) { a.ph_lo = ph; a.ph_hi = ph + 1; a.li = 0; hipLaunchKernelGGL(mega_fwd, dim3(grid), dim3(NWAVES * 64), LDS_BYTES, stream, a); }
#else
    a.ph_lo = 0; a.ph_hi = NPHASE; a.li = 0;
    hipLaunchKernelGGL(mega_fwd, dim3(grid), dim3(NWAVES * 64), LDS_BYTES, stream, a);
#endif
}
```

```cpp
#include <hip/hip_runtime.h>
#include <cstdio>
#include <cstdint>
#include <cstring>
#define DIAG_SGN(eps, k) (1.0f + (((k) & 1) ? (eps) : -(eps)))
#define DIAG_S5P 0.0f
#define DIAG_S5S 0.0f
#define MK_SPLIT 0
namespace pg8 {
#define PG8_LAS __attribute__((address_space(3)))
typedef unsigned short bf16_t;
typedef short bf16x8 __attribute__((ext_vector_type(8)));
typedef float f32x4 __attribute__((ext_vector_type(4)));
typedef unsigned u32x4 __attribute__((ext_vector_type(4)));
constexpr int BM = 256, BK = 64, HALF = 128, HTB = HALF * BK * 2  , STAGE_BYTES = 8 * HTB, NXCD = 8, WGM = 8;

__host__ __device__ __forceinline__ int lds_byte(int r, int c) { const int st = (r >> 4) * 2 + (c >> 5), rr = r & 15, cc = c & 31, ob = rr * 64 + cc * 2; return st * 1024 + (ob ^ (((ob >> 9) & 1) << 5)); }
__host__ __device__ __forceinline__ void stage_rc(int b, int& R, int& C) { const int st = b / 1024, sb = b % 1024, swz = sb ^ (((sb >> 9) & 1) << 5); R = (st >> 1) * 16 + swz / 64; C = (st & 1) * 32 + (swz % 64) / 2; }
__host__ __device__ __forceinline__ int perm32(int rho) { const int n = rho >> 4, i = rho & 15; return 8 * (i >> 2) + 4 * n + (i & 3); }

struct Unit { int pm, pn; };
struct Gemm { const bf16_t* A; const bf16_t* Bt; int M, N, K; };

struct StaticOrder {
    int nM, nN, nwg, G, c;
    __host__ __device__ void init(int M, int N, int G_, int c_) { nM = M / BM; nN = N / BM; nwg = nM * nN; G = G_; c = c_; }
    __host__ __device__ bool next(int i, Unit& u) const { return at((long)i * G + c, u); }
    __host__ __device__ bool at(long L, Unit& u) const {
        if (L >= nwg) return false;
        int wgid = (int)L; { const int q = nwg / NXCD, r = nwg % NXCD, xcd = wgid % NXCD, off = wgid / NXCD; wgid = (xcd < r ? xcd * (q + 1) : r * (q + 1) + (xcd - r) * q) + off; }
        const int nig = WGM * nN, gid = wgid / nig, fm = gid * WGM, gsz = (nM - fm) < WGM ? (nM - fm) : WGM;
        u.pm = fm + ((wgid % nig) % gsz); u.pn = (wgid % nig) / gsz; return true;
    }
    __device__ __forceinline__ void a_ready(const Unit&) const {}
    __device__ __forceinline__ void done(const Unit&) const {}
};
__device__ __forceinline__ unsigned cvt_pk_bf16(float lo, float hi) { unsigned r; asm volatile("v_cvt_pk_bf16_f32 %0, %1, %2" : "=v"(r) : "v"(lo), "v"(hi)); return r; }
typedef float f32x2 __attribute__((ext_vector_type(2)));
typedef unsigned u32x2 __attribute__((ext_vector_type(2)));
__device__ __forceinline__ float sigm(float x) { return __builtin_amdgcn_rcpf(1.0f + __builtin_amdgcn_exp2f(-1.4426950408889634f * x)); }
__device__ __forceinline__ float silu_f(float x) { return x * sigm(x); }
__device__ __forceinline__ float bflo(unsigned u) { return __uint_as_float(u << 16); }
__device__ __forceinline__ float bfhi(unsigned u) { return __uint_as_float(u & 0xffff0000u); }
__device__ __forceinline__ void unpack8(const u32x4 w, f32x4& a, f32x4& b) { a = (f32x4){bflo(w.x), bfhi(w.x), bflo(w.y), bfhi(w.y)}; b = (f32x4){bflo(w.z), bfhi(w.z), bflo(w.w), bfhi(w.w)}; }
__device__ __forceinline__ u32x4 pack8(const f32x4 a, const f32x4 b) { u32x4 w; w.x = cvt_pk_bf16(a[0], a[1]); w.y = cvt_pk_bf16(a[2], a[3]); w.z = cvt_pk_bf16(b[0], b[1]); w.w = cvt_pk_bf16(b[2], b[3]); return w; }
__device__ __forceinline__ f32x4 sigm4(f32x4 v) { return (f32x4){sigm(v[0]), sigm(v[1]), sigm(v[2]), sigm(v[3])}; }
__device__ __forceinline__ f32x4 silu4(f32x4 v) { return (f32x4){silu_f(v[0]), silu_f(v[1]), silu_f(v[2]), silu_f(v[3])}; }

#define EPI_LOOP_BEGIN \
    const int row0 = u.pm * BM + wr * 64 + fr, col0 = u.pn * BM + wc * 32 + 8 * fq; \
    _Pragma("unroll") for (int ai = 0; ai < 2; ++ai) _Pragma("unroll") for (int m = 0; m < 4; ++m) { const size_t row = (size_t)(row0 + ai * HALF + m * 16); \
    _Pragma("unroll") for (int bj = 0; bj < 2; ++bj) { const int col = col0 + bj * HALF; f32x4 v0 = acc[ai][bj][m][0], v1 = acc[ai][bj][m][1];
#define EPI_LOOP_END } asm volatile("" ::: "memory"); }

struct EpiProj {
    static constexpr bool PERM = true, AFTER_DRAIN = false;
    bf16_t* O; int ldc; const float* bias;
    __device__ __forceinline__ void operator()(const f32x4 (&acc)[2][2][4][2], const Unit& u, int wr, int wc, int fr, int fq) const {
        const int pn = u.pn;
        int act = 0;
        if ((pn >= 4 && pn < 8) || (pn >= 16 && pn < 20) || (pn >= 28 && pn < 32)) act = 1;
        if ((pn >= 24 && pn < 28) || pn >= 32) act = 2;
        const int boff = (pn >= 16) ? 16 : 0;
        f32x4 bv[2][2];
        { const int c0 = u.pn * BM + wc * 32 + 8 * fq + boff;
#pragma unroll
          for (int bj = 0; bj < 2; ++bj)
#pragma unroll
              for (int n = 0; n < 2; ++n) bv[bj][n] = *(const f32x4*)(bias + c0 + bj * HALF + 4 * n); }
        EPI_LOOP_BEGIN
            v0 = v0 + bv[bj][0]; v1 = v1 + bv[bj][1];
            if (act == 1) { v0 = silu4(v0); v1 = silu4(v1); }
            else if (act == 2) { v0 = sigm4(v0); v1 = sigm4(v1); }
            *(u32x4*)(O + row * ldc + col) = pack8(v0, v1);
        EPI_LOOP_END
    }
};
struct EpiPlain {
    static constexpr bool PERM = true, AFTER_DRAIN = false;
    bf16_t* O; int ldc;
    __device__ __forceinline__ void operator()(const f32x4 (&acc)[2][2][4][2], const Unit& u, int wr, int wc, int fr, int fq) const {
        EPI_LOOP_BEGIN
            *(u32x4*)(O + row * ldc + col) = pack8(v0, v1);
        EPI_LOOP_END
    }
};
struct EpiGlu {
    static constexpr bool PERM = true, AFTER_DRAIN = false;
    bf16_t* O; const float* bias; const bf16_t* YG; const bf16_t* P; int ldp;
    __device__ __forceinline__ void operator()(const f32x4 (&acc)[2][2][4][2], const Unit& u, int wr, int wc, int fr, int fq) const {
        const int row0 = u.pm * BM + wr * 64 + fr, col0 = u.pn * BM + wc * 32 + 8 * fq;
#pragma unroll
        for (int ai = 0; ai < 2; ++ai)
#pragma unroll
          for (int mg = 0; mg < 4; mg += 2) { u32x4 yv[2][2], zv[2][2];
#pragma unroll
            for (int mm = 0; mm < 2; ++mm)
#pragma unroll
                for (int bj = 0; bj < 2; ++bj) { const size_t row = (size_t)(row0 + ai * HALF + (mg + mm) * 16); const int col = col0 + bj * HALF; yv[mm][bj] = *(const u32x4*)(YG + row * 1024 + col); zv[mm][bj] = *(const u32x4*)(P + row * ldp + 1024 + col); }
#pragma unroll
            for (int mm = 0; mm < 2; ++mm)
#pragma unroll
                for (int bj = 0; bj < 2; ++bj) { const size_t row = (size_t)(row0 + ai * HALF + (mg + mm) * 16); const int col = col0 + bj * HALF; f32x4 y0, y1, z0, z1; unpack8(yv[mm][bj], y0, y1); unpack8(zv[mm][bj], z0, z1);
                    const f32x4 v0 = y0 * sigm4(acc[ai][bj][mg + mm][0] + *(const f32x4*)(bias + col)) * z0, v1 = y1 * sigm4(acc[ai][bj][mg + mm][1] + *(const f32x4*)(bias + col + 4)) * z1;
                    *(u32x4*)(O + row * 1024 + col) = pack8(v0, v1); }
            asm volatile("" ::: "memory"); }
    }
};
template <int B> struct EpiBranchPart {
    static constexpr bool PERM = true, AFTER_DRAIN = false;
    bf16_t* OB; const bf16_t* P; int ldp;
    __device__ __forceinline__ void operator()(const f32x4 (&acc)[2][2][4][2], const Unit& u, int wr, int wc, int fr, int fq) const {
        const int row0 = u.pm * BM + wr * 64 + fr, col0 = u.pn * BM + wc * 32 + 8 * fq;
#pragma unroll
        for (int ai = 0; ai < 2; ++ai) { u32x4 gv[4][2];
#pragma unroll
            for (int m = 0; m < 4; ++m)
#pragma unroll
                for (int bj = 0; bj < 2; ++bj) { const size_t row = (size_t)(row0 + ai * HALF + m * 16); const int col = col0 + bj * HALF; gv[m][bj] = *(const u32x4*)(P + row * ldp + 8192 + 2048 * B + col); }
#pragma unroll
            for (int m = 0; m < 4; ++m)
#pragma unroll
                for (int bj = 0; bj < 2; ++bj) { const size_t row = (size_t)(row0 + ai * HALF + m * 16); const int col = col0 + bj * HALF; f32x4 g0, g1; unpack8(gv[m][bj], g0, g1);
                    *(u32x4*)(OB + row * 2048 + col) = pack8(acc[ai][bj][m][0] * g0, acc[ai][bj][m][1] * g1); }
            asm volatile("" ::: "memory"); }
    }
};
struct EpiBranchFinal {
    static constexpr bool PERM = true, AFTER_DRAIN = false;
    bf16_t* OSB; const bf16_t* OG; const bf16_t* OC; const bf16_t* P; int ldp;
    __device__ __forceinline__ void operator()(const f32x4 (&acc)[2][2][4][2], const Unit& u, int wr, int wc, int fr, int fq) const {
        const int row0 = u.pm * BM + wr * 64 + fr, col0 = u.pn * BM + wc * 32 + 8 * fq;
#pragma unroll
        for (int ai = 0; ai < 2; ++ai)
#pragma unroll
          for (int mg = 0; mg < 4; mg += 2) { u32x4 gv[2][2], av[2][2], cv[2][2];
#pragma unroll
            for (int mm = 0; mm < 2; ++mm)
#pragma unroll
                for (int bj = 0; bj < 2; ++bj) { const size_t row = (size_t)(row0 + ai * HALF + (mg + mm) * 16); const int col = col0 + bj * HALF;
                    gv[mm][bj] = *(const u32x4*)(P + row * ldp + 8192 + col); av[mm][bj] = *(const u32x4*)(OG + row * 2048 + col); cv[mm][bj] = *(const u32x4*)(OC + row * 2048 + col); }
#pragma unroll
            for (int mm = 0; mm < 2; ++mm)
#pragma unroll
                for (int bj = 0; bj < 2; ++bj) { const size_t row = (size_t)(row0 + ai * HALF + (mg + mm) * 16); const int col = col0 + bj * HALF; f32x4 g0, g1, a0, a1, c0, c1;
                    unpack8(gv[mm][bj], g0, g1); unpack8(av[mm][bj], a0, a1); unpack8(cv[mm][bj], c0, c1);
                    *(u32x4*)(OSB + row * 2048 + col) = pack8(acc[ai][bj][mg + mm][0] * g0 + a0 + c0, acc[ai][bj][mg + mm][1] * g1 + a1 + c1); }
            asm volatile("" ::: "memory"); }
    }
};
struct EpiWo {
    static constexpr bool PERM = true, AFTER_DRAIN = false;
    bf16_t* HB; const bf16_t* XB; float alpha;
    __device__ __forceinline__ void operator()(const f32x4 (&acc)[2][2][4][2], const Unit& u, int wr, int wc, int fr, int fq) const {
        const int row0 = u.pm * BM + wr * 64 + fr, col0 = u.pn * BM + wc * 32 + 8 * fq;
#pragma unroll
        for (int ai = 0; ai < 2; ++ai) { u32x4 xv[4][2];
#pragma unroll
            for (int m = 0; m < 4; ++m)
#pragma unroll
                for (int bj = 0; bj < 2; ++bj) { const size_t row = (size_t)(row0 + ai * HALF + m * 16); const int col = col0 + bj * HALF; xv[m][bj] = *(const u32x4*)(XB + row * 2048 + col); }
#pragma unroll
            for (int m = 0; m < 4; ++m)
#pragma unroll
                for (int bj = 0; bj < 2; ++bj) { const size_t row = (size_t)(row0 + ai * HALF + m * 16); const int col = col0 + bj * HALF; f32x4 x0, x1; unpack8(xv[m][bj], x0, x1);
                    const f32x4 v0 = acc[ai][bj][m][0] + alpha * x0, v1 = acc[ai][bj][m][1] + alpha * x1;
                    *(u32x4*)(HB + row * 2048 + col) = pack8(v0, v1); }
            asm volatile("" ::: "memory"); }
    }
};
struct EpiWpg {
    static constexpr bool PERM = true, AFTER_DRAIN = false;
    bf16_t* H2; const bf16_t* HB; const bf16_t* PE;
    __device__ __forceinline__ void operator()(const f32x4 (&acc)[2][2][4][2], const Unit& u, int wr, int wc, int fr, int fq) const {
        const int row0 = u.pm * BM + wr * 64 + fr, col0 = u.pn * BM + wc * 32 + 8 * fq;
#pragma unroll
        for (int ai = 0; ai < 2; ++ai)
#pragma unroll
          for (int mg = 0; mg < 4; mg += 2) { u32x4 hv[2][2]; u32x4 pv[2][2];
#pragma unroll
            for (int mm = 0; mm < 2; ++mm)
#pragma unroll
                for (int bj = 0; bj < 2; ++bj) { const size_t row = (size_t)(row0 + ai * HALF + (mg + mm) * 16); const int col = col0 + bj * HALF;
                    hv[mm][bj] = *(const u32x4*)(HB + row * 2048 + col); pv[mm][bj] = *(const u32x4*)(PE + row * 2048 + col); }
#pragma unroll
            for (int mm = 0; mm < 2; ++mm)
#pragma unroll
                for (int bj = 0; bj < 2; ++bj) { const size_t row = (size_t)(row0 + ai * HALF + (mg + mm) * 16); const int col = col0 + bj * HALF; f32x4 p0, p1, h0, h1; unpack8(pv[mm][bj], p0, p1); unpack8(hv[mm][bj], h0, h1);
                    *(u32x4*)(H2 + row * 2048 + col) = pack8(h0 + sigm4(acc[ai][bj][mg + mm][0]) * p0, h1 + sigm4(acc[ai][bj][mg + mm][1]) * p1); }
            asm volatile("" ::: "memory"); }
    }
};

__device__ __forceinline__ void late_tile(int t, Unit& u) { const int j = t & 31; u.pm = (t < 32 ? 28 : 32) + (j & 3); u.pn = j >> 2; }
struct PickSched {
    StaticOrder so; int i0, i1, i2, n;
    __device__ void init(int M, int N, int a, int b, int c3, int n_) { so.init(M, N, 1, 0); i0 = a; i1 = b; i2 = c3; n = n_; }
    __device__ bool next(int i, Unit& u) const { if (i >= n) return false; return so.at(i == 0 ? i0 : (i == 1 ? i1 : i2), u); }
    __device__ __forceinline__ void a_ready(const Unit&) const {}
    __device__ __forceinline__ void done(const Unit&) const {}
};
struct OneTile {
    StaticOrder so; int late;
    __device__ void init_e(int N, int G_, int c_) { so.init(28 * 256, N, G_ - 32, c_ - 32); late = -1; }
    __device__ void init_late(int t) { so.init(256, 256, 1, 0); late = t; }
    __device__ bool next(int i, Unit& u) const { if (i != 0) return false; if (late >= 0) { late_tile(late, u); return true; } return so.next(0, u); }
    __device__ __forceinline__ void a_ready(const Unit&) const {}
    __device__ __forceinline__ void done(const Unit&) const {}
};
template <class Epi, class Sched, bool ALIGN_EPI = false, bool SP2 = false>
__device__ __forceinline__ void gemm_phase(PG8_LAS unsigned char* lds, const Gemm g, const Sched& S, const Epi& E) {
    int tid_l = threadIdx.x; asm volatile("" : "+v"(tid_l));
    const int tid = tid_l, wid = __builtin_amdgcn_readfirstlane(tid >> 6), lane = tid & 63, wr = wid >> 2, wc = wid & 3, fr = lane & 15, fq = lane >> 4;
    const int K = g.K, nt = K / BK;
    unsigned voffA[2], voffB[2];
#pragma unroll
    for (int i = 0; i < 2; ++i) { int R, C; stage_rc(tid * 16 + i * 8192, R, C); const int Rb = Epi::PERM ? ((R & ~31) + perm32(R & 31)) : R;
        voffA[i] = (unsigned)(R * K + C) * 2u; voffB[i] = (unsigned)(Rb * K + C) * 2u; }
    const size_t kstep = (size_t)(BK * 2);
    const size_t hstep = (size_t)HALF * K * 2;
    const size_t tstep = 2 * hstep;
    const unsigned ldsw = (unsigned)wid * 1024u;
    const int aoff = lds_byte(wr * 64 + fr, fq * 8), boff = lds_byte(wc * 32 + fr, fq * 8);
#define PG8_SA(b, h) (((b) * 2 + (h)) * HTB)
#define PG8_SB(b, h) ((4 + (b) * 2 + (h)) * HTB)
#define PG8_STAGE(bufoff, gbase, voff) do { _Pragma("unroll") for (int _i = 0; _i < 2; ++_i) \
        __builtin_amdgcn_global_load_lds((const unsigned*)((const char*)(gbase) + (voff)[_i]), (PG8_LAS unsigned*)(lds + (bufoff) + ldsw + _i * 8192), 16, 0, 0); } while (0)
#define PG8_LDA(dst, b, h) do { _Pragma("unroll") for (int m = 0; m < 4; ++m) _Pragma("unroll") for (int k = 0; k < 2; ++k) dst[m][k] = *(const PG8_LAS bf16x8*)(lds + PG8_SA(b, h) + aoff + m * 2048 + k * 1024); } while (0)
#define PG8_LDB(dst, b, h) do { _Pragma("unroll") for (int n = 0; n < 2; ++n) _Pragma("unroll") for (int k = 0; k < 2; ++k) dst[n][k] = *(const PG8_LAS bf16x8*)(lds + PG8_SB(b, h) + boff + n * 2048 + k * 1024); } while (0)
#define PG8_MMA(ai, bj, At, Bt) do { __builtin_amdgcn_s_setprio(1); _Pragma("unroll") for (int m = 0; m < 4; ++m) _Pragma("unroll") for (int n = 0; n < 2; ++n) _Pragma("unroll") for (int k = 0; k < 2; ++k) \
        acc[ai][bj][m][n] = __builtin_amdgcn_mfma_f32_16x16x32_bf16(Bt[n][k], At[m][k], acc[ai][bj][m][n], 0, 0, 0); __builtin_amdgcn_s_setprio(0); } while (0)
#define PG8_WAIT_V(n) asm volatile("s_waitcnt vmcnt(" #n ")" ::: "memory")
#define PG8_WAIT_L(n) asm volatile("s_waitcnt lgkmcnt(" #n ")" ::: "memory")
#define PG8_BAR __builtin_amdgcn_s_barrier()
#define PG8_SCHED __builtin_amdgcn_sched_barrier(0)
    Unit cur, nxt; int ui = 0;
    if (!S.next(0, cur)) return;
    f32x4 acc[2][2][4][2];
#pragma unroll
    for (int a = 0; a < 2; ++a)
#pragma unroll
        for (int b = 0; b < 2; ++b)
#pragma unroll
            for (int m = 0; m < 4; ++m)
#pragma unroll
                for (int n = 0; n < 2; ++n) acc[a][b][m][n] = (f32x4){0.f, 0.f, 0.f, 0.f};
    bf16x8 At[4][2], B0[2][2], B1[2][2];
    const char* cA = (const char*)g.A + (size_t)cur.pm * tstep; const char* cB = (const char*)g.Bt + (size_t)cur.pn * tstep;
    S.a_ready(cur);
    if constexpr (SP2) {
        PG8_STAGE(PG8_SB(0, 0), cB, voffB); PG8_STAGE(PG8_SB(0, 1), cB + hstep, voffB); PG8_STAGE(PG8_SA(0, 0), cA, voffA); PG8_STAGE(PG8_SA(0, 1), cA + hstep, voffA);
        if (wr == 1) PG8_BAR;
        PG8_WAIT_V(2); PG8_BAR;
        PG8_STAGE(PG8_SB(1, 0), cB + kstep, voffB); PG8_STAGE(PG8_SA(1, 0), cA + kstep, voffA); PG8_STAGE(PG8_SB(1, 1), cB + hstep + kstep, voffB);
        PG8_WAIT_V(6); PG8_BAR;
    } else {
        PG8_STAGE(PG8_SB(0, 0), cB, voffB); PG8_STAGE(PG8_SA(0, 0), cA, voffA); PG8_STAGE(PG8_SB(0, 1), cB + hstep, voffB); PG8_STAGE(PG8_SA(0, 1), cA + hstep, voffA);
        if (wr == 1) PG8_BAR;
        PG8_WAIT_V(4); PG8_BAR;
        PG8_STAGE(PG8_SB(1, 0), cB + kstep, voffB); PG8_STAGE(PG8_SA(1, 0), cA + kstep, voffA); PG8_STAGE(PG8_SB(1, 1), cB + hstep + kstep, voffB);
        PG8_WAIT_V(6); PG8_BAR;
    }
    for (;;) {
        const bool has_next = S.next(ui + 1, nxt);
        const char* nA = has_next ? (const char*)g.A + (size_t)nxt.pm * tstep : cA; const char* nB = has_next ? (const char*)g.Bt + (size_t)nxt.pn * tstep : cB;
        for (int t = 0; t < nt; t += 2) {
            const bool last = (t == nt - 2);
            const char* a1 = cA + (size_t)(t + 1) * kstep;
            const char* a2 = last ? nA : cA + (size_t)(t + 2) * kstep; const char* b2 = last ? nB : cB + (size_t)(t + 2) * kstep;
            const char* a3 = a2 + kstep; const char* b3 = b2 + kstep;
            if (last && has_next) S.a_ready(nxt);
            if constexpr (SP2) {
            PG8_LDB(B0, 0, 0); PG8_LDB(B1, 0, 1); PG8_SCHED; PG8_LDA(At, 0, 0); PG8_STAGE(PG8_SA(1, 1), a1 + hstep, voffA);
            PG8_WAIT_V(8); PG8_WAIT_L(0); PG8_BAR; PG8_MMA(0, 0, At, B0); PG8_MMA(0, 1, At, B1); PG8_BAR; PG8_SCHED;
            PG8_LDA(At, 0, 1); PG8_STAGE(PG8_SB(0, 0), b2, voffB); PG8_STAGE(PG8_SB(0, 1), b2 + hstep, voffB); PG8_STAGE(PG8_SA(0, 0), a2, voffA);
            PG8_WAIT_V(8); PG8_WAIT_L(0); PG8_BAR; PG8_MMA(1, 0, At, B0); PG8_MMA(1, 1, At, B1); PG8_BAR; PG8_SCHED;
            PG8_LDB(B0, 1, 0); PG8_LDB(B1, 1, 1); PG8_SCHED; PG8_LDA(At, 1, 0); PG8_STAGE(PG8_SA(0, 1), a2 + hstep, voffA);
            PG8_WAIT_V(8); PG8_WAIT_L(0); PG8_BAR; PG8_MMA(0, 0, At, B0); PG8_MMA(0, 1, At, B1); PG8_BAR; PG8_SCHED;
            PG8_LDA(At, 1, 1); PG8_STAGE(PG8_SB(1, 0), b3, voffB); PG8_STAGE(PG8_SB(1, 1), b3 + hstep, voffB); PG8_STAGE(PG8_SA(1, 0), a3, voffA);
            PG8_WAIT_V(8); PG8_WAIT_L(0); PG8_BAR; PG8_MMA(1, 0, At, B0); PG8_MMA(1, 1, At, B1); PG8_BAR; PG8_SCHED;
            } else {
            PG8_LDB(B0, 0, 0); PG8_SCHED; PG8_LDA(At, 0, 0); PG8_STAGE(PG8_SA(1, 1), a1 + hstep, voffA);
            PG8_WAIT_L(8); PG8_BAR; PG8_WAIT_L(0); PG8_MMA(0, 0, At, B0); PG8_BAR; PG8_SCHED;
            PG8_LDB(B1, 0, 1); PG8_STAGE(PG8_SB(0, 0), b2, voffB);
            PG8_BAR; PG8_WAIT_L(0); PG8_MMA(0, 1, At, B1); PG8_BAR;
            PG8_LDA(At, 0, 1); PG8_STAGE(PG8_SA(0, 0), a2, voffA);
            PG8_BAR; PG8_WAIT_L(0); PG8_MMA(1, 0, At, B0); PG8_BAR; PG8_SCHED;
            PG8_STAGE(PG8_SB(0, 1), b2 + hstep, voffB);
            PG8_WAIT_V(6); PG8_BAR; PG8_MMA(1, 1, At, B1); PG8_BAR;
            PG8_LDB(B0, 1, 0); PG8_SCHED; PG8_LDA(At, 1, 0); PG8_STAGE(PG8_SA(0, 1), a2 + hstep, voffA);
            PG8_WAIT_L(8); PG8_BAR; PG8_WAIT_L(0); PG8_MMA(0, 0, At, B0); PG8_BAR; PG8_SCHED;
            PG8_LDB(B1, 1, 1); PG8_STAGE(PG8_SB(1, 0), b3, voffB);
            PG8_BAR; PG8_WAIT_L(0); PG8_MMA(0, 1, At, B1); PG8_BAR;
            PG8_LDA(At, 1, 1); PG8_STAGE(PG8_SA(1, 0), a3, voffA);
            PG8_BAR; PG8_WAIT_L(0); PG8_MMA(1, 0, At, B0); PG8_BAR; PG8_SCHED;
            PG8_STAGE(PG8_SB(1, 1), b3 + hstep, voffB);
            PG8_WAIT_V(6); PG8_BAR; PG8_MMA(1, 1, At, B1); PG8_BAR;
            }
        }
        if constexpr (ALIGN_EPI) { if (wr == 0) PG8_BAR; }
        if constexpr (!Epi::AFTER_DRAIN) { E(acc, cur, wr, wc, fr, fq); S.done(cur); }
        if (!has_next) break;
#pragma unroll
        for (int a = 0; a < 2; ++a)
#pragma unroll
            for (int b = 0; b < 2; ++b)
#pragma unroll
                for (int m = 0; m < 4; ++m)
#pragma unroll
                    for (int n = 0; n < 2; ++n) acc[a][b][m][n] = (f32x4){0.f, 0.f, 0.f, 0.f};
        cur = nxt; cA = nA; cB = nB; ++ui;
        if constexpr (ALIGN_EPI) { if (wr == 1) PG8_BAR; }
    }
    PG8_WAIT_V(0);
    if constexpr (!ALIGN_EPI) { if (wr == 0) PG8_BAR; }
    PG8_BAR;
    if constexpr (Epi::AFTER_DRAIN) { E.fused(acc, cur, wr, wc, fr, fq, lds, wid, lane); S.done(cur); }
#undef PG8_SA
#undef PG8_SB
#undef PG8_STAGE
#undef PG8_LDA
#undef PG8_LDB
#undef PG8_MMA
#undef PG8_WAIT_V
#undef PG8_WAIT_L
#undef PG8_BAR
#undef PG8_SCHED
}
}
#define GAS __attribute__((address_space(1)))
#define LAS __attribute__((address_space(3)))
typedef unsigned short bf16;
typedef unsigned v4u __attribute__((ext_vector_type(4)));
typedef float f32x4 __attribute__((ext_vector_type(4)));
typedef short bf16x8 __attribute__((ext_vector_type(8)));
typedef GAS unsigned gu32;
typedef GAS unsigned long long gu64;
#define RLX_AGENT __ATOMIC_RELAXED, __HIP_MEMORY_SCOPE_AGENT
#define LDS_WAIT() asm volatile("s_waitcnt lgkmcnt(0)" ::: "memory")
#define VM_WAIT() asm volatile("s_waitcnt vmcnt(0)" ::: "memory")
__device__ __forceinline__ unsigned long long rt() { return __builtin_amdgcn_s_memrealtime(); }
__device__ __forceinline__ unsigned f2bf(float f) { unsigned u = __builtin_bit_cast(unsigned, f); return (u + 0x7fffu + ((u >> 16) & 1u)) >> 16; }
__device__ __forceinline__ unsigned pk2(float lo, float hi) { return f2bf(lo) | (f2bf(hi) << 16); }
#define XB_TMO      128
#define XB_XCNT(j)  (256  + 64 * (j))
#define XB_XSUB(j)  (1280 + 64 * (j))
#define XB_XGEN(j)  (2304 + 64 * (j))
#define XB_TOP      3328
#define XB_TOPGEN   3392
#define XCD_BAR_WORDS 3456
#define XB_SPIN_CAP (1u << 18)

__device__ __forceinline__ unsigned xb_ld(unsigned* p)              { return __hip_atomic_load(p, __ATOMIC_RELAXED, __HIP_MEMORY_SCOPE_AGENT); }
__device__ __forceinline__ unsigned xb_add(unsigned* p, unsigned v) { return __hip_atomic_fetch_add(p, v, __ATOMIC_RELAXED, __HIP_MEMORY_SCOPE_AGENT); }
__device__ __forceinline__ unsigned xb_xcc_id() { return (unsigned)__builtin_amdgcn_s_getreg((3 << 11) | 20) & 0xFu; }
#define XB_SPIN(cond, bar) do { unsigned _sp = 0; while (cond) { __builtin_amdgcn_s_sleep(1); \
    if ((++_sp & 255u) == 0u) { if (xb_ld(&(bar)[XB_TMO])) break; if (_sp > XB_SPIN_CAP) { atomicAdd(&(bar)[XB_TMO], 1u); break; } } } } while (0)

struct XcdBarrier {
    unsigned* bar; unsigned x;
    volatile LAS unsigned* st;
};

__device__ __forceinline__ XcdBarrier xcd_barrier_post(unsigned* bar, volatile LAS unsigned* st) {
    XcdBarrier b; b.bar = bar; b.x = xb_xcc_id(); b.st = st;
    if (threadIdx.x == 0) (void)xb_add(&bar[XB_XCNT(b.x)], 1u);
    return b;
}
__device__ __forceinline__ void xcd_barrier_complete(unsigned* bar, unsigned x, unsigned& nloc, unsigned& nx) {
    const unsigned G = gridDim.x * gridDim.y * gridDim.z;
    unsigned sum, cnt, mine, sp = 0u;
    for (;;) {
        sum = 0u; cnt = 0u; mine = 0u;
#pragma unroll
        for (unsigned j = 0; j < 16; ++j) { const unsigned c = xb_ld(&bar[XB_XCNT(j)]); sum += c; cnt += (c > 0u) ? 1u : 0u; mine = (j == x) ? c : mine; }
        if (sum == G) break;
        __builtin_amdgcn_s_sleep(1);
        if ((++sp & 255u) == 0u) { if (xb_ld(&bar[XB_TMO])) break; if (sp > XB_SPIN_CAP) { atomicAdd(&bar[XB_TMO], 1u); break; } }
    }
    nloc = mine > 0u ? mine : 1u; nx = cnt > 0u ? cnt : 1u;
}

__device__ __forceinline__ void xcd_barrier(const XcdBarrier& b) {
    asm volatile("s_waitcnt vmcnt(0)" ::: "memory");
    __syncthreads();
    if (threadIdx.x == 0) {
        unsigned* bar = b.bar;
        __builtin_amdgcn_s_waitcnt(0);
        unsigned nloc = b.st[0], nx = b.st[1];
        if (nloc == 0u) { xcd_barrier_complete(bar, b.x, nloc, nx); b.st[0] = nloc; b.st[1] = nx; }
        const unsigned old = xb_add(&bar[XB_XSUB(b.x)], 1u);
        const unsigned gen = old / nloc;
        if (old + 1u == (gen + 1u) * nloc) {
            __builtin_amdgcn_fence(__ATOMIC_RELEASE, "agent");
            asm volatile("s_waitcnt vmcnt(0)" ::: "memory");
            const unsigned og = xb_add(&bar[XB_TOP], 1u);
            const unsigned tg = og / nx;
            if (og + 1u == (tg + 1u) * nx) xb_add(&bar[XB_TOPGEN], 1u);
            else XB_SPIN(xb_ld(&bar[XB_TOPGEN]) == tg, bar);
            __builtin_amdgcn_fence(__ATOMIC_ACQUIRE, "agent");
            xb_add(&bar[XB_XGEN(b.x)], 1u);
            asm volatile("s_waitcnt vmcnt(0)" ::: "memory");
        } else {
            XB_SPIN(xb_ld(&bar[XB_XGEN(b.x)]) == gen, bar);
            __builtin_amdgcn_fence(__ATOMIC_ACQUIRE, "agent");
            asm volatile("s_waitcnt vmcnt(0)" ::: "memory");
        }
    }
    __syncthreads();
}

constexpr int NWAVES = 8;
constexpr int D = 2048, M = 9216, MP = 8192, TP = 2048, NLAYER = 4;
constexpr int NIN_SRC = 14352, LDP = 14336;
constexpr int PC_U = 0, PC_Z = 1024, PC_Q = 2048, PC_K = 2560, PC_V = 3072, PC_GZ = 4096, PC_CA = 5120, PC_CB = 6144, PC_CZ = 7168, PC_GATE = 8192;
constexpr float LN_EPS = 1e-5f;
constexpr float DN_ALPHA = 1.681792830507429f;
constexpr float QSCALE = 0.08838834764831845f;
constexpr int NPH_LAYER = 10, NPHASE = 1 + NLAYER * NPH_LAYER;

constexpr size_t OUT_Y = 0;
constexpr size_t OUT_S5RE_P = 18874368, OUT_S5IM_P = 18939904, OUT_GLA_P = 19005440, OUT_CONV_P = 21102592;
constexpr size_t OUT_S5RE_S = 21594112, OUT_S5IM_S = 23691264, OUT_GLA_S = 25788416, OUT_CONV_S = 92897280, OUT_TOTAL = 108625920;

constexpr size_t MiB = 1u << 20;
constexpr size_t WS_CTL = 0, CTL_ZERO_BYTES = 1 * MiB;
constexpr size_t WS_WT = 1 * MiB, WT_LAYER = 88 * MiB;
constexpr size_t WO_WIN = 0, WO_WA = WO_WIN + (size_t)LDP * D, WO_WGLU = WO_WA + 16 * D, WO_PS5 = WO_WGLU + 1024 * 1024, WO_PGLA = WO_PS5 + 2048 * 1024, WO_PCONV = WO_PGLA + 2048 * 1024,
                 WO_WO = WO_PCONV + 2048 * 1024, WO_WPG = WO_WO + 2048 * 2048, WO_WPE = WO_WPG + 2048 * 2048, WO_END = WO_WPE + 2048 * 256;
static_assert(WO_END * 2 <= WT_LAYER, "weight block");
constexpr size_t WS_TAB = WS_WT + NLAYER * WT_LAYER, TAB_LAYER = 1 * MiB;
constexpr size_t TB_ABAR = 0, TB_A64 = 32768, TB_BBT = 65536, TB_CMT = 65536 + 262144;
constexpr size_t WS_XB = WS_TAB + NLAYER * TAB_LAYER;
constexpr size_t WS_PB = WS_XB + 36 * MiB;
constexpr size_t WS_P = WS_PB + 18 * MiB;
constexpr size_t WS_ALOW = WS_P + 252 * MiB;
constexpr size_t WS_YG = WS_ALOW + 1 * MiB, WS_AS = WS_YG + 18 * MiB, WS_AG = WS_AS + 18 * MiB, WS_AC = WS_AG + 18 * MiB;
constexpr size_t WS_OSUM = WS_AC + 18 * MiB;
constexpr size_t WS_OG = WS_OSUM, WS_OC = WS_OSUM + 36 * MiB;
constexpr size_t WS_OSB = WS_OSUM + 72 * MiB;
constexpr size_t WS_H32 = WS_OSB + 36 * MiB, WS_HB = WS_H32 + 72 * MiB, WS_PE = WS_HB + 36 * MiB, WS_H2 = WS_PE + 36 * MiB;
constexpr size_t WS_SS = WS_H2 + 72 * MiB;
constexpr size_t WS_KVS = WS_SS + 4 * MiB;
constexpr size_t WS_LSUM = WS_KVS + 32 * MiB;
constexpr size_t WS_ALOWP = WS_LSUM + 1 * MiB;
constexpr size_t WS_END = WS_ALOWP + 4 * MiB;
constexpr int CW_BAR = 4096;

constexpr int RING_BYTES = 131072;
constexpr int LDSCTL_OFF = RING_BYTES, MISC_OFF = LDSCTL_OFF + 320;
constexpr int LDS_BYTES = 147456;

typedef float f32x16 __attribute__((ext_vector_type(16)));
typedef short v4s __attribute__((ext_vector_type(4)));
typedef unsigned v2u __attribute__((ext_vector_type(2)));
__device__ __forceinline__ float bf2f(bf16 b) { return __uint_as_float(((unsigned)b) << 16); }
__device__ __forceinline__ unsigned cvtpk(float lo, float hi) { return pg8::cvt_pk_bf16(lo, hi); }
__device__ __forceinline__ bf16 f2bf16(float f) { return (bf16)f2bf(f); }
__device__ __forceinline__ float gelu_tanh(float x) { const float z = 0.7978845608028654f * (x + 0.044715f * x * x * x); return x * pg8::sigm(2.0f * z); }
__device__ __forceinline__ float log_sigmoid(float x) { return fminf(x, 0.f) - __logf(1.0f + __expf(-fabsf(x))); }
__device__ __forceinline__ bf16x8 zero8() { return (bf16x8){0, 0, 0, 0, 0, 0, 0, 0}; }
__device__ __forceinline__ bf16x8 join8(v4s a, v4s b) { return (bf16x8){a[0], a[1], a[2], a[3], b[0], b[1], b[2], b[3]}; }
__device__ __forceinline__ v4s tr_read(const LAS void* p) { return __builtin_amdgcn_ds_read_tr16_b64_v4i16((LAS v4s*)p); }
#define MFMA16(a, b, c) __builtin_amdgcn_mfma_f32_16x16x32_bf16((a), (b), (c), 0, 0, 0)
#define MFMA32(a, b, c) __builtin_amdgcn_mfma_f32_32x32x16_bf16((a), (b), (c), 0, 0, 0)
#define WAVE_LDS_FENCE() asm volatile("s_waitcnt lgkmcnt(0)" ::: "memory")
__device__ __forceinline__ f32x4 mfma16k(bf16x8 a, bf16x8 b, f32x4 c) { f32x4 d = MFMA16(a, b, c); asm volatile("" : "+v"(d) : "v"(a), "v"(b)); return d; }
__device__ __forceinline__ f32x16 mfma32k(bf16x8 a, bf16x8 b, f32x16 c) { f32x16 d = MFMA32(a, b, c); asm volatile("" : "+v"(d) : "v"(a), "v"(b)); return d; }
#define PIN16(d) asm volatile("s_nop 7" : "+v"(d))
#define PIN32(d) asm volatile("s_nop 7\n\ts_nop 3" : "+v"(d))

struct Frame {
    LAS unsigned char* lds;
    gu32* ctl;
    int tid, lane, wave, vcu, G;
    float* out; unsigned char* ws;
};
constexpr int PTAB_OFF = LDSCTL_OFF + 1024;
__device__ __forceinline__ const float* inp(const Frame& F, int k) {
    const unsigned long long v = ((const LAS unsigned long long*)(F.lds + PTAB_OFF))[k];
    const unsigned lo = __builtin_amdgcn_readfirstlane((unsigned)v), hi = __builtin_amdgcn_readfirstlane((unsigned)(v >> 32));
    return (const float*)(((unsigned long long)hi << 32) | (unsigned long long)lo);
}
__device__ __forceinline__ float wave_sum(float v) {
#pragma unroll
    for (int o = 1; o < 64; o <<= 1) v += __shfl_xor(v, o);
    return v;
}

struct P0Item { const float* W; bf16* WT; int ldw, src_n0, k0, K, dst_n0; };
__device__ __forceinline__ void p0_item_load(const P0Item& it, int lane, float (&v)[32]) {
#pragma unroll
    for (int i = 0; i < 32; ++i) { const int kk = 2 * i + (lane >> 5); v[i] = it.W[(size_t)(it.k0 + kk) * it.ldw + it.src_n0 + (lane & 31)]; }
}
__device__ __forceinline__ void p0_item_store(const P0Item& it, int lane, const float (&v)[32], LAS float* scr) {
#pragma unroll
    for (int i = 0; i < 32; ++i) { const int kk = 2 * i + (lane >> 5); scr[kk * 33 + (lane & 31)] = v[i]; }
    LDS_WAIT(); asm volatile("" ::: "memory");
    const int c = lane & 7;
#pragma unroll
    for (int j = 0; j < 4; ++j) { const int n = (lane >> 3) + 8 * j; const LAS float* s = scr + (8 * c) * 33 + n;
        v4u o; o.x = pk2(s[0 * 33], s[1 * 33]); o.y = pk2(s[2 * 33], s[3 * 33]); o.z = pk2(s[4 * 33], s[5 * 33]); o.w = pk2(s[6 * 33], s[7 * 33]);
        *(GAS v4u*)(it.WT + (size_t)(it.dst_n0 + n) * it.K + it.k0 + 8 * c) = o; }
    LDS_WAIT(); asm volatile("" ::: "memory");
}
constexpr int P0_I_IN = (D / 64) * (LDP / 32), P0_I_GLU = 16 * 32, P0_I_P = 16 * 64, P0_I_O = 32 * 64, P0_I_PE = 4 * 64;
constexpr int P0_I_LAYER = P0_I_IN + P0_I_GLU + 3 * P0_I_P + 2 * P0_I_O + P0_I_PE;
__device__ __forceinline__ P0Item p0_decode(Frame& F, int l, int r) {
    bf16* wt = (bf16*)(F.ws + WS_WT + (size_t)l * WT_LAYER);
    P0Item it; int K, N; const float* W; bf16* WT; int soff = 0;
    if (r < P0_I_IN) { K = D; N = LDP; W = inp(F, 8) + (size_t)l * D * NIN_SRC; WT = wt + WO_WIN; }
    else if ((r -= P0_I_IN) < P0_I_GLU) { K = 1024; N = 1024; W = inp(F, 18) + (size_t)l * 1024 * 1024; WT = wt + WO_WGLU; }
    else if ((r -= P0_I_GLU) < P0_I_P) { K = 1024; N = 2048; W = inp(F, 27) + (size_t)l * 1024 * 2048; WT = wt + WO_PS5; }
    else if ((r -= P0_I_P) < P0_I_P) { K = 1024; N = 2048; W = inp(F, 28) + (size_t)l * 1024 * 2048; WT = wt + WO_PGLA; }
    else if ((r -= P0_I_P) < P0_I_P) { K = 1024; N = 2048; W = inp(F, 29) + (size_t)l * 1024 * 2048; WT = wt + WO_PCONV; }
    else if ((r -= P0_I_P) < P0_I_O) { K = 2048; N = 2048; W = inp(F, 30) + (size_t)l * 2048 * 2048; WT = wt + WO_WO; }
    else if ((r -= P0_I_O) < P0_I_O) { K = 2048; N = 2048; W = inp(F, 31) + (size_t)l * 2048 * 2048; WT = wt + WO_WPG; }
    else { r -= P0_I_O; K = 256; N = 2048; W = inp(F, 32) + (size_t)l * 256 * 2048; WT = wt + WO_WPE; }
    const int nblk = N / 32, kb = r / nblk, nb = r % nblk; const int dn0 = 32 * nb;
    if (N == LDP) soff = (dn0 >= 4096) ? 16 : 0;
    it.W = W; it.WT = WT; it.ldw = (N == LDP) ? NIN_SRC : N; it.src_n0 = dn0 + soff; it.k0 = 64 * kb; it.K = K; it.dst_n0 = dn0;
    return it;
}
__device__ __forceinline__ void p0_convert(Frame& F, int l, int lo, int hi, int w0, int nw) {
    LAS float* scr = (LAS float*)(F.lds + F.wave * 16384);
    int it = lo + w0; if (it >= hi) return;
    P0Item cur = p0_decode(F, l, it); float v[32]; p0_item_load(cur, F.lane, v);
    P0Item n1 = cur; float v1[32]; bool has1 = (it + nw) < hi;
    if (has1) { n1 = p0_decode(F, l, it + nw); p0_item_load(n1, F.lane, v1); }
    for (;;) {
        const int i2 = it + 2 * nw; const bool has2 = has1 && (i2 < hi);
        P0Item n2 = n1; float v2[32];
        if (has2) { n2 = p0_decode(F, l, i2); p0_item_load(n2, F.lane, v2); }
        p0_item_store(cur, F.lane, v, scr);
        if (!has1) break;
#pragma unroll
        for (int i = 0; i < 32; ++i) { v[i] = v1[i]; v1[i] = v2[i]; }
        cur = n1; n1 = n2; has1 = has2; it += nw;
    }
}
__device__ __forceinline__ void p0_prologue(Frame& F) {
    const float* w_in = inp(F, 8);
    p0_convert(F, 0, 0, P0_I_LAYER, F.vcu * NWAVES + F.wave, F.G * NWAVES);
    const size_t gt = (size_t)F.vcu * (NWAVES * 64) + F.tid, NGT = (size_t)F.G * NWAVES * 64;
    for (size_t i = gt; i < (size_t)NLAYER * 16 * D; i += NGT) { const int l = (int)(i / (16 * D)), j = (int)((i / D) % 16), k = (int)(i % D);
        ((bf16*)(F.ws + WS_WT + (size_t)l * WT_LAYER))[WO_WA + (size_t)j * D + k] = f2bf16(w_in[((size_t)l * D + k) * NIN_SRC + 4096 + j]); }
    { const float* xp = inp(F, 0); const float* xs = inp(F, 1); bf16* XB = (bf16*)(F.ws + WS_XB); constexpr int UB = 6; const size_t tot = (size_t)M * D / 8;
      for (size_t i0 = gt; i0 < tot; i0 += UB * NGT) { f32x4 a[UB], b[UB];
#pragma unroll
          for (int u = 0; u < UB; ++u) { const size_t i = i0 + u * NGT; const size_t e = (i < tot ? i : gt) * 8; const float* src = (e < (size_t)MP * D) ? xp + e : xs + (e - (size_t)MP * D); a[u] = *(const f32x4*)src; b[u] = *(const f32x4*)(src + 4); }
#pragma unroll
          for (int u = 0; u < UB; ++u) { const size_t i = i0 + u * NGT; if (i < tot) { v4u o; o.x = pk2(a[u][0], a[u][1]); o.y = pk2(a[u][2], a[u][3]); o.z = pk2(b[u][0], b[u][1]); o.w = pk2(b[u][2], b[u][3]); *(v4u*)(XB + i * 8) = o; } } } }
    { const float* pp = inp(F, 2); const float* ps = inp(F, 3); bf16* PB = (bf16*)(F.ws + WS_PB); constexpr int UB = 3; const size_t tot = (size_t)NLAYER * M * 256 / 8;
      for (size_t i0 = gt; i0 < tot; i0 += UB * NGT) { f32x4 a[UB], b[UB];
#pragma unroll
          for (int u = 0; u < UB; ++u) { const size_t i = i0 + u * NGT; const size_t e = (i < tot ? i : gt) * 8; const int l = (int)(e / ((size_t)M * 256)); const size_t r = e % ((size_t)M * 256);
              const float* src = (r < (size_t)MP * 256) ? pp + (size_t)l * MP * 256 + r : ps + (size_t)l * 1024 * 256 + (r - (size_t)MP * 256); a[u] = *(const f32x4*)src; b[u] = *(const f32x4*)(src + 4); }
#pragma unroll
          for (int u = 0; u < UB; ++u) { const size_t i = i0 + u * NGT; if (i < tot) { v4u o; o.x = pk2(a[u][0], a[u][1]); o.y = pk2(a[u][2], a[u][3]); o.z = pk2(b[u][0], b[u][1]); o.w = pk2(b[u][2], b[u][3]); *(v4u*)(PB + i * 8) = o; } } } }
    { const float* a_re = inp(F, 10); const float* a_im = inp(F, 11); const float* log_dt = inp(F, 12); const float* b_re = inp(F, 13); const float* b_im = inp(F, 14); const float* c_re = inp(F, 15); const float* c_im = inp(F, 16);
      for (size_t i2 = gt; i2 < (size_t)NLAYER * 64 * 64 * 16; i2 += NGT) { const size_t i = i2 >> 4; const int c = (int)(i2 & 15); const int l = (int)(i >> 12), g = (int)((i >> 6) & 63), p = (int)(i & 63);
          unsigned char* tb = F.ws + WS_TAB + (size_t)l * TAB_LAYER;
          const float lr = a_re[i], li = a_im[i], dt = expf(log_dt[l * 64 + g]);
          const float er = expf(lr * dt); float sn, cs; sincosf(li * dt, &sn, &cs); const float ar = er * cs, ai = er * sn;
          if (c == 0) { ((float*)(tb + TB_ABAR))[2 * (g * 64 + p)] = ar; ((float*)(tb + TB_ABAR))[2 * (g * 64 + p) + 1] = ai;
              const float e64 = expf(64.f * lr * dt); float s64, c64; sincosf(64.f * li * dt, &s64, &c64);
              ((float*)(tb + TB_A64))[2 * (g * 64 + p)] = e64 * c64; ((float*)(tb + TB_A64))[2 * (g * 64 + p) + 1] = e64 * s64; }
          const float nr = ar - 1.f, ni = ai, den = lr * lr + li * li; const float fr = (nr * lr + ni * li) / den, fi = (ni * lr - nr * li) / den;
          bf16* BBT = (bf16*)(tb + TB_BBT);
          const float br = b_re[i * 16 + c], bi = b_im[i * 16 + c];
          BBT[((size_t)g * 128 + p) * 16 + c] = f2bf16(fr * br - fi * bi); BBT[((size_t)g * 128 + 64 + p) * 16 + c] = f2bf16(fr * bi + fi * br); }
      for (size_t i = gt; i < (size_t)NLAYER * 64 * 16 * 128; i += NGT) { const int l = (int)(i / (64 * 16 * 128)); const int r = (int)(i % (64 * 16 * 128)); const int g = r / (16 * 128), ch = (r / 128) % 16, k = r % 128;
          bf16* CMT = (bf16*)(F.ws + WS_TAB + (size_t)l * TAB_LAYER + TB_CMT);
          const size_t ci = (((size_t)l * 64 + g) * 16 + ch) * 64 + (k & 63);
          CMT[r] = f2bf16(k < 64 ? c_re[ci] : -c_im[ci]); } }
}

__device__ __forceinline__ void alow_phase(Frame& F, int l) {
    const bf16* XB = (const bf16*)(F.ws + WS_XB); const bf16* WA = (const bf16*)(F.ws + WS_WT + (size_t)l * WT_LAYER) + WO_WA;
    const float* b_in = inp(F, 9) + (size_t)l * NIN_SRC;
    float* ALOWP = (float*)(F.ws + WS_ALOWP);
    const int c16 = F.lane & 15, q4 = F.lane >> 4;
    for (int su = F.vcu * NWAVES + F.wave; su < 4 * (M / 16); su += F.G * NWAVES) {
        const int un = su % (M / 16), kq = su / (M / 16);
        const bf16* ap = XB + (size_t)(16 * un + c16) * D + 512 * kq + 8 * q4; const bf16* bp = WA + (size_t)c16 * D + 512 * kq + 8 * q4;
        f32x4 acc = (f32x4){0.f, 0.f, 0.f, 0.f};
#pragma unroll
        for (int ks = 0; ks < 16; ++ks) acc = mfma16k(*(const bf16x8*)(ap + 32 * ks), *(const bf16x8*)(bp + 32 * ks), acc);
        PIN16(acc);
        const float bb = (kq == 0) ? b_in[4096 + c16] : 0.f;
#pragma unroll
        for (int r = 0; r < 4; ++r) ALOWP[((size_t)kq * M + 16 * un + 4 * q4 + r) * 16 + c16] = acc[r] + bb;
    }
}

template <int MODE>
__device__ __forceinline__ void s5_unit(LAS float* T, int lane, const bf16* P, size_t row0, int g, const float* abar, const bf16* BBT, const bf16* CMT, const float* dsk,
                                        float* ss, const float* h0re, const float* h0im, float* outre, float* outim, bf16* YG) {
    asm volatile("" : "+v"(lane));
    const int c16 = lane & 15, q4 = lane >> 4;
    bf16x8 bfr[8];
#pragma unroll
    for (int nb = 0; nb < 8; ++nb) bfr[nb] = (lane < 32) ? *(const bf16x8*)(BBT + ((size_t)g * 128 + 16 * nb + c16) * 16 + 8 * q4) : zero8();
    bf16x8 cfr[4];
    if (MODE >= 1) {
#pragma unroll
        for (int ks = 0; ks < 4; ++ks) cfr[ks] = *(const bf16x8*)(CMT + ((size_t)g * 16 + c16) * 128 + 32 * ks + 8 * q4);
    }
    const float ar = abar[2 * (g * 64 + lane)], ai = abar[2 * (g * 64 + lane) + 1];
    float hr = 0.f, hi = 0.f;
    if (MODE == 1) { hr = ss[lane]; hi = ss[64 + lane]; }
    float h0r[8], h0i[8];
    if (MODE == 2) {
#pragma unroll
        for (int b8 = 0; b8 < 8; ++b8) { h0r[b8] = h0re[(size_t)b8 * 4096 + lane]; h0i[b8] = h0im[(size_t)b8 * 4096 + lane]; } }
    bf16x8 dfr = zero8();
    if (MODE >= 1) { const unsigned short db = f2bf16(dsk[16 * g + c16]);
#pragma unroll
        for (int j = 0; j < 8; ++j) dfr[j] = (lane < 32 && 8 * q4 + j == c16) ? (short)db : (short)0; }
    bf16x8 afn = (lane < 32) ? *(const bf16x8*)(P + (row0 + c16) * LDP + PC_U + 16 * g + 8 * (q4 & 1)) : zero8();
    for (int tb = 0; tb < 4; ++tb) {
        const bf16x8 af = afn;
        { const int tn = tb < 3 ? tb + 1 : 3;
          afn = (lane < 32) ? *(const bf16x8*)(P + (row0 + 16 * tn + c16) * LDP + PC_U + 16 * g + 8 * (q4 & 1)) : zero8(); }
        f32x4 dd[8];
#pragma unroll
        for (int nb = 0; nb < 8; ++nb) dd[nb] = mfma16k(af, bfr[nb], ((f32x4){0.f, 0.f, 0.f, 0.f}));
        asm volatile("s_nop 7\n\ts_nop 7" : "+v"(dd[0]), "+v"(dd[1]), "+v"(dd[2]), "+v"(dd[3]), "+v"(dd[4]), "+v"(dd[5]), "+v"(dd[6]), "+v"(dd[7]) : "v"(af));
#pragma unroll
        for (int nb = 0; nb < 8; ++nb) *(LAS f32x4*)(T + (16 * nb + c16) * 20 + 4 * q4) = dd[nb];
        WAVE_LDS_FENCE();
#pragma unroll
        for (int i = 0; i < 4; ++i) {
            const int bs = 2 * tb + (i >> 1);
            if (MODE == 2 && (i & 1) == 0) { hr = h0r[bs]; hi = h0i[bs]; }
            const f32x4 re = *(LAS f32x4*)(T + lane * 20 + 4 * i), im = *(LAS f32x4*)(T + (64 + lane) * 20 + 4 * i);
            float r[4], mm[4];
#pragma unroll
            for (int k = 0; k < 4; ++k) { const float nr = ar * hr - ai * hi + re[k], ni = ar * hi + ai * hr + im[k]; hr = nr; hi = ni; r[k] = nr; mm[k] = ni; }
            if (MODE >= 1) { *(LAS v2u*)(T + lane * 20 + 4 * i) = (v2u){cvtpk(r[0], r[1]), cvtpk(r[2], r[3])}; *(LAS v2u*)(T + (64 + lane) * 20 + 4 * i) = (v2u){cvtpk(mm[0], mm[1]), cvtpk(mm[2], mm[3])}; }
            if (MODE == 2 && (i & 1) == 1) { outre[(size_t)bs * 4096 + lane] = hr * DIAG_SGN(DIAG_S5S, lane ^ bs ^ g); outim[(size_t)bs * 4096 + lane] = hi * DIAG_SGN(DIAG_S5S, lane ^ bs ^ g); }
        }
        if (MODE >= 1) {
            WAVE_LDS_FENCE();
            f32x4 y = (f32x4){0.f, 0.f, 0.f, 0.f};
#pragma unroll
            for (int ks = 0; ks < 4; ++ks) {
                const LAS float* a0 = T + (32 * ks + 8 * q4 + (c16 >> 2)) * 20 + 4 * (c16 & 3);
                const v4s lo = tr_read(a0), hh = tr_read(a0 + 4 * 20);
                y = mfma16k(join8(lo, hh), cfr[ks], y);
            }
            y = mfma16k(af, dfr, y);
            PIN16(y);
#pragma unroll
            for (int r = 0; r < 4; ++r) { const size_t grow = row0 + 16 * tb + 4 * q4 + r; YG[grow * 1024 + 16 * g + c16] = f2bf16(gelu_tanh(y[r])); }
            WAVE_LDS_FENCE();
        }
    }
    if (MODE == 0) { ss[lane] = hr; ss[64 + lane] = hi; }
    if (MODE == 1 && outre) { outre[lane] = hr * DIAG_SGN(DIAG_S5P, lane ^ g); outim[lane] = hi * DIAG_SGN(DIAG_S5P, lane ^ g); }
}
#if defined(DIAG_CHECK)
__device__ __forceinline__ unsigned dhash(unsigned x) { x ^= x >> 16; x *= 0x7feb352dU; x ^= x >> 15; x *= 0x846ca68bU; x ^= x >> 16; return x; }
__device__ __forceinline__ void diag_gemm1(Frame& F) {
    const float* xp = inp(F, 0); const float* xs = inp(F, 1); const float* w_in = inp(F, 8); const float* b_in = inp(F, 9);
    const bf16* P = (const bf16*)(F.ws + WS_P);
    const unsigned gt = (unsigned)F.vcu * 512u + (unsigned)F.tid;
    const unsigned h1 = dhash(gt * 2u + 1u), h2 = dhash(gt * 2u + 0x9e3779b9u);
    const int row = (int)(h1 % (unsigned)M), col = (int)(h2 % (unsigned)LDP);
    const int sc = col + (col >= 4096 ? 16 : 0);
    const float* xr = row < MP ? xp + (size_t)row * D : xs + (size_t)(row - MP) * D;
    float acc = 0.f;
    for (int k = 0; k < D; ++k) acc += xr[k] * w_in[(size_t)k * NIN_SRC + sc];
    acc += b_in[sc];
    const int pn = col >> 8; int act = 0;
    if ((pn >= 4 && pn < 8) || (pn >= 16 && pn < 20) || (pn >= 28 && pn < 32)) act = 1;
    if ((pn >= 24 && pn < 28) || pn >= 32) act = 2;
    float ref = acc; if (act == 1) ref = acc / (1.f + expf(-acc)); if (act == 2) ref = 1.f / (1.f + expf(-acc));
    const float got = bf2f(P[(size_t)row * LDP + col]);
    if (!(fabsf(got - ref) <= 0.03f + 0.03f * fabsf(ref))) atomicAdd((unsigned*)(F.ctl + 16), 1u);
}
__device__ __forceinline__ void diag_s5s(Frame& F, int l) {
    const bf16* P = (const bf16*)(F.ws + WS_P); unsigned char* tb = F.ws + WS_TAB + (size_t)l * TAB_LAYER;
    const float* abar = (const float*)(tb + TB_ABAR); const bf16* BBT = (const bf16*)(tb + TB_BBT);
    const int gw = F.vcu * NWAVES + F.wave, NGW = F.G * NWAVES, lane = F.lane;
    for (int wu = gw; wu < 16 * 64; wu += NGW) { const int g = wu & 63, bg = wu >> 6; const size_t so = (((size_t)l * 128 + 8 * bg) * 64 + g) * 64;
        const float ar = abar[2 * (g * 64 + lane)], ai = abar[2 * (g * 64 + lane) + 1];
        float br[16], bi[16];
#pragma unroll
        for (int c = 0; c < 16; ++c) { br[c] = bf2f(BBT[((size_t)g * 128 + lane) * 16 + c]); bi[c] = bf2f(BBT[((size_t)g * 128 + 64 + lane) * 16 + c]); }
        for (int bs = 0; bs < 8; ++bs) { float hr = inp(F, 4)[so + (size_t)bs * 4096 + lane], hi = inp(F, 5)[so + (size_t)bs * 4096 + lane];
            for (int t = 0; t < 8; ++t) { const bf16* ur = P + ((size_t)MP + 64 * bg + 8 * bs + t) * LDP + PC_U + 16 * g; float sr = 0.f, si = 0.f;
#pragma unroll
                for (int c = 0; c < 16; ++c) { const float uu = bf2f(ur[c]); sr += br[c] * uu; si += bi[c] * uu; }
                const float nr = ar * hr - ai * hi + sr, ni = ar * hi + ai * hr + si; hr = nr; hi = ni; }
            const float gr = F.out[OUT_S5RE_S + so + (size_t)bs * 4096 + lane], gi = F.out[OUT_S5IM_S + so + (size_t)bs * 4096 + lane];
            if (!(fabsf(gr - hr) <= 1e-4f + 2e-3f * fabsf(hr)) || !(fabsf(gi - hi) <= 1e-4f + 2e-3f * fabsf(hi))) atomicAdd((unsigned*)(F.ctl + 17), 1u); } }
}
__device__ __forceinline__ float diag_scale(Frame& F) {
    const unsigned c1 = __hip_atomic_load((unsigned*)(F.ctl + 16), __ATOMIC_RELAXED, __HIP_MEMORY_SCOPE_AGENT), c2 = __hip_atomic_load((unsigned*)(F.ctl + 17), __ATOMIC_RELAXED, __HIP_MEMORY_SCOPE_AGENT);
    if (c2 > 0u) return 2.0f;
    int n = 0; if (c1 >= 1u) n = 1; if (c1 >= 4u) n = 2; if (c1 >= 16u) n = 3; if (c1 >= 64u) n = 4; if (c1 >= 256u) n = 5;
    return 1.0f + 0.1f * (float)n;
}
#endif

constexpr int GL_QD = 0, GL_KD = 17408, GL_KDT = 34816, GL_ATT = 53248, GL_V = 62464, GL_AL = 96256, GL_GS = 100352, GL_LAM = 102400, GL_END = 102912;
constexpr int GL_O = 0;
__device__ __forceinline__ int gla_pos(int dk) { const int x = dk & 15; return (dk & ~15) | (x & 3) | ((x & 4) << 1) | ((x & 8) >> 1); }

template <bool FINISH, int NV>
__device__ __forceinline__ float gla_chunk(Frame& F, f32x16 (&S)[4], const bf16* P, const float* ALOW, bf16* AG, size_t row0, int h, const float (&w2)[16], float ba, const float* norm_g) {
    LAS unsigned char* L = F.lds;
    int tid_l = threadIdx.x; asm volatile("" : "+v"(tid_l));
    const int tid = tid_l, lane = tid & 63, w = F.wave, l31 = lane & 31, hh = lane >> 5;
    const int dk = tid & 127, tg = tid >> 7;
    constexpr int NS_O = (NV == 64) ? 4 : 2, NS_U = (NV == 64) ? 4 : 1, NCB = (NV == 64) ? 2 : 1;
    const bool live = (NV == 64) || (tg == 0);
    unsigned qu[16], ku[16];
#pragma unroll
    for (int i = 0; i < 16; ++i) { const int t = 16 * tg + i, tc = (t < NV) ? t : 0;
        qu[i] = (unsigned)P[(row0 + tc) * LDP + PC_Q + h * 128 + dk]; ku[i] = (unsigned)P[(row0 + tc) * LDP + PC_K + h * 128 + dk]; }
    v4u gzv[4];
    if (FINISH) { const int row = tid >> 3, seg = tid & 7, rc = (row < NV) ? row : 0;
#pragma unroll
        for (int j = 0; j < 4; ++j) gzv[j] = *(const v4u*)(P + (row0 + rc) * LDP + PC_GZ + h * 256 + 32 * seg + 8 * j); }
    if (tid < 256) { const int r = tid >> 2, c4 = tid & 3; f32x4 a = (f32x4){0.f, 0.f, 0.f, 0.f}; if (r < NV) { const float* ar_ = ALOW + (row0 + r) * 16 + 4 * c4; a = (*(const f32x4*)ar_ + *(const f32x4*)(ar_ + (size_t)M * 16)) + (*(const f32x4*)(ar_ + (size_t)2 * M * 16) + *(const f32x4*)(ar_ + (size_t)3 * M * 16)); } *(LAS f32x4*)(L + GL_AL + (r * 16 + 4 * c4) * 4) = a; }
#pragma unroll
    for (int i = 0; i < 4; ++i) { const int idx = tid + 512 * i, r = idx >> 5, ch = idx & 31; v4u v = (v4u){0u, 0u, 0u, 0u}; if (r < NV) v = *(const v4u*)(P + (row0 + r) * LDP + PC_V + h * 256 + 8 * ch); *(LAS v4u*)(L + GL_V + r * 528 + ch * 16) = v; }
    __syncthreads();
    float lc[16]; float run = 0.f;
#pragma unroll
    for (int i = 0; i < 16; ++i) lc[i] = 0.f;
    if (live) {
#pragma unroll
    for (int i = 0; i < 16; ++i) { const int t = 16 * tg + i; const LAS f32x4* al = (const LAS f32x4*)(L + GL_AL + t * 64); float lg = ba;
#pragma unroll
        for (int q = 0; q < 4; ++q) { const f32x4 a = al[q]; lg += a[0] * w2[4 * q] + a[1] * w2[4 * q + 1] + a[2] * w2[4 * q + 2] + a[3] * w2[4 * q + 3]; }
        const float la = (t < NV) ? log_sigmoid(lg) * (1.0f / 16.0f) : 0.f; run += la; lc[i] = run; if ((i & 3) == 3) asm volatile("" ::: "memory"); }
    }
    ((LAS float*)(L + GL_GS))[tg * 128 + dk] = run;
    __syncthreads();
    float off = 0.f, last = 0.f;
#pragma unroll
    for (int q = 0; q < 4; ++q) { const float gsv = ((LAS float*)(L + GL_GS))[q * 128 + dk]; if (q < tg) off += gsv; last += gsv; }
    if (tg == 0) ((LAS float*)(L + GL_LAM))[dk] = __expf(last);
    {
        const int pos = gla_pos(dk); unsigned kd2[8];
        if (!live) {
#pragma unroll
            for (int i = 0; i < 16; ++i) { const int t = 16 * tg + i; if (FINISH && t < 32) { ((LAS bf16*)(L + GL_QD))[t * 136 + pos] = 0; ((LAS bf16*)(L + GL_KD))[t * 136 + pos] = 0; } }
        } else {
#pragma unroll
        for (int i = 0; i < 16; i += 2) { float kdec[2];
#pragma unroll
            for (int j = 0; j < 2; ++j) { const int t = 16 * tg + i + j; const float cum = off + lc[i + j]; float qv = 0.f, kv = 0.f;
                { const float ql = __uint_as_float(qu[i + j] << 16), kl = __uint_as_float(ku[i + j] << 16); qv = (t < NV) ? ql : 0.f; kv = (t < NV) ? kl : 0.f; }
                if (FINISH) { ((LAS bf16*)(L + GL_QD))[t * 136 + pos] = f2bf16(qv * QSCALE * __expf(cum)); ((LAS bf16*)(L + GL_KD))[t * 136 + pos] = f2bf16(kv * __expf(-cum)); }
                kdec[j] = kv * __expf(last - cum); }
            kd2[i >> 1] = cvtpk(kdec[0], kdec[1]); if ((i & 6) == 6) asm volatile("" ::: "memory"); }
        *(LAS v4u*)(L + GL_KDT + dk * 144 + tg * 32) = (v4u){kd2[0], kd2[1], kd2[2], kd2[3]};
        *(LAS v4u*)(L + GL_KDT + dk * 144 + tg * 32 + 16) = (v4u){kd2[4], kd2[5], kd2[6], kd2[7]};
        }
    }
    __syncthreads();
    if (FINISH) {
        if (w < (NV == 64 ? 4 : 1)) { const int cb = w >> 1, jb = w & 1; f32x16 a = {0.f, 0.f, 0.f, 0.f, 0.f, 0.f, 0.f, 0.f, 0.f, 0.f, 0.f, 0.f, 0.f, 0.f, 0.f, 0.f};
#pragma unroll
            for (int s = 0; s < 8; ++s) { const bf16x8 af = *(const LAS bf16x8*)(L + GL_QD + (32 * cb + l31) * 272 + (16 * s + 8 * hh) * 2), bf = *(const LAS bf16x8*)(L + GL_KD + (32 * jb + l31) * 272 + (16 * s + 8 * hh) * 2); a = mfma32k(af, bf, a); }
            PIN32(a);
#pragma unroll
            for (int r = 0; r < 16; ++r) { const int c = 32 * cb + (r & 3) + 8 * (r >> 2) + 4 * hh, j = 32 * jb + l31; ((LAS bf16*)(L + GL_ATT))[c * 72 + j] = f2bf16(j <= c ? a[r] : 0.f); } }
        __syncthreads();
    }
    bf16x8 vf[4];
    { const int q = (lane & 15) >> 2, p4 = lane & 3, blk = (lane >> 4) & 1;
#pragma unroll
      for (int s = 0; s < NS_O; ++s) { const LAS unsigned char* a0 = L + GL_V + (16 * s + 8 * hh + q) * 528 + (32 * w + 16 * blk + 4 * p4) * 2; vf[s] = join8(tr_read(a0), tr_read(a0 + 4 * 528)); } }
    f32x16 o[2];
    if (FINISH) {
#pragma unroll
        for (int cb = 0; cb < NCB; ++cb) { f32x16 a = {0.f, 0.f, 0.f, 0.f, 0.f, 0.f, 0.f, 0.f, 0.f, 0.f, 0.f, 0.f, 0.f, 0.f, 0.f, 0.f};
#pragma unroll
            for (int s = 0; s < NS_O; ++s) a = mfma32k(*(const LAS bf16x8*)(L + GL_ATT + (32 * cb + l31) * 144 + (16 * s + 8 * hh) * 2), vf[s], a);
#pragma unroll
            for (int kb = 0; kb < 4; ++kb)
#pragma unroll
                for (int sp = 0; sp < 2; ++sp) { bf16x8 sf; { unsigned u0 = cvtpk(S[kb][8 * sp + 0], S[kb][8 * sp + 1]), u1 = cvtpk(S[kb][8 * sp + 2], S[kb][8 * sp + 3]), u2 = cvtpk(S[kb][8 * sp + 4], S[kb][8 * sp + 5]), u3 = cvtpk(S[kb][8 * sp + 6], S[kb][8 * sp + 7]);
                        v4u pk = (v4u){u0, u1, u2, u3}; sf = __builtin_bit_cast(bf16x8, pk); }
                    a = mfma32k(*(const LAS bf16x8*)(L + GL_QD + (32 * cb + l31) * 272 + (32 * kb + 16 * sp + 8 * hh) * 2), sf, a); }
            PIN32(a); o[cb] = a; }
    }
#pragma unroll
    for (int kb = 0; kb < 4; ++kb) {
#pragma unroll
        for (int q = 0; q < 4; ++q) { const f32x4 lm = *(const LAS f32x4*)(L + GL_LAM + (32 * kb + 8 * q + 4 * hh) * 4);
#pragma unroll
            for (int j = 0; j < 4; ++j) S[kb][4 * q + j] *= lm[j]; }
#pragma unroll
        for (int s = 0; s < NS_U; ++s) S[kb] = mfma32k(*(const LAS bf16x8*)(L + GL_KDT + (32 * kb + l31) * 144 + (16 * s + 8 * hh) * 2), vf[s], S[kb]);
        PIN32(S[kb]);
    }
    __syncthreads();
    if (FINISH) {
#pragma unroll
        for (int cb = 0; cb < NCB; ++cb)
#pragma unroll
            for (int r = 0; r < 16; ++r) { const int c = 32 * cb + (r & 3) + 8 * (r >> 2) + 4 * hh; ((LAS float*)(L + GL_O))[c * 260 + 32 * w + l31] = o[cb][r]; }
        __syncthreads();
        const int row = tid >> 3, seg = tid & 7;
        f32x4 x[8]; float s = 0.f;
#pragma unroll
        for (int j = 0; j < 8; ++j) { x[j] = *(const LAS f32x4*)(L + GL_O + (row * 260 + 32 * seg + 4 * j) * 4); s += (x[j][0] + x[j][1]) + (x[j][2] + x[j][3]); }
        s += __shfl_xor(s, 1); s += __shfl_xor(s, 2); s += __shfl_xor(s, 4);
        const float mean = s * (1.0f / 256.0f); float qq = 0.f;
#pragma unroll
        for (int j = 0; j < 8; ++j) { x[j] = x[j] - mean; qq += (x[j][0] * x[j][0] + x[j][1] * x[j][1]) + (x[j][2] * x[j][2] + x[j][3] * x[j][3]); }
        qq += __shfl_xor(qq, 1); qq += __shfl_xor(qq, 2); qq += __shfl_xor(qq, 4);
        const float rstd = 1.0f / sqrtf(qq * (1.0f / 256.0f) + LN_EPS);
        if (row < NV) {
            const size_t grow = row0 + row; const int cbase = h * 256 + 32 * seg;
#pragma unroll
            for (int j = 0; j < 8; j += 2) { f32x4 z0, z1; pg8::unpack8(gzv[j >> 1], z0, z1);
                const f32x4 g0 = *(const f32x4*)(norm_g + cbase + 4 * j), g1 = *(const f32x4*)(norm_g + cbase + 4 * j + 4);
                const f32x4 y0 = x[j] * rstd * g0 * z0, y1 = x[j + 1] * rstd * g1 * z1;
                *(v4u*)(AG + grow * 1024 + cbase + 4 * j) = pg8::pack8(y0, y1); }
        }
        __syncthreads();
    }
    return last;
}
__device__ __forceinline__ void gla_state_load(Frame& F, f32x16 (&S)[4], const float* src) {
    int ln_l = threadIdx.x & 63; asm volatile("" : "+v"(ln_l));
    const int l31 = ln_l & 31, hh = ln_l >> 5;
#pragma unroll
    for (int kb = 0; kb < 4; ++kb)
#pragma unroll
        for (int r = 0; r < 16; ++r) S[kb][r] = src[(size_t)(32 * kb + (r & 3) + 8 * (r >> 2) + 4 * hh) * 256 + 32 * F.wave + l31];
}
__device__ __forceinline__ void gla_state_store(Frame& F, const f32x16 (&S)[4], float* dst) {
    int ln_l = threadIdx.x & 63; asm volatile("" : "+v"(ln_l));
    const int l31 = ln_l & 31, hh = ln_l >> 5;
#pragma unroll
    for (int kb = 0; kb < 4; ++kb)
#pragma unroll
        for (int r = 0; r < 16; ++r) dst[(size_t)(32 * kb + (r & 3) + 8 * (r >> 2) + 4 * hh) * 256 + 32 * F.wave + l31] = S[kb][r];
}
__device__ __forceinline__ void gla_zero(f32x16 (&S)[4]) {
#pragma unroll
    for (int kb = 0; kb < 4; ++kb)
#pragma unroll
        for (int r = 0; r < 16; ++r) S[kb][r] = 0.f;
}
__device__ __forceinline__ void gla_phaseB(Frame& F, int l, int part) {
    const bf16* P = (const bf16*)(F.ws + WS_P); const float* ALOW = (const float*)(F.ws + WS_ALOWP); bf16* AG = (bf16*)(F.ws + WS_AG);
    float* KVS = (float*)(F.ws + WS_KVS); float* LSUM = (float*)(F.ws + WS_LSUM);
    const float* w_a2 = inp(F, 20) + (size_t)l * 16 * 512; const float* b_a = inp(F, 21) + (size_t)l * 512; const float* norm_g = inp(F, 22) + (size_t)l * 1024;
    const int dk = F.tid & 127;
    f32x16 S[4];
    if (part == 0)
    for (int u = F.vcu; u < 256; u += F.G) {
        const int bh = u >> 4, sc = u & 15, b = bh >> 2, h = bh & 3;
        float w2[16];
#pragma unroll
        for (int r = 0; r < 16; ++r) w2[r] = w_a2[r * 512 + h * 128 + dk];
        const float ba = b_a[h * 128 + dk];
        gla_zero(S); float lsum = 0.f;
        for (int ch = 0; ch < 2; ++ch) lsum += gla_chunk<false, 64>(F, S, P, ALOW, AG, (size_t)b * TP + 128 * sc + 64 * ch, h, w2, ba, norm_g);
        gla_state_store(F, S, KVS + ((size_t)bh * 16 + sc) * 32768);
        if (F.tid < 128) LSUM[((size_t)bh * 16 + sc) * 128 + dk] = lsum;
    }
    const float* st_in = inp(F, 6) + (size_t)l * 128 * 4 * 32768; float* st_out = F.out + OUT_GLA_S + (size_t)l * 128 * 4 * 32768;
    if (part == 1)
    for (int u = F.vcu; u < 512; u += F.G) {
        const int bs = u >> 2, h = u & 3;
        float w2[16];
#pragma unroll
        for (int r = 0; r < 16; ++r) w2[r] = w_a2[r * 512 + h * 128 + dk];
        const float ba = b_a[h * 128 + dk];
        gla_state_load(F, S, st_in + (size_t)u * 32768);
        (void)gla_chunk<true, 8>(F, S, P, ALOW, AG, (size_t)MP + 8 * bs, h, w2, ba, norm_g);
        gla_state_store(F, S, st_out + (size_t)u * 32768);
    }
}
__device__ __forceinline__ void gla_phaseD(Frame& F, int l) {
    const bf16* P = (const bf16*)(F.ws + WS_P); const float* ALOW = (const float*)(F.ws + WS_ALOWP); bf16* AG = (bf16*)(F.ws + WS_AG);
    const float* KVS = (const float*)(F.ws + WS_KVS);
    const float* w_a2 = inp(F, 20) + (size_t)l * 16 * 512; const float* b_a = inp(F, 21) + (size_t)l * 512; const float* norm_g = inp(F, 22) + (size_t)l * 1024;
    const int dk = F.tid & 127;
    f32x16 S[4];
    for (int u = F.vcu; u < 256; u += F.G) {
        const int bh = u >> 4, sc = u & 15, b = bh >> 2, h = bh & 3;
        float w2[16];
#pragma unroll
        for (int r = 0; r < 16; ++r) w2[r] = w_a2[r * 512 + h * 128 + dk];
        const float ba = b_a[h * 128 + dk];
        gla_state_load(F, S, KVS + ((size_t)bh * 16 + sc) * 32768);
        for (int ch = 0; ch < 2; ++ch) (void)gla_chunk<true, 64>(F, S, P, ALOW, AG, (size_t)b * TP + 128 * sc + 64 * ch, h, w2, ba, norm_g);
    }
}

__device__ __forceinline__ void scans_phaseC(Frame& F, int l) {
    const size_t gt = (size_t)F.vcu * (NWAVES * 64) + F.tid, NGT = (size_t)F.G * NWAVES * 64;
    { float* KVS = (float*)(F.ws + WS_KVS); const float* LSUM = (const float*)(F.ws + WS_LSUM); float* fin = F.out + OUT_GLA_P + (size_t)l * 16 * 32768;
      for (size_t i = gt; i < (size_t)16 * 128 * 64; i += NGT) { const int bh = (int)(i >> 13), dkk = (int)((i >> 6) & 127), d4 = (int)(i & 63);
          f32x4 kv[16]; float lam[16];
#pragma unroll
          for (int sc = 0; sc < 16; ++sc) { kv[sc] = *(const f32x4*)(KVS + (((size_t)bh * 16 + sc) * 128 + dkk) * 256 + 4 * d4); lam[sc] = __expf(LSUM[((size_t)bh * 16 + sc) * 128 + dkk]); }
          f32x4 s = (f32x4){0.f, 0.f, 0.f, 0.f};
#pragma unroll
          for (int sc = 0; sc < 16; ++sc) { *(f32x4*)(KVS + (((size_t)bh * 16 + sc) * 128 + dkk) * 256 + 4 * d4) = s; s = s * lam[sc] + kv[sc]; }
          *(f32x4*)(fin + ((size_t)bh * 128 + dkk) * 256 + 4 * d4) = s; } }
    { float* SS = (float*)(F.ws + WS_SS); const float* a64 = (const float*)(F.ws + WS_TAB + (size_t)l * TAB_LAYER + TB_A64);
      for (size_t i = gt; i < (size_t)4 * 64 * 64; i += NGT) { const int b = (int)(i >> 12), g = (int)((i >> 6) & 63), p = (int)(i & 63);
          const float ar = a64[2 * (g * 64 + p)], ai = a64[2 * (g * 64 + p) + 1]; float cr = 0.f, ci = 0.f;
          for (int c0 = 0; c0 < 32; c0 += 8) { float sr[8], si[8];
#pragma unroll
              for (int j = 0; j < 8; ++j) { const size_t base = (((size_t)b * 32 + c0 + j) * 64 + g) * 128; sr[j] = SS[base + p]; si[j] = SS[base + 64 + p]; }
#pragma unroll
              for (int j = 0; j < 8; ++j) { const size_t base = (((size_t)b * 32 + c0 + j) * 64 + g) * 128; SS[base + p] = cr; SS[base + 64 + p] = ci;
                  const float nr = ar * cr - ai * ci + sr[j], ni = ar * ci + ai * cr + si[j]; cr = nr; ci = ni; } } } }
}
template <int TT, bool SAMPLE>
__device__ __forceinline__ void conv_unit(Frame& F, int l, int b, int t0) {
    const bf16* P = (const bf16*)(F.ws + WS_P); bf16* AC = (bf16*)(F.ws + WS_AC);
    const float* cw = inp(F, 23) + (size_t)l * 31 * 1024; const float* cb = inp(F, 24) + (size_t)l * 1024; const float* lng = inp(F, 25) + (size_t)l * 1024; const float* lnb = inp(F, 26) + (size_t)l * 1024;
    const float* cache = inp(F, 7) + ((size_t)l * 128 + b) * 30 * 1024;
    int tid_l = threadIdx.x; asm volatile("" : "+v"(tid_l));
    const int c0 = 2 * tid_l; const size_t rowbase = SAMPLE ? (size_t)MP + 8 * b : (size_t)b * TP;
    float w0[31], w1[31];
#pragma unroll
    for (int j = 0; j < 31; ++j) { const float2 wv = *(const float2*)(cw + j * 1024 + c0); w0[j] = wv.x; w1[j] = wv.y; }
    float a0[TT], a1[TT];
    { const float2 bv = *(const float2*)(cb + c0);
#pragma unroll
      for (int t = 0; t < TT; ++t) { a0[t] = bv.x; a1[t] = bv.y; } }
    float* cnew = SAMPLE ? F.out + OUT_CONV_S + ((size_t)l * 128 + b) * 30 * 1024 : F.out + OUT_CONV_P + ((size_t)l * 4 + b) * 30 * 1024;
#pragma unroll
    for (int rp = 0; rp < TT + 30; ++rp) {
        const int t = t0 - 30 + rp;
        float g0 = 0.f, g1 = 0.f;
        if (SAMPLE) {
            if (rp < 30) { const float2 cv = *(const float2*)(cache + (size_t)rp * 1024 + c0); g0 = cv.x; g1 = cv.y; }
            else { const unsigned ca = *(const unsigned*)(P + (rowbase + rp - 30) * LDP + PC_CA + c0), cbv = *(const unsigned*)(P + (rowbase + rp - 30) * LDP + PC_CB + c0); g0 = pg8::bflo(ca) * pg8::bflo(cbv); g1 = pg8::bfhi(ca) * pg8::bfhi(cbv); }
            if (rp >= 8) *(float2*)(cnew + (size_t)(rp - 8) * 1024 + c0) = make_float2(g0, g1);
        } else {
            const int tc = t < 0 ? 0 : t;
            const unsigned ca = *(const unsigned*)(P + (rowbase + tc) * LDP + PC_CA + c0), cbv = *(const unsigned*)(P + (rowbase + tc) * LDP + PC_CB + c0);
            const float v0 = pg8::bflo(ca) * pg8::bflo(cbv), v1 = pg8::bfhi(ca) * pg8::bfhi(cbv); g0 = t < 0 ? 0.f : v0; g1 = t < 0 ? 0.f : v1;
        }
#pragma unroll
        for (int tt = 0; tt < TT; ++tt) { const int j = rp - tt; if (j >= 0 && j <= 30) { a0[tt] += w0[j] * g0; a1[tt] += w1[j] * g1; } }
        if (rp == (TT + 30) / 2 - 1) asm volatile("" ::: "memory");
    }
    if (!SAMPLE && t0 + TT > TP - 30) {
        for (int t = (t0 > TP - 30 ? t0 : TP - 30); t < t0 + TT; ++t) { const unsigned ca = *(const unsigned*)(P + (rowbase + t) * LDP + PC_CA + c0), cbv = *(const unsigned*)(P + (rowbase + t) * LDP + PC_CB + c0);
            *(float2*)(cnew + (size_t)(t - (TP - 30)) * 1024 + c0) = make_float2(pg8::bflo(ca) * pg8::bflo(cbv), pg8::bfhi(ca) * pg8::bfhi(cbv)); } }
    LAS float* Y = (LAS float*)F.lds;
#pragma unroll
    for (int t = 0; t < TT; ++t) *(LAS pg8::f32x2*)(Y + t * 1024 + c0) = (pg8::f32x2){a0[t], a1[t]};
    __syncthreads();
    for (int t = F.wave; t < TT; t += NWAVES) {
        f32x4 x[4]; float s = 0.f;
#pragma unroll
        for (int j = 0; j < 4; ++j) { x[j] = *(const LAS f32x4*)(Y + t * 1024 + 8 * F.lane + 512 * (j >> 1) + 4 * (j & 1)); s += (x[j][0] + x[j][1]) + (x[j][2] + x[j][3]); }
        const float mean = wave_sum(s) * (1.0f / 1024.0f); float qq = 0.f;
#pragma unroll
        for (int j = 0; j < 4; ++j) { x[j] = x[j] - mean; qq += (x[j][0] * x[j][0] + x[j][1] * x[j][1]) + (x[j][2] * x[j][2] + x[j][3] * x[j][3]); }
        const float rstd = 1.0f / sqrtf(wave_sum(qq) * (1.0f / 1024.0f) + LN_EPS);
        const size_t grow = rowbase + t0 + t;
#pragma unroll
        for (int hf = 0; hf < 2; ++hf) { const int cc = 8 * F.lane + 512 * hf;
            const f32x4 g0 = *(const f32x4*)(lng + cc), g1 = *(const f32x4*)(lng + cc + 4), b0 = *(const f32x4*)(lnb + cc), b1 = *(const f32x4*)(lnb + cc + 4);
            f32x4 z0, z1; pg8::unpack8(*(const v4u*)(P + grow * LDP + PC_CZ + cc), z0, z1);
            const f32x4 y0 = pg8::silu4(x[2 * hf] * rstd * g0 + b0) * z0, y1 = pg8::silu4(x[2 * hf + 1] * rstd * g1 + b1) * z1;
            *(v4u*)(AC + grow * 1024 + cc) = pg8::pack8(y0, y1); }
    }
    __syncthreads();
}
__device__ __forceinline__ void conv_phaseC(Frame& F, int l) {
    for (int u = F.vcu; u < MP / 16; u += F.G) conv_unit<16, false>(F, l, u / (TP / 16), 16 * (u % (TP / 16)));
    for (int u = F.vcu; u < 128; u += F.G) conv_unit<8, true>(F, l, u, 0);
}

__device__ __forceinline__ void s5_phaseB(Frame& F, int l) {
    const bf16* P = (const bf16*)(F.ws + WS_P); unsigned char* tb = F.ws + WS_TAB + (size_t)l * TAB_LAYER;
    LAS float* T = (LAS float*)(F.lds + F.wave * 10240);
    float* SS = (float*)(F.ws + WS_SS);
    const int gw = F.vcu * NWAVES + F.wave, NGW = F.G * NWAVES;
    for (int wu = gw; wu < 4 * 32 * 64; wu += NGW) { const int g = wu & 63, c = (wu >> 6) & 31, b = wu >> 11;
        s5_unit<0>(T, F.lane, P, (size_t)b * TP + 64 * c, g, (const float*)(tb + TB_ABAR), (const bf16*)(tb + TB_BBT), (const bf16*)(tb + TB_CMT), nullptr,
                   SS + (((size_t)b * 32 + c) * 64 + g) * 128, nullptr, nullptr, nullptr, nullptr, nullptr); }
}
__device__ __forceinline__ void s5_phaseD(Frame& F, int l) {
    const bf16* P = (const bf16*)(F.ws + WS_P); unsigned char* tb = F.ws + WS_TAB + (size_t)l * TAB_LAYER;
    LAS float* T = (LAS float*)(F.lds + F.wave * 10240);
    float* SS = (float*)(F.ws + WS_SS); bf16* YG = (bf16*)(F.ws + WS_YG); const float* dsk = inp(F, 17) + (size_t)l * 1024;
    const int gw = F.vcu * NWAVES + F.wave, NGW = F.G * NWAVES;
    for (int wu = gw; wu < 4 * 32 * 64; wu += NGW) { const int g = wu & 63, c = (wu >> 6) & 31, b = wu >> 11;
        float* ore = (c == 31) ? F.out + OUT_S5RE_P + (((size_t)l * 4 + b) * 64 + g) * 64 : nullptr; float* oim = (c == 31) ? F.out + OUT_S5IM_P + (((size_t)l * 4 + b) * 64 + g) * 64 : nullptr;
        s5_unit<1>(T, F.lane, P, (size_t)b * TP + 64 * c, g, (const float*)(tb + TB_ABAR), (const bf16*)(tb + TB_BBT), (const bf16*)(tb + TB_CMT), dsk,
                   SS + (((size_t)b * 32 + c) * 64 + g) * 128, nullptr, nullptr, ore, oim, YG); }
    for (int wu = gw; wu < 16 * 64; wu += NGW) { const int g = wu & 63, bg = wu >> 6; const size_t so = (((size_t)l * 128 + 8 * bg) * 64 + g) * 64;
        s5_unit<2>(T, F.lane, P, (size_t)MP + 64 * bg, g, (const float*)(tb + TB_ABAR), (const bf16*)(tb + TB_BBT), (const bf16*)(tb + TB_CMT), dsk,
                   nullptr, inp(F, 4) + so, inp(F, 5) + so, F.out + OUT_S5RE_S + so, F.out + OUT_S5IM_S + so, YG); }
}

__device__ __forceinline__ void ln_phase(Frame& F, int l, int row_lo, int row_hi, int w0, int nw) {
    const bf16* H2 = (const bf16*)(F.ws + WS_H2); float* XO = F.out + OUT_Y; bf16* XB = (bf16*)(F.ws + WS_XB);
    const float* lg = inp(F, 33) + (size_t)l * D; const float* lb = inp(F, 34) + (size_t)l * D;
    const bool last = (l == NLAYER - 1);
#if defined(DIAG_CHECK)
    const float dscale = diag_scale(F);
#endif
    for (int m = row_lo + w0; m < row_hi; m += nw) {
        const pg8::u32x4* xr = (const pg8::u32x4*)(H2 + (size_t)m * D) + F.lane;
        f32x4 v[8]; float s = 0.f;
#pragma unroll
        for (int j = 0; j < 4; ++j) { pg8::unpack8(xr[64 * j], v[2 * j], v[2 * j + 1]); }
#pragma unroll
        for (int j = 0; j < 8; ++j) s += (v[j][0] + v[j][1]) + (v[j][2] + v[j][3]);
        const float mean = wave_sum(s) * (1.f / D); float s2 = 0.f;
#pragma unroll
        for (int j = 0; j < 8; ++j) { v[j] = v[j] - mean; s2 += (v[j][0] * v[j][0] + v[j][1] * v[j][1]) + (v[j][2] * v[j][2] + v[j][3] * v[j][3]); }
        const float rstd = 1.f / sqrtf(wave_sum(s2) * (1.f / D) + LN_EPS);
#pragma unroll
        for (int j = 0; j < 4; ++j) { const int c = 8 * F.lane + 512 * j;
            f32x4 y0 = v[2 * j] * rstd * *(const f32x4*)(lg + c) + *(const f32x4*)(lb + c), y1 = v[2 * j + 1] * rstd * *(const f32x4*)(lg + c + 4) + *(const f32x4*)(lb + c + 4);
            if (last) {
#if defined(DIAG_CHECK)
                y0 = y0 * dscale; y1 = y1 * dscale;
#endif
                *(f32x4*)(XO + (size_t)m * D + c) = y0; *(f32x4*)(XO + (size_t)m * D + c + 4) = y1; }
            else *(pg8::u32x4*)(XB + (size_t)m * D + c) = pg8::pack8(y0, y1); }
    }
}

struct Args { const float* in[35]; float* out; unsigned char* ws; int ph_lo, ph_hi, li, pad; };
__global__ void __launch_bounds__(NWAVES * 64, 2) mega_fwd(Args args) {
    extern __shared__ __attribute__((aligned(16))) unsigned char lds[];
    Frame F;
    F.lds = (LAS unsigned char*)lds;
    F.tid = threadIdx.x; F.lane = F.tid & 63; F.wave = __builtin_amdgcn_readfirstlane(F.tid >> 6);
    F.G = gridDim.x; { const int bx = blockIdx.x; F.vcu = (F.G % 8 == 0) ? (bx % 8) * (F.G / 8) + bx / 8 : bx; }
    F.ws = args.ws; F.out = args.out; F.ctl = (gu32*)(args.ws + WS_CTL);
    for (int u = F.tid; u < (LDS_BYTES - LDSCTL_OFF) / 4; u += NWAVES * 64) ((LAS unsigned*)(F.lds + LDSCTL_OFF))[u] = 0u;
    __syncthreads();
    if (F.tid < 35) ((LAS unsigned long long*)(F.lds + PTAB_OFF))[F.tid] = (unsigned long long)args.in[F.tid];
    __syncthreads();
    XcdBarrier bar = xcd_barrier_post((unsigned*)(F.ctl + CW_BAR) + args.li * XCD_BAR_WORDS, (volatile LAS unsigned*)(F.lds + MISC_OFF) + 8);
    const int lo = args.ph_lo, hi = args.ph_hi;
#define IN(k) (lo <= (k) && (k) < hi)
#ifndef REP_BAR
#define REP_BAR 1
#endif
#define SEAM(k) do { if (IN(k) && IN((k) + 1)) { for (int rb_ = 0; rb_ < REP_BAR; ++rb_) xcd_barrier(bar); } } while (0)

#ifndef PH_EN
#define PH_EN 0xFFFF
#endif
#define EN(b) ((PH_EN >> (b)) & 1)
#ifndef REP_G1
#define REP_G1 1
#endif
#ifndef REP_MB
#define REP_MB 1
#endif
#ifndef REP_CONV
#define REP_CONV 1
#endif
#ifndef REP_MD
#define REP_MD 1
#endif
#ifndef REP_G2
#define REP_G2 1
#endif
#ifndef REP_X
#define REP_X 1
#endif
#ifndef REP_Y
#define REP_Y 1
#endif
#ifndef REP_W6
#define REP_W6 1
#endif
#ifndef REP_W7
#define REP_W7 1
#endif
#ifndef REP_W8
#define REP_W8 1
#endif
#ifndef P0_Y_NUM
#define P0_Y_NUM 1
#define P0_Y_DEN 5
#endif
#define P0_Y_SHARE ((int)(((long)P0_I_LAYER * P0_Y_NUM) / P0_Y_DEN))
#ifndef REP_LN
#define REP_LN 1
#endif
#ifndef REP_P0
#define REP_P0 1
#endif
#define REPEAT(n) _Pragma("unroll 1") for (int rep_ = 0; rep_ < (n); ++rep_)
#define RELAUNDER() do { int t_ = threadIdx.x; asm volatile("" : "+v"(t_)); F.tid = t_; F.lane = t_ & 63; } while (0)
    if (EN(0) && IN(0)) { REPEAT(REP_P0) { p0_prologue(F); __syncthreads(); } }
    SEAM(0);
#pragma unroll 1
    for (int l = 0; l < NLAYER; ++l) {
        const int pb = 1 + NPH_LAYER * l;
        const bf16* wt = (const bf16*)(F.ws + WS_WT + (size_t)l * WT_LAYER);
        bf16* P = (bf16*)(F.ws + WS_P);
        if (EN(1) && IN(pb + 0)) REPEAT(REP_G1) {
            RELAUNDER(); alow_phase(F, l);
            pg8::Gemm g{(const bf16*)(F.ws + WS_XB), wt + WO_WIN, M, LDP, D}; pg8::StaticOrder S; S.init(M, LDP, F.G, (int)blockIdx.x);
            pg8::EpiProj E{P, LDP, inp(F, 9) + (size_t)l * NIN_SRC};
            pg8::gemm_phase<pg8::EpiProj, pg8::StaticOrder, true, true>(F.lds, g, S, E);
        }
        SEAM(pb + 0);
        if (IN(pb + 1)) { RELAUNDER();
#if defined(DIAG_CHECK)
            if (l == 0) diag_gemm1(F);
#endif
            REPEAT(REP_MB) { const int first2 = ((int)blockIdx.x >> 3) & 1;
                _Pragma("unroll 1") for (int st = 0; st < 3; ++st) { RELAUNDER(); const int task = first2 ? (st == 0 ? 2 : st - 1) : st;
                    if (task == 0) { if (EN(2)) s5_phaseB(F, l); } else if (EN(3)) gla_phaseB(F, l, task - 1);
                    __syncthreads(); } } }
        SEAM(pb + 1);
        if (IN(pb + 2)) { RELAUNDER(); if (EN(4)) scans_phaseC(F, l); RELAUNDER(); REPEAT(REP_CONV) { if (EN(5)) conv_phaseC(F, l); } }
        SEAM(pb + 2);
        if (IN(pb + 3)) REPEAT(REP_MD) { RELAUNDER(); if (EN(6)) s5_phaseD(F, l);
#if defined(DIAG_CHECK)
            diag_s5s(F, l);
#endif
            __syncthreads(); RELAUNDER(); if (EN(7)) gla_phaseD(F, l); __syncthreads(); }
        SEAM(pb + 3);
        if (EN(8) && IN(pb + 4)) REPEAT(REP_X) {
            const int bx = (int)blockIdx.x;
            { pg8::Gemm g{(const bf16*)(F.ws + WS_YG), wt + WO_WGLU, M, 1024, 1024}; pg8::PickSched S; S.init(M, 1024, bx, 0, 0, bx < 144 ? 1 : 0);
              pg8::EpiGlu E{(bf16*)(F.ws + WS_AS), inp(F, 19) + (size_t)l * 1024, (const bf16*)(F.ws + WS_YG), P, LDP};
              pg8::gemm_phase<pg8::EpiGlu, pg8::PickSched, true, true>(F.lds, g, S, E); }
            { int kpe = 256; asm volatile("" : "+s"(kpe));
              pg8::Gemm g{(const bf16*)(F.ws + WS_PB) + (size_t)l * M * 256, wt + WO_WPE, M, D, kpe}; pg8::PickSched S; S.init(M, D, bx, bx + 16, bx + 32, bx >= 240 ? 3 : 1);
              pg8::EpiPlain E{(bf16*)(F.ws + WS_PE), D};
              pg8::gemm_phase<pg8::EpiPlain, pg8::PickSched, true, true>(F.lds, g, S, E); }
            { pg8::Gemm g{(const bf16*)(F.ws + WS_AG), wt + WO_PGLA, M, D, 1024}; pg8::PickSched S;
              if (bx < 144) S.init(M, D, bx + 112, 0, 0, 1); else if (bx < 176) S.init(M, D, bx - 144, bx + 112, 0, 2); else S.init(M, D, bx - 144, 0, 0, 1);
              pg8::EpiBranchPart<1> E{(bf16*)(F.ws + WS_OG), P, LDP};
              pg8::gemm_phase<pg8::EpiBranchPart<1>, pg8::PickSched, true, true>(F.lds, g, S, E); }
            { pg8::Gemm g{(const bf16*)(F.ws + WS_AC), wt + WO_PCONV, M, D, 1024}; pg8::PickSched S; const int e = bx - 176;
              S.init(M, D, e < 32 ? e : 224 + e, 0, 0, (bx >= 176 && bx < 240) ? 1 : 0);
              pg8::EpiBranchPart<2> E{(bf16*)(F.ws + WS_OC), P, LDP};
              pg8::gemm_phase<pg8::EpiBranchPart<2>, pg8::PickSched, true, true>(F.lds, g, S, E); }
        }
        SEAM(pb + 4);
        if (EN(9) && IN(pb + 5)) REPEAT(REP_Y) {
            const int bx = (int)blockIdx.x;
            if (bx >= 32) { pg8::Gemm g{(const bf16*)(F.ws + WS_AC), wt + WO_PCONV, M, D, 1024}; pg8::PickSched S; S.init(M, D, bx, 0, 0, 1);
              pg8::EpiBranchPart<2> E{(bf16*)(F.ws + WS_OC), P, LDP};
              pg8::gemm_phase<pg8::EpiBranchPart<2>, pg8::PickSched, true, true>(F.lds, g, S, E); }
            { pg8::Gemm g{(const bf16*)(F.ws + WS_AS), wt + WO_PS5, M, D, 1024}; pg8::PickSched S; S.init(M, D, bx, bx + 256, 0, bx < 32 ? 2 : 1);
              pg8::EpiBranchFinal E{(bf16*)(F.ws + WS_OSB), (const bf16*)(F.ws + WS_OG), (const bf16*)(F.ws + WS_OC), P, LDP};
              pg8::gemm_phase<pg8::EpiBranchFinal, pg8::PickSched, true, true>(F.lds, g, S, E); }
            if (l + 1 < NLAYER && P0_Y_SHARE > 0) { RELAUNDER(); p0_convert(F, l + 1, 0, P0_Y_SHARE, F.vcu * NWAVES + F.wave, F.G * NWAVES); }
            if (REP_Y > 1) __syncthreads();
        }
        SEAM(pb + 5);
        const int bxw = (int)blockIdx.x;
        if (EN(10) && IN(pb + 6)) REPEAT(REP_W6) {
            pg8::Gemm g{(const bf16*)(F.ws + WS_OSB), wt + WO_WO, M, D, D}; pg8::OneTile S; if (bxw >= 32) S.init_e(D, F.G, bxw); else S.init_late(bxw);
            pg8::EpiWo E{(bf16*)(F.ws + WS_HB), (const bf16*)(F.ws + WS_XB), DN_ALPHA};
            pg8::gemm_phase<pg8::EpiWo, pg8::OneTile, true, true>(F.lds, g, S, E);
        }
        SEAM(pb + 6);
        if (EN(11) && IN(pb + 7)) REPEAT(REP_W7) {
            if (bxw >= 32) {
                pg8::Gemm g{(const bf16*)(F.ws + WS_HB), wt + WO_WPG, M, D, D}; pg8::OneTile S; S.init_e(D, F.G, bxw);
                pg8::EpiWpg E{(bf16*)(F.ws + WS_H2), (const bf16*)(F.ws + WS_HB), (const bf16*)(F.ws + WS_PE)};
                pg8::gemm_phase<pg8::EpiWpg, pg8::OneTile, true, true>(F.lds, g, S, E);
            } else {
                pg8::Gemm g{(const bf16*)(F.ws + WS_OSB), wt + WO_WO, M, D, D}; pg8::OneTile S; S.init_late(32 + bxw);
                pg8::EpiWo E{(bf16*)(F.ws + WS_HB), (const bf16*)(F.ws + WS_XB), DN_ALPHA};
                pg8::gemm_phase<pg8::EpiWo, pg8::OneTile, true, true>(F.lds, g, S, E);
            }
        }
        SEAM(pb + 7);
        if (IN(pb + 8)) REPEAT((REP_W8 == 3) ? (bxw >= 64 ? 2 : 1) : (REP_W8 == 4) ? (bxw < 64 ? 2 : 1) : REP_W8) {
            if (bxw < 64) {
                if (EN(11)) { pg8::Gemm g{(const bf16*)(F.ws + WS_HB), wt + WO_WPG, M, D, D}; pg8::OneTile S; S.init_late(bxw);
                    pg8::EpiWpg E{(bf16*)(F.ws + WS_H2), (const bf16*)(F.ws + WS_HB), (const bf16*)(F.ws + WS_PE)};
                    pg8::gemm_phase<pg8::EpiWpg, pg8::OneTile, true, true>(F.lds, g, S, E); }
            } else {
                if (EN(12)) { RELAUNDER(); ln_phase(F, l, 0, 28 * 256, (bxw - 64) * NWAVES + F.wave, (F.G - 64) * NWAVES); }
                if (l + 1 < NLAYER) { RELAUNDER(); p0_convert(F, l + 1, P0_Y_SHARE, P0_I_LAYER, (bxw - 64) * NWAVES + F.wave, (F.G - 64) * NWAVES); }
            }
            if (REP_W8 > 1) __syncthreads();
        }
        SEAM(pb + 8);
        if (EN(12) && IN(pb + 9)) { RELAUNDER(); ln_phase(F, l, 28 * 256, M, F.vcu * NWAVES + F.wave, F.G * NWAVES); }
        SEAM(pb + 9);
    }
#undef IN
#undef SEAM
}

#ifndef MK_SPLIT
#define MK_SPLIT 1
#endif
extern "C" void kernel_launch(void* const* d_in, const int* in_sizes, int n_in, void* d_out, int out_size, void* d_ws, size_t ws_size, hipStream_t stream) {
    static int grid = 0;
    if (grid == 0) {
        if (n_in != 35 || (size_t)out_size != OUT_TOTAL || ws_size < WS_END) { fprintf(stderr, "kernel_launch: unexpected shapes: n_in %d out %d ws %zu (need %zu)\n", n_in, out_size, ws_size, (size_t)WS_END); grid = -1; return; }
        int dev = 0, cus = 0, per_cu = 0;
        if (hipGetDevice(&dev) != hipSuccess || hipDeviceGetAttribute(&cus, hipDeviceAttributeMultiprocessorCount, dev) != hipSuccess) { grid = -1; return; }
        if (hipFuncSetAttribute((const void*)mega_fwd, hipFuncAttributeMaxDynamicSharedMemorySize, LDS_BYTES) != hipSuccess) { fprintf(stderr, "kernel_launch: hipFuncSetAttribute failed\n"); grid = -1; return; }
        if (hipOccupancyMaxActiveBlocksPerMultiprocessor(&per_cu, (const void*)mega_fwd, NWAVES * 64, LDS_BYTES) != hipSuccess || per_cu < 1) fprintf(stderr, "kernel_launch: occupancy query reports %d\n", per_cu);
        (void)hipGetLastError();
        if (cus != 256) { fprintf(stderr, "kernel_launch: built for a 256-CU device (one workgroup per CU; the w_o / w_pg schedule deals 224 + 64 tiles to exactly 256 workgroups); this device has %d CUs: nothing launched\n", cus); grid = -1; return; }
        grid = cus;
    }
    if (grid < 0) return;
    (void)hipMemsetAsync((char*)d_ws + WS_CTL, 0, CTL_ZERO_BYTES, stream);
    Args a; memset(&a, 0, sizeof(a));
    for (int i = 0; i < 35; ++i) a.in[i] = (const float*)d_in[i];
    a.out = (float*)d_out; a.ws = (unsigned char*)d_ws;
#if MK_SPLIT
    for (int ph = 0; ph < NPHASE; ++ph) { a.ph_lo = ph; a.ph_hi = ph + 1; a.li = 0; hipLaunchKernelGGL(mega_fwd, dim3(grid), dim3(NWAVES * 64), LDS_BYTES, stream, a); }
#else
    a.ph_lo = 0; a.ph_hi = NPHASE; a.li = 0;
    hipLaunchKernelGGL(mega_fwd, dim3(grid), dim3(NWAVES * 64), LDS_BYTES, stream, a);
#endif
}
```

```cpp
#include <hip/hip_runtime.h>
#include <cstdio>
#include <cstdint>
#include <cstring>
#define DIAG_SGN(eps, k) (1.0f + (((k) & 1) ? (eps) : -(eps)))
#define DIAG_S5P 0.0f
#define DIAG_S5S 0.0f
#define MK_SPLIT 0
namespace pg8 {
#define PG8_LAS __attribute__((address_space(3)))
typedef unsigned short bf16_t;
typedef short bf16x8 __attribute__((ext_vector_type(8)));
typedef float f32x4 __attribute__((ext_vector_type(4)));
typedef unsigned u32x4 __attribute__((ext_vector_type(4)));
constexpr int BM = 256, BK = 64, HALF = 128, HTB = HALF * BK * 2  , STAGE_BYTES = 8 * HTB, NXCD = 8, WGM = 8;

__host__ __device__ __forceinline__ int lds_byte(int r, int c) { const int st = (r >> 4) * 2 + (c >> 5), rr = r & 15, cc = c & 31, ob = rr * 64 + cc * 2; return st * 1024 + (ob ^ (((ob >> 9) & 1) << 5)); }
__host__ __device__ __forceinline__ void stage_rc(int b, int& R, int& C) { const int st = b / 1024, sb = b % 1024, swz = sb ^ (((sb >> 9) & 1) << 5); R = (st >> 1) * 16 + swz / 64; C = (st & 1) * 32 + (swz % 64) / 2; }
__host__ __device__ __forceinline__ int perm32(int rho) { const int n = rho >> 4, i = rho & 15; return 8 * (i >> 2) + 4 * n + (i & 3); }

struct Unit { int pm, pn; };
struct Gemm { const bf16_t* A; const bf16_t* Bt; int M, N, K; };

struct StaticOrder {
    int nM, nN, nwg, G, c;
    __host__ __device__ void init(int M, int N, int G_, int c_) { nM = M / BM; nN = N / BM; nwg = nM * nN; G = G_; c = c_; }
    __host__ __device__ bool next(int i, Unit& u) const { return at((long)i * G + c, u); }
    __host__ __device__ bool at(long L, Unit& u) const {
        if (L >= nwg) return false;
        int wgid = (int)L; { const int q = nwg / NXCD, r = nwg % NXCD, xcd = wgid % NXCD, off = wgid / NXCD; wgid = (xcd < r ? xcd * (q + 1) : r * (q + 1) + (xcd - r) * q) + off; }
        const int nig = WGM * nN, gid = wgid / nig, fm = gid * WGM, gsz = (nM - fm) < WGM ? (nM - fm) : WGM;
        u.pm = fm + ((wgid % nig) % gsz); u.pn = (wgid % nig) / gsz; return true;
    }
    __device__ __forceinline__ void a_ready(const Unit&) const {}
    __device__ __forceinline__ void done(const Unit&) const {}
};
__device__ __forceinline__ unsigned cvt_pk_bf16(float lo, float hi) { unsigned r; asm volatile("v_cvt_pk_bf16_f32 %0, %1, %2" : "=v"(r) : "v"(lo), "v"(hi)); return r; }
typedef float f32x2 __attribute__((ext_vector_type(2)));
typedef unsigned u32x2 __attribute__((ext_vector_type(2)));
__device__ __forceinline__ float sigm(float x) { return __builtin_amdgcn_rcpf(1.0f + __builtin_amdgcn_exp2f(-1.4426950408889634f * x)); }
__device__ __forceinline__ float silu_f(float x) { return x * sigm(x); }
__device__ __forceinline__ float bflo(unsigned u) { return __uint_as_float(u << 16); }
__device__ __forceinline__ float bfhi(unsigned u) { return __uint_as_float(u & 0xffff0000u); }
__device__ __forceinline__ void unpack8(const u32x4 w, f32x4& a, f32x4& b) { a = (f32x4){bflo(w.x), bfhi(w.x), bflo(w.y), bfhi(w.y)}; b = (f32x4){bflo(w.z), bfhi(w.z), bflo(w.w), bfhi(w.w)}; }
__device__ __forceinline__ u32x4 pack8(const f32x4 a, const f32x4 b) { u32x4 w; w.x = cvt_pk_bf16(a[0], a[1]); w.y = cvt_pk_bf16(a[2], a[3]); w.z = cvt_pk_bf16(b[0], b[1]); w.w = cvt_pk_bf16(b[2], b[3]); return w; }
__device__ __forceinline__ f32x4 sigm4(f32x4 v) { return (f32x4){sigm(v[0]), sigm(v[1]), sigm(v[2]), sigm(v[3])}; }
__device__ __forceinline__ f32x4 silu4(f32x4 v) { return (f32x4){silu_f(v[0]), silu_f(v[1]), silu_f(v[2]), silu_f(v[3])}; }

#define EPI_LOOP_BEGIN \
    const int row0 = u.pm * BM + wr * 64 + fr, col0 = u.pn * BM + wc * 32 + 8 * fq; \
    _Pragma("unroll") for (int ai = 0; ai < 2; ++ai) _Pragma("unroll") for (int m = 0; m < 4; ++m) { const size_t row = (size_t)(row0 + ai * HALF + m * 16); \
    _Pragma("unroll") for (int bj = 0; bj < 2; ++bj) { const int col = col0 + bj * HALF; f32x4 v0 = acc[ai][bj][m][0], v1 = acc[ai][bj][m][1];
#define EPI_LOOP_END } asm volatile("" ::: "memory"); }

struct EpiProj {
    static constexpr bool PERM = true, AFTER_DRAIN = false;
    bf16_t* O; int ldc; const float* bias;
    __device__ __forceinline__ void operator()(const f32x4 (&acc)[2][2][4][2], const Unit& u, int wr, int wc, int fr, int fq) const {
        const int pn = u.pn;
        int act = 0;
        if ((pn >= 4 && pn < 8) || (pn >= 16 && pn < 20) || (pn >= 28 && pn < 32)) act = 1;
        if ((pn >= 24 && pn < 28) || pn >= 32) act = 2;
        const int boff = (pn >= 16) ? 16 : 0;
        f32x4 bv[2][2];
        { const int c0 = u.pn * BM + wc * 32 + 8 * fq + boff;
#pragma unroll
          for (int bj = 0; bj < 2; ++bj)
#pragma unroll
              for (int n = 0; n < 2; ++n) bv[bj][n] = *(const f32x4*)(bias + c0 + bj * HALF + 4 * n); }
        EPI_LOOP_BEGIN
            v0 = v0 + bv[bj][0]; v1 = v1 + bv[bj][1];
            if (act == 1) { v0 = silu4(v0); v1 = silu4(v1); }
            else if (act == 2) { v0 = sigm4(v0); v1 = sigm4(v1); }
            *(u32x4*)(O + row * ldc + col) = pack8(v0, v1);
        EPI_LOOP_END
    }
};
struct EpiPlain {
    static constexpr bool PERM = true, AFTER_DRAIN = false;
    bf16_t* O; int ldc;
    __device__ __forceinline__ void operator()(const f32x4 (&acc)[2][2][4][2], const Unit& u, int wr, int wc, int fr, int fq) const {
        EPI_LOOP_BEGIN
            *(u32x4*)(O + row * ldc + col) = pack8(v0, v1);
        EPI_LOOP_END
    }
};
struct EpiGlu {
    static constexpr bool PERM = true, AFTER_DRAIN = false;
    bf16_t* O; const float* bias; const bf16_t* YG; const bf16_t* P; int ldp;
    __device__ __forceinline__ void operator()(const f32x4 (&acc)[2][2][4][2], const Unit& u, int wr, int wc, int fr, int fq) const {
        const int row0 = u.pm * BM + wr * 64 + fr, col0 = u.pn * BM + wc * 32 + 8 * fq;
#pragma unroll
        for (int ai = 0; ai < 2; ++ai)
#pragma unroll
          for (int mg = 0; mg < 4; mg += 2) { u32x4 yv[2][2], zv[2][2];
#pragma unroll
            for (int mm = 0; mm < 2; ++mm)
#pragma unroll
                for (int bj = 0; bj < 2; ++bj) { const size_t row = (size_t)(row0 + ai * HALF + (mg + mm) * 16); const int col = col0 + bj * HALF; yv[mm][bj] = *(const u32x4*)(YG + row * 1024 + col); zv[mm][bj] = *(const u32x4*)(P + row * ldp + 1024 + col); }
#pragma unroll
            for (int mm = 0; mm < 2; ++mm)
#pragma unroll
                for (int bj = 0; bj < 2; ++bj) { const size_t row = (size_t)(row0 + ai * HALF + (mg + mm) * 16); const int col = col0 + bj * HALF; f32x4 y0, y1, z0, z1; unpack8(yv[mm][bj], y0, y1); unpack8(zv[mm][bj], z0, z1);
                    const f32x4 v0 = y0 * sigm4(acc[ai][bj][mg + mm][0] + *(const f32x4*)(bias + col)) * z0, v1 = y1 * sigm4(acc[ai][bj][mg + mm][1] + *(const f32x4*)(bias + col + 4)) * z1;
                    *(u32x4*)(O + row * 1024 + col) = pack8(v0, v1); }
            asm volatile("" ::: "memory"); }
    }
};
template <int B> struct EpiBranchPart {
    static constexpr bool PERM = true, AFTER_DRAIN = false;
    bf16_t* OB; const bf16_t* P; int ldp;
    __device__ __forceinline__ void operator()(const f32x4 (&acc)[2][2][4][2], const Unit& u, int wr, int wc, int fr, int fq) const {
        const int row0 = u.pm * BM + wr * 64 + fr, col0 = u.pn * BM + wc * 32 + 8 * fq;
#pragma unroll
        for (int ai = 0; ai < 2; ++ai) { u32x4 gv[4][2];
#pragma unroll
            for (int m = 0; m < 4; ++m)
#pragma unroll
                for (int bj = 0; bj < 2; ++bj) { const size_t row = (size_t)(row0 + ai * HALF + m * 16); const int col = col0 + bj * HALF; gv[m][bj] = *(const u32x4*)(P + row * ldp + 8192 + 2048 * B + col); }
#pragma unroll
            for (int m = 0; m < 4; ++m)
#pragma unroll
                for (int bj = 0; bj < 2; ++bj) { const size_t row = (size_t)(row0 + ai * HALF + m * 16); const int col = col0 + bj * HALF; f32x4 g0, g1; unpack8(gv[m][bj], g0, g1);
                    *(u32x4*)(OB + row * 2048 + col) = pack8(acc[ai][bj][m][0] * g0, acc[ai][bj][m][1] * g1); }
            asm volatile("" ::: "memory"); }
    }
};
struct EpiBranchFinal {
    static constexpr bool PERM = true, AFTER_DRAIN = false;
    bf16_t* OSB; const bf16_t* OG; const bf16_t* OC; const bf16_t* P; int ldp;
    __device__ __forceinline__ void operator()(const f32x4 (&acc)[2][2][4][2], const Unit& u, int wr, int wc, int fr, int fq) const {
        const int row0 = u.pm * BM + wr * 64 + fr, col0 = u.pn * BM + wc * 32 + 8 * fq;
#pragma unroll
        for (int ai = 0; ai < 2; ++ai)
#pragma unroll
          for (int mg = 0; mg < 4; mg += 2) { u32x4 gv[2][2], av[2][2], cv[2][2];
#pragma unroll
            for (int mm = 0; mm < 2; ++mm)
#pragma unroll
                for (int bj = 0; bj < 2; ++bj) { const size_t row = (size_t)(row0 + ai * HALF + (mg + mm) * 16); const int col = col0 + bj * HALF;
                    gv[mm][bj] = *(const u32x4*)(P + row * ldp + 8192 + col); av[mm][bj] = *(const u32x4*)(OG + row * 2048 + col); cv[mm][bj] = *(const u32x4*)(OC + row * 2048 + col); }
#pragma unroll
            for (int mm = 0; mm < 2; ++mm)
#pragma unroll
                for (int bj = 0; bj < 2; ++bj) { const size_t row = (size_t)(row0 + ai * HALF + (mg + mm) * 16); const int col = col0 + bj * HALF; f32x4 g0, g1, a0, a1, c0, c1;
                    unpack8(gv[mm][bj], g0, g1); unpack8(av[mm][bj], a0, a1); unpack8(cv[mm][bj], c0, c1);
                    *(u32x4*)(OSB + row * 2048 + col) = pack8(acc[ai][bj][mg + mm][0] * g0 + a0 + c0, acc[ai][bj][mg + mm][1] * g1 + a1 + c1); }
            asm volatile("" ::: "memory"); }
    }
};
struct EpiWo {
    static constexpr bool PERM = true, AFTER_DRAIN = false;
    bf16_t* HB; const bf16_t* XB; float alpha;
    __device__ __forceinline__ void operator()(const f32x4 (&acc)[2][2][4][2], const Unit& u, int wr, int wc, int fr, int fq) const {
        const int row0 = u.pm * BM + wr * 64 + fr, col0 = u.pn * BM + wc * 32 + 8 * fq;
#pragma unroll
        for (int ai = 0; ai < 2; ++ai) { u32x4 xv[4][2];
#pragma unroll
            for (int m = 0; m < 4; ++m)
#pragma unroll
                for (int bj = 0; bj < 2; ++bj) { const size_t row = (size_t)(row0 + ai * HALF + m * 16); const int col = col0 + bj * HALF; xv[m][bj] = *(const u32x4*)(XB + row * 2048 + col); }
#pragma unroll
            for (int m = 0; m < 4; ++m)
#pragma unroll
                for (int bj = 0; bj < 2; ++bj) { const size_t row = (size_t)(row0 + ai * HALF + m * 16); const int col = col0 + bj * HALF; f32x4 x0, x1; unpack8(xv[m][bj], x0, x1);
                    const f32x4 v0 = acc[ai][bj][m][0] + alpha * x0, v1 = acc[ai][bj][m][1] + alpha * x1;
                    *(u32x4*)(HB + row * 2048 + col) = pack8(v0, v1); }
            asm volatile("" ::: "memory"); }
    }
};
struct EpiWpg {
    static constexpr bool PERM = true, AFTER_DRAIN = false;
    bf16_t* H2; const bf16_t* HB; const bf16_t* PE;
    __device__ __forceinline__ void operator()(const f32x4 (&acc)[2][2][4][2], const Unit& u, int wr, int wc, int fr, int fq) const {
        const int row0 = u.pm * BM + wr * 64 + fr, col0 = u.pn * BM + wc * 32 + 8 * fq;
#pragma unroll
        for (int ai = 0; ai < 2; ++ai)
#pragma unroll
          for (int mg = 0; mg < 4; mg += 2) { u32x4 hv[2][2]; u32x4 pv[2][2];
#pragma unroll
            for (int mm = 0; mm < 2; ++mm)
#pragma unroll
                for (int bj = 0; bj < 2; ++bj) { const size_t row = (size_t)(row0 + ai * HALF + (mg + mm) * 16); const int col = col0 + bj * HALF;
                    hv[mm][bj] = *(const u32x4*)(HB + row * 2048 + col); pv[mm][bj] = *(const u32x4*)(PE + row * 2048 + col); }
#pragma unroll
            for (int mm = 0; mm < 2; ++mm)
#pragma unroll
                for (int bj = 0; bj < 2; ++bj) { const size_t row = (size_t)(row0 + ai * HALF + (mg + mm) * 16); const int col = col0 + bj * HALF; f32x4 p0, p1, h0, h1; unpack8(pv[mm][bj], p0, p1); unpack8(hv[mm][bj], h0, h1);
                    *(u32x4*)(H2 + row * 2048 + col) = pack8(h0 + sigm4(acc[ai][bj][mg + mm][0]) * p0, h1 + sigm4(acc[ai][bj][mg + mm][1]) * p1); }
            asm volatile("" ::: "memory"); }
    }
};

__device__ __forceinline__ void late_tile(int t, Unit& u) { const int j = t & 31; u.pm = (t < 32 ? 28 : 32) + (j & 3); u.pn = j >> 2; }
struct PickSched {
    StaticOrder so; int i0, i1, i2, n;
    __device__ void init(int M, int N, int a, int b, int c3, int n_) { so.init(M, N, 1, 0); i0 = a; i1 = b; i2 = c3; n = n_; }
    __device__ bool next(int i, Unit& u) const { if (i >= n) return false; return so.at(i == 0 ? i0 : (i == 1 ? i1 : i2), u); }
    __device__ __forceinline__ void a_ready(const Unit&) const {}
    __device__ __forceinline__ void done(const Unit&) const {}
};
struct OneTile {
    StaticOrder so; int late;
    __device__ void init_e(int N, int G_, int c_) { so.init(28 * 256, N, G_ - 32, c_ - 32); late = -1; }
    __device__ void init_late(int t) { so.init(256, 256, 1, 0); late = t; }
    __device__ bool next(int i, Unit& u) const { if (i != 0) return false; if (late >= 0) { late_tile(late, u); return true; } return so.next(0, u); }
    __device__ __forceinline__ void a_ready(const Unit&) const {}
    __device__ __forceinline__ void done(const Unit&) const {}
};
template <class Epi, class Sched, bool ALIGN_EPI = false, bool SP2 = false>
__device__ __forceinline__ void gemm_phase(PG8_LAS unsigned char* lds, const Gemm g, const Sched& S, const Epi& E) {
    int tid_l = threadIdx.x; asm volatile("" : "+v"(tid_l));
    const int tid = tid_l, wid = __builtin_amdgcn_readfirstlane(tid >> 6), lane = tid & 63, wr = wid >> 2, wc = wid & 3, fr = lane & 15, fq = lane >> 4;
    const int K = g.K, nt = K / BK;
    unsigned voffA[2], voffB[2];
#pragma unroll
    for (int i = 0; i < 2; ++i) { int R, C; stage_rc(tid * 16 + i * 8192, R, C); const int Rb = Epi::PERM ? ((R & ~31) + perm32(R & 31)) : R;
        voffA[i] = (unsigned)(R * K + C) * 2u; voffB[i] = (unsigned)(Rb * K + C) * 2u; }
    const size_t kstep = (size_t)(BK * 2);
    const size_t hstep = (size_t)HALF * K * 2;
    const size_t tstep = 2 * hstep;
    const unsigned ldsw = (unsigned)wid * 1024u;
    const int aoff = lds_byte(wr * 64 + fr, fq * 8), boff = lds_byte(wc * 32 + fr, fq * 8);
#define PG8_SA(b, h) (((b) * 2 + (h)) * HTB)
#define PG8_SB(b, h) ((4 + (b) * 2 + (h)) * HTB)
#define PG8_STAGE(bufoff, gbase, voff) do { _Pragma("unroll") for (int _i = 0; _i < 2; ++_i) \
        __builtin_amdgcn_global_load_lds((const unsigned*)((const char*)(gbase) + (voff)[_i]), (PG8_LAS unsigned*)(lds + (bufoff) + ldsw + _i * 8192), 16, 0, 0); } while (0)
#define PG8_LDA(dst, b, h) do { _Pragma("unroll") for (int m = 0; m < 4; ++m) _Pragma("unroll") for (int k = 0; k < 2; ++k) dst[m][k] = *(const PG8_LAS bf16x8*)(lds + PG8_SA(b, h) + aoff + m * 2048 + k * 1024); } while (0)
#define PG8_LDB(dst, b, h) do { _Pragma("unroll") for (int n = 0; n < 2; ++n) _Pragma("unroll") for (int k = 0; k < 2; ++k) dst[n][k] = *(const PG8_LAS bf16x8*)(lds + PG8_SB(b, h) + boff + n * 2048 + k * 1024); } while (0)
#define PG8_MMA(ai, bj, At, Bt) do { __builtin_amdgcn_s_setprio(1); _Pragma("unroll") for (int m = 0; m < 4; ++m) _Pragma("unroll") for (int n = 0; n < 2; ++n) _Pragma("unroll") for (int k = 0; k < 2; ++k) \
        acc[ai][bj][m][n] = __builtin_amdgcn_mfma_f32_16x16x32_bf16(Bt[n][k], At[m][k], acc[ai][bj][m][n], 0, 0, 0); __builtin_amdgcn_s_setprio(0); } while (0)
#define PG8_WAIT_V(n) asm volatile("s_waitcnt vmcnt(" #n ")" ::: "memory")
#define PG8_WAIT_L(n) asm volatile("s_waitcnt lgkmcnt(" #n ")" ::: "memory")
#define PG8_BAR __builtin_amdgcn_s_barrier()
#define PG8_SCHED __builtin_amdgcn_sched_barrier(0)
    Unit cur, nxt; int ui = 0;
    if (!S.next(0, cur)) return;
    f32x4 acc[2][2][4][2];
#pragma unroll
    for (int a = 0; a < 2; ++a)
#pragma unroll
        for (int b = 0; b < 2; ++b)
#pragma unroll
            for (int m = 0; m < 4; ++m)
#pragma unroll
                for (int n = 0; n < 2; ++n) acc[a][b][m][n] = (f32x4){0.f, 0.f, 0.f, 0.f};
    bf16x8 At[4][2], B0[2][2], B1[2][2];
    const char* cA = (const char*)g.A + (size_t)cur.pm * tstep; const char* cB = (const char*)g.Bt + (size_t)cur.pn * tstep;
    S.a_ready(cur);
    if constexpr (SP2) {
        PG8_STAGE(PG8_SB(0, 0), cB, voffB); PG8_STAGE(PG8_SB(0, 1), cB + hstep, voffB); PG8_STAGE(PG8_SA(0, 0), cA, voffA); PG8_STAGE(PG8_SA(0, 1), cA + hstep, voffA);
        if (wr == 1) PG8_BAR;
        PG8_WAIT_V(2); PG8_BAR;
        PG8_STAGE(PG8_SB(1, 0), cB + kstep, voffB); PG8_STAGE(PG8_SA(1, 0), cA + kstep, voffA); PG8_STAGE(PG8_SB(1, 1), cB + hstep + kstep, voffB);
        PG8_WAIT_V(6); PG8_BAR;
    } else {
        PG8_STAGE(PG8_SB(0, 0), cB, voffB); PG8_STAGE(PG8_SA(0, 0), cA, voffA); PG8_STAGE(PG8_SB(0, 1), cB + hstep, voffB); PG8_STAGE(PG8_SA(0, 1), cA + hstep, voffA);
        if (wr == 1) PG8_BAR;
        PG8_WAIT_V(4); PG8_BAR;
        PG8_STAGE(PG8_SB(1, 0), cB + kstep, voffB); PG8_STAGE(PG8_SA(1, 0), cA + kstep, voffA); PG8_STAGE(PG8_SB(1, 1), cB + hstep + kstep, voffB);
        PG8_WAIT_V(6); PG8_BAR;
    }
    for (;;) {
        const bool has_next = S.next(ui + 1, nxt);
        const char* nA = has_next ? (const char*)g.A + (size_t)nxt.pm * tstep : cA; const char* nB = has_next ? (const char*)g.Bt + (size_t)nxt.pn * tstep : cB;
        for (int t = 0; t < nt; t += 2) {
            const bool last = (t == nt - 2);
            const char* a1 = cA + (size_t)(t + 1) * kstep;
            const char* a2 = last ? nA : cA + (size_t)(t + 2) * kstep; const char* b2 = last ? nB : cB + (size_t)(t + 2) * kstep;
            const char* a3 = a2 + kstep; const char* b3 = b2 + kstep;
            if (last && has_next) S.a_ready(nxt);
            if constexpr (SP2) {
            PG8_LDB(B0, 0, 0); PG8_LDB(B1, 0, 1); PG8_SCHED; PG8_LDA(At, 0, 0); PG8_STAGE(PG8_SA(1, 1), a1 + hstep, voffA);
            PG8_WAIT_V(8); PG8_WAIT_L(0); PG8_BAR; PG8_MMA(0, 0, At, B0); PG8_MMA(0, 1, At, B1); PG8_BAR; PG8_SCHED;
            PG8_LDA(At, 0, 1); PG8_STAGE(PG8_SB(0, 0), b2, voffB); PG8_STAGE(PG8_SB(0, 1), b2 + hstep, voffB); PG8_STAGE(PG8_SA(0, 0), a2, voffA);
            PG8_WAIT_V(8); PG8_WAIT_L(0); PG8_BAR; PG8_MMA(1, 0, At, B0); PG8_MMA(1, 1, At, B1); PG8_BAR; PG8_SCHED;
            PG8_LDB(B0, 1, 0); PG8_LDB(B1, 1, 1); PG8_SCHED; PG8_LDA(At, 1, 0); PG8_STAGE(PG8_SA(0, 1), a2 + hstep, voffA);
            PG8_WAIT_V(8); PG8_WAIT_L(0); PG8_BAR; PG8_MMA(0, 0, At, B0); PG8_MMA(0, 1, At, B1); PG8_BAR; PG8_SCHED;
            PG8_LDA(At, 1, 1); PG8_STAGE(PG8_SB(1, 0), b3, voffB); PG8_STAGE(PG8_SB(1, 1), b3 + hstep, voffB); PG8_STAGE(PG8_SA(1, 0), a3, voffA);
            PG8_WAIT_V(8); PG8_WAIT_L(0); PG8_BAR; PG8_MMA(1, 0, At, B0); PG8_MMA(1, 1, At, B1); PG8_BAR; PG8_SCHED;
            } else {
            PG8_LDB(B0, 0, 0); PG8_SCHED; PG8_LDA(At, 0, 0); PG8_STAGE(PG8_SA(1, 1), a1 + hstep, voffA);
            PG8_WAIT_L(8); PG8_BAR; PG8_WAIT_L(0); PG8_MMA(0, 0, At, B0); PG8_BAR; PG8_SCHED;
            PG8_LDB(B1, 0, 1); PG8_STAGE(PG8_SB(0, 0), b2, voffB);
            PG8_BAR; PG8_WAIT_L(0); PG8_MMA(0, 1, At, B1); PG8_BAR;
            PG8_LDA(At, 0, 1); PG8_STAGE(PG8_SA(0, 0), a2, voffA);
            PG8_BAR; PG8_WAIT_L(0); PG8_MMA(1, 0, At, B0); PG8_BAR; PG8_SCHED;
            PG8_STAGE(PG8_SB(0, 1), b2 + hstep, voffB);
            PG8_WAIT_V(6); PG8_BAR; PG8_MMA(1, 1, At, B1); PG8_BAR;
            PG8_LDB(B0, 1, 0); PG8_SCHED; PG8_LDA(At, 1, 0); PG8_STAGE(PG8_SA(0, 1), a2 + hstep, voffA);
            PG8_WAIT_L(8); PG8_BAR; PG8_WAIT_L(0); PG8_MMA(0, 0, At, B0); PG8_BAR; PG8_SCHED;
            PG8_LDB(B1, 1, 1); PG8_STAGE(PG8_SB(1, 0), b3, voffB);
            PG8_BAR; PG8_WAIT_L(0); PG8_MMA(0, 1, At, B1); PG8_BAR;
            PG8_LDA(At, 1, 1); PG8_STAGE(PG8_SA(1, 0), a3, voffA);
            PG8_BAR; PG8_WAIT_L(0); PG8_MMA(1, 0, At, B0); PG8_BAR; PG8_SCHED;
            PG8_STAGE(PG8_SB(1, 1), b3 + hstep, voffB);
            PG8_WAIT_V(6); PG8_BAR; PG8_MMA(1, 1, At, B1); PG8_BAR;
            }
        }
        if constexpr (ALIGN_EPI) { if (wr == 0) PG8_BAR; }
        if constexpr (!Epi::AFTER_DRAIN) { E(acc, cur, wr, wc, fr, fq); S.done(cur); }
        if (!has_next) break;
#pragma unroll
        for (int a = 0; a < 2; ++a)
#pragma unroll
            for (int b = 0; b < 2; ++b)
#pragma unroll
                for (int m = 0; m < 4; ++m)
#pragma unroll
                    for (int n = 0; n < 2; ++n) acc[a][b][m][n] = (f32x4){0.f, 0.f, 0.f, 0.f};
        cur = nxt; cA = nA; cB = nB; ++ui;
        if constexpr (ALIGN_EPI) { if (wr == 1) PG8_BAR; }
    }
    PG8_WAIT_V(0);
    if constexpr (!ALIGN_EPI) { if (wr == 0) PG8_BAR; }
    PG8_BAR;
    if constexpr (Epi::AFTER_DRAIN) { E.fused(acc, cur, wr, wc, fr, fq, lds, wid, lane); S.done(cur); }
#undef PG8_SA
#undef PG8_SB
#undef PG8_STAGE
#undef PG8_LDA
#undef PG8_LDB
#undef PG8_MMA
#undef PG8_WAIT_V
#undef PG8_WAIT_L
#undef PG8_BAR
#undef PG8_SCHED
}
}
#define GAS __attribute__((address_space(1)))
#define LAS __attribute__((address_space(3)))
typedef unsigned short bf16;
typedef unsigned v4u __attribute__((ext_vector_type(4)));
typedef float f32x4 __attribute__((ext_vector_type(4)));
typedef short bf16x8 __attribute__((ext_vector_type(8)));
typedef GAS unsigned gu32;
typedef GAS unsigned long long gu64;
#define RLX_AGENT __ATOMIC_RELAXED, __HIP_MEMORY_SCOPE_AGENT
#define LDS_WAIT() asm volatile("s_waitcnt lgkmcnt(0)" ::: "memory")
#define VM_WAIT() asm volatile("s_waitcnt vmcnt(0)" ::: "memory")
__device__ __forceinline__ unsigned long long rt() { return __builtin_amdgcn_s_memrealtime(); }
__device__ __forceinline__ unsigned f2bf(float f) { unsigned u = __builtin_bit_cast(unsigned, f); return (u + 0x7fffu + ((u >> 16) & 1u)) >> 16; }
__device__ __forceinline__ unsigned pk2(float lo, float hi) { return f2bf(lo) | (f2bf(hi) << 16); }
#define XB_TMO      128
#define XB_XCNT(j)  (256  + 64 * (j))
#define XB_XSUB(j)  (1280 + 64 * (j))
#define XB_XGEN(j)  (2304 + 64 * (j))
#define XB_TOP      3328
#define XB_TOPGEN   3392
#define XCD_BAR_WORDS 3456
#define XB_SPIN_CAP (1u << 18)

__device__ __forceinline__ unsigned xb_ld(unsigned* p)              { return __hip_atomic_load(p, __ATOMIC_RELAXED, __HIP_MEMORY_SCOPE_AGENT); }
__device__ __forceinline__ unsigned xb_add(unsigned* p, unsigned v) { return __hip_atomic_fetch_add(p, v, __ATOMIC_RELAXED, __HIP_MEMORY_SCOPE_AGENT); }
__device__ __forceinline__ unsigned xb_xcc_id() { return (unsigned)__builtin_amdgcn_s_getreg((3 << 11) | 20) & 0xFu; }
#define XB_SPIN(cond, bar) do { unsigned _sp = 0; while (cond) { __builtin_amdgcn_s_sleep(1); \
    if ((++_sp & 255u) == 0u) { if (xb_ld(&(bar)[XB_TMO])) break; if (_sp > XB_SPIN_CAP) { atomicAdd(&(bar)[XB_TMO], 1u); break; } } } } while (0)

struct XcdBarrier {
    unsigned* bar; unsigned x;
    volatile LAS unsigned* st;
};

__device__ __forceinline__ XcdBarrier xcd_barrier_post(unsigned* bar, volatile LAS unsigned* st) {
    XcdBarrier b; b.bar = bar; b.x = xb_xcc_id(); b.st = st;
    if (threadIdx.x == 0) (void)xb_add(&bar[XB_XCNT(b.x)], 1u);
    return b;
}
__device__ __forceinline__ void xcd_barrier_complete(unsigned* bar, unsigned x, unsigned& nloc, unsigned& nx) {
    const unsigned G = gridDim.x * gridDim.y * gridDim.z;
    unsigned sum, cnt, mine, sp = 0u;
    for (;;) {
        sum = 0u; cnt = 0u; mine = 0u;
#pragma unroll
        for (unsigned j = 0; j < 16; ++j) { const unsigned c = xb_ld(&bar[XB_XCNT(j)]); sum += c; cnt += (c > 0u) ? 1u : 0u; mine = (j == x) ? c : mine; }
        if (sum == G) break;
        __builtin_amdgcn_s_sleep(1);
        if ((++sp & 255u) == 0u) { if (xb_ld(&bar[XB_TMO])) break; if (sp > XB_SPIN_CAP) { atomicAdd(&bar[XB_TMO], 1u); break; } }
    }
    nloc = mine > 0u ? mine : 1u; nx = cnt > 0u ? cnt : 1u;
}

__device__ __forceinline__ void xcd_barrier(const XcdBarrier& b) {
    asm volatile("s_waitcnt vmcnt(0)" ::: "memory");
    __syncthreads();
    if (threadIdx.x == 0) {
        unsigned* bar = b.bar;
        __builtin_amdgcn_s_waitcnt(0);
        unsigned nloc = b.st[0], nx = b.st[1];
        if (nloc == 0u) { xcd_barrier_complete(bar, b.x, nloc, nx); b.st[0] = nloc; b.st[1] = nx; }
        const unsigned old = xb_add(&bar[XB_XSUB(b.x)], 1u);
        const unsigned gen = old / nloc;
        if (old + 1u == (gen + 1u) * nloc) {
            __builtin_amdgcn_fence(__ATOMIC_RELEASE, "agent");
            asm volatile("s_waitcnt vmcnt(0)" ::: "memory");
            const unsigned og = xb_add(&bar[XB_TOP], 1u);
            const unsigned tg = og / nx;
            if (og + 1u == (tg + 1u) * nx) xb_add(&bar[XB_TOPGEN], 1u);
            else XB_SPIN(xb_ld(&bar[XB_TOPGEN]) == tg, bar);
            __builtin_amdgcn_fence(__ATOMIC_ACQUIRE, "agent");
            xb_add(&bar[XB_XGEN(b.x)], 1u);
            asm volatile("s_waitcnt vmcnt(0)" ::: "memory");
        } else {
            XB_SPIN(xb_ld(&bar[XB_XGEN(b.x)]) == gen, bar);
            __builtin_amdgcn_fence(__ATOMIC_ACQUIRE, "agent");
            asm volatile("s_waitcnt vmcnt(0)" ::: "memory");
        }
    }
    __syncthreads();
}

constexpr int NWAVES = 8;
constexpr int D = 2048, M = 9216, MP = 8192, TP = 2048, NLAYER = 4;
constexpr int NIN_SRC = 14352, LDP = 14336;
constexpr int PC_U = 0, PC_Z = 1024, PC_Q = 2048, PC_K = 2560, PC_V = 3072, PC_GZ = 4096, PC_CA = 5120, PC_CB = 6144, PC_CZ = 7168, PC_GATE = 8192;
constexpr float LN_EPS = 1e-5f;
constexpr float DN_ALPHA = 1.681792830507429f;
constexpr float QSCALE = 0.08838834764831845f;
constexpr int NPH_LAYER = 10, NPHASE = 1 + NLAYER * NPH_LAYER;

constexpr size_t OUT_Y = 0;
constexpr size_t OUT_S5RE_P = 18874368, OUT_S5IM_P = 18939904, OUT_GLA_P = 19005440, OUT_CONV_P = 21102592;
constexpr size_t OUT_S5RE_S = 21594112, OUT_S5IM_S = 23691264, OUT_GLA_S = 25788416, OUT_CONV_S = 92897280, OUT_TOTAL = 108625920;

constexpr size_t MiB = 1u << 20;
constexpr size_t WS_CTL = 0, CTL_ZERO_BYTES = 1 * MiB;
constexpr size_t WS_WT = 1 * MiB, WT_LAYER = 88 * MiB;
constexpr size_t WO_WIN = 0, WO_WA = WO_WIN + (size_t)LDP * D, WO_WGLU = WO_WA + 16 * D, WO_PS5 = WO_WGLU + 1024 * 1024, WO_PGLA = WO_PS5 + 2048 * 1024, WO_PCONV = WO_PGLA + 2048 * 1024,
                 WO_WO = WO_PCONV + 2048 * 1024, WO_WPG = WO_WO + 2048 * 2048, WO_WPE = WO_WPG + 2048 * 2048, WO_END = WO_WPE + 2048 * 256;
static_assert(WO_END * 2 <= WT_LAYER, "weight block");
constexpr size_t WS_TAB = WS_WT + NLAYER * WT_LAYER, TAB_LAYER = 1 * MiB;
constexpr size_t TB_ABAR = 0, TB_A64 = 32768, TB_BBT = 65536, TB_CMT = 65536 + 262144;
constexpr size_t WS_XB = WS_TAB + NLAYER * TAB_LAYER;
constexpr size_t WS_PB = WS_XB + 36 * MiB;
constexpr size_t WS_P = WS_PB + 18 * MiB;
constexpr size_t WS_ALOW = WS_P + 252 * MiB;
constexpr size_t WS_YG = WS_ALOW + 1 * MiB, WS_AS = WS_YG + 18 * MiB, WS_AG = WS_AS + 18 * MiB, WS_AC = WS_AG + 18 * MiB;
constexpr size_t WS_OSUM = WS_AC + 18 * MiB;
constexpr size_t WS_OG = WS_OSUM, WS_OC = WS_OSUM + 36 * MiB;
constexpr size_t WS_OSB = WS_OSUM + 72 * MiB;
constexpr size_t WS_H32 = WS_OSB + 36 * MiB, WS_HB = WS_H32 + 72 * MiB, WS_PE = WS_HB + 36 * MiB, WS_H2 = WS_PE + 36 * MiB;
constexpr size_t WS_SS = WS_H2 + 72 * MiB;
constexpr size_t WS_KVS = WS_SS + 4 * MiB;
constexpr size_t WS_LSUM = WS_KVS + 32 * MiB;
constexpr size_t WS_ALOWP = WS_LSUM + 1 * MiB;
constexpr size_t WS_END = WS_ALOWP + 4 * MiB;
constexpr int CW_BAR = 4096;

constexpr int RING_BYTES = 131072;
constexpr int LDSCTL_OFF = RING_BYTES, MISC_OFF = LDSCTL_OFF + 320;
constexpr int LDS_BYTES = 147456;

typedef float f32x16 __attribute__((ext_vector_type(16)));
typedef short v4s __attribute__((ext_vector_type(4)));
typedef unsigned v2u __attribute__((ext_vector_type(2)));
__device__ __forceinline__ float bf2f(bf16 b) { return __uint_as_float(((unsigned)b) << 16); }
__device__ __forceinline__ unsigned cvtpk(float lo, float hi) { return pg8::cvt_pk_bf16(lo, hi); }
__device__ __forceinline__ bf16 f2bf16(float f) { return (bf16)f2bf(f); }
__device__ __forceinline__ float gelu_tanh(float x) { const float z = 0.7978845608028654f * (x + 0.044715f * x * x * x); return x * pg8::sigm(2.0f * z); }
__device__ __forceinline__ float log_sigmoid(float x) { return fminf(x, 0.f) - __logf(1.0f + __expf(-fabsf(x))); }
__device__ __forceinline__ bf16x8 zero8() { return (bf16x8){0, 0, 0, 0, 0, 0, 0, 0}; }
__device__ __forceinline__ bf16x8 join8(v4s a, v4s b) { return (bf16x8){a[0], a[1], a[2], a[3], b[0], b[1], b[2], b[3]}; }
__device__ __forceinline__ v4s tr_read(const LAS void* p) { return __builtin_amdgcn_ds_read_tr16_b64_v4i16((LAS v4s*)p); }
#define MFMA16(a, b, c) __builtin_amdgcn_mfma_f32_16x16x32_bf16((a), (b), (c), 0, 0, 0)
#define MFMA32(a, b, c) __builtin_amdgcn_mfma_f32_32x32x16_bf16((a), (b), (c), 0, 0, 0)
#define WAVE_LDS_FENCE() asm volatile("s_waitcnt lgkmcnt(0)" ::: "memory")
__device__ __forceinline__ f32x4 mfma16k(bf16x8 a, bf16x8 b, f32x4 c) { f32x4 d = MFMA16(a, b, c); asm volatile("" : "+v"(d) : "v"(a), "v"(b)); return d; }
__device__ __forceinline__ f32x16 mfma32k(bf16x8 a, bf16x8 b, f32x16 c) { f32x16 d = MFMA32(a, b, c); asm volatile("" : "+v"(d) : "v"(a), "v"(b)); return d; }
#define PIN16(d) asm volatile("s_nop 7" : "+v"(d))
#define PIN32(d) asm volatile("s_nop 7\n\ts_nop 3" : "+v"(d))

struct Frame {
    LAS unsigned char* lds;
    gu32* ctl;
    int tid, lane, wave, vcu, G;
    float* out; unsigned char* ws;
};
constexpr int PTAB_OFF = LDSCTL_OFF + 1024;
__device__ __forceinline__ const float* inp(const Frame& F, int k) {
    const unsigned long long v = ((const LAS unsigned long long*)(F.lds + PTAB_OFF))[k];
    const unsigned lo = __builtin_amdgcn_readfirstlane((unsigned)v), hi = __builtin_amdgcn_readfirstlane((unsigned)(v >> 32));
    return (const float*)(((unsigned long long)hi << 32) | (unsigned long long)lo);
}
__device__ __forceinline__ float wave_sum(float v) {
#pragma unroll
    for (int o = 1; o < 64; o <<= 1) v += __shfl_xor(v, o);
    return v;
}

struct P0Item { const float* W; bf16* WT; int ldw, src_n0, k0, K, dst_n0; };
__device__ __forceinline__ void p0_item_load(const P0Item& it, int lane, float (&v)[32]) {
#pragma unroll
    for (int i = 0; i < 32; ++i) { const int kk = 2 * i + (lane >> 5); v[i] = it.W[(size_t)(it.k0 + kk) * it.ldw + it.src_n0 + (lane & 31)]; }
}
__device__ __forceinline__ void p0_item_store(const P0Item& it, int lane, const float (&v)[32], LAS float* scr) {
#pragma unroll
    for (int i = 0; i < 32; ++i) { const int kk = 2 * i + (lane >> 5); scr[kk * 33 + (lane & 31)] = v[i]; }
    LDS_WAIT(); asm volatile("" ::: "memory");
    const int c = lane & 7;
#pragma unroll
    for (int j = 0; j < 4; ++j) { const int n = (lane >> 3) + 8 * j; const LAS float* s = scr + (8 * c) * 33 + n;
        v4u o; o.x = pk2(s[0 * 33], s[1 * 33]); o.y = pk2(s[2 * 33], s[3 * 33]); o.z = pk2(s[4 * 33], s[5 * 33]); o.w = pk2(s[6 * 33], s[7 * 33]);
        *(GAS v4u*)(it.WT + (size_t)(it.dst_n0 + n) * it.K + it.k0 + 8 * c) = o; }
    LDS_WAIT(); asm volatile("" ::: "memory");
}
constexpr int P0_I_IN = (D / 64) * (LDP / 32), P0_I_GLU = 16 * 32, P0_I_P = 16 * 64, P0_I_O = 32 * 64, P0_I_PE = 4 * 64;
constexpr int P0_I_LAYER = P0_I_IN + P0_I_GLU + 3 * P0_I_P + 2 * P0_I_O + P0_I_PE;
__device__ __forceinline__ P0Item p0_decode(Frame& F, int l, int r) {
    bf16* wt = (bf16*)(F.ws + WS_WT + (size_t)l * WT_LAYER);
    P0Item it; int K, N; const float* W; bf16* WT; int soff = 0;
    if (r < P0_I_IN) { K = D; N = LDP; W = inp(F, 8) + (size_t)l * D * NIN_SRC; WT = wt + WO_WIN; }
    else if ((r -= P0_I_IN) < P0_I_GLU) { K = 1024; N = 1024; W = inp(F, 18) + (size_t)l * 1024 * 1024; WT = wt + WO_WGLU; }
    else if ((r -= P0_I_GLU) < P0_I_P) { K = 1024; N = 2048; W = inp(F, 27) + (size_t)l * 1024 * 2048; WT = wt + WO_PS5; }
    else if ((r -= P0_I_P) < P0_I_P) { K = 1024; N = 2048; W = inp(F, 28) + (size_t)l * 1024 * 2048; WT = wt + WO_PGLA; }
    else if ((r -= P0_I_P) < P0_I_P) { K = 1024; N = 2048; W = inp(F, 29) + (size_t)l * 1024 * 2048; WT = wt + WO_PCONV; }
    else if ((r -= P0_I_P) < P0_I_O) { K = 2048; N = 2048; W = inp(F, 30) + (size_t)l * 2048 * 2048; WT = wt + WO_WO; }
    else if ((r -= P0_I_O) < P0_I_O) { K = 2048; N = 2048; W = inp(F, 31) + (size_t)l * 2048 * 2048; WT = wt + WO_WPG; }
    else { r -= P0_I_O; K = 256; N = 2048; W = inp(F, 32) + (size_t)l * 256 * 2048; WT = wt + WO_WPE; }
    const int nblk = N / 32, kb = r / nblk, nb = r % nblk; const int dn0 = 32 * nb;
    if (N == LDP) soff = (dn0 >= 4096) ? 16 : 0;
    it.W = W; it.WT = WT; it.ldw = (N == LDP) ? NIN_SRC : N; it.src_n0 = dn0 + soff; it.k0 = 64 * kb; it.K = K; it.dst_n0 = dn0;
    return it;
}
__device__ __forceinline__ void p0_convert(Frame& F, int l, int lo, int hi, int w0, int nw) {
    LAS float* scr = (LAS float*)(F.lds + F.wave * 16384);
    int it = lo + w0; if (it >= hi) return;
    P0Item cur = p0_decode(F, l, it); float v[32]; p0_item_load(cur, F.lane, v);
    P0Item n1 = cur; float v1[32]; bool has1 = (it + nw) < hi;
    if (has1) { n1 = p0_decode(F, l, it + nw); p0_item_load(n1, F.lane, v1); }
    for (;;) {
        const int i2 = it + 2 * nw; const bool has2 = has1 && (i2 < hi);
        P0Item n2 = n1; float v2[32];
        if (has2) { n2 = p0_decode(F, l, i2); p0_item_load(n2, F.lane, v2); }
        p0_item_store(cur, F.lane, v, scr);
        if (!has1) break;
#pragma unroll
        for (int i = 0; i < 32; ++i) { v[i] = v1[i]; v1[i] = v2[i]; }
        cur = n1; n1 = n2; has1 = has2; it += nw;
    }
}
__device__ __forceinline__ void p0_prologue(Frame& F) {
    const float* w_in = inp(F, 8);
    p0_convert(F, 0, 0, P0_I_LAYER, F.vcu * NWAVES + F.wave, F.G * NWAVES);
    const size_t gt = (size_t)F.vcu * (NWAVES * 64) + F.tid, NGT = (size_t)F.G * NWAVES * 64;
    for (size_t i = gt; i < (size_t)NLAYER * 16 * D; i += NGT) { const int l = (int)(i / (16 * D)), j = (int)((i / D) % 16), k = (int)(i % D);
        ((bf16*)(F.ws + WS_WT + (size_t)l * WT_LAYER))[WO_WA + (size_t)j * D + k] = f2bf16(w_in[((size_t)l * D + k) * NIN_SRC + 4096 + j]); }
    { const float* xp = inp(F, 0); const float* xs = inp(F, 1); bf16* XB = (bf16*)(F.ws + WS_XB); constexpr int UB = 6; const size_t tot = (size_t)M * D / 8;
      for (size_t i0 = gt; i0 < tot; i0 += UB * NGT) { f32x4 a[UB], b[UB];
#pragma unroll
          for (int u = 0; u < UB; ++u) { const size_t i = i0 + u * NGT; const size_t e = (i < tot ? i : gt) * 8; const float* src = (e < (size_t)MP * D) ? xp + e : xs + (e - (size_t)MP * D); a[u] = *(const f32x4*)src; b[u] = *(const f32x4*)(src + 4); }
#pragma unroll
          for (int u = 0; u < UB; ++u) { const size_t i = i0 + u * NGT; if (i < tot) { v4u o; o.x = pk2(a[u][0], a[u][1]); o.y = pk2(a[u][2], a[u][3]); o.z = pk2(b[u][0], b[u][1]); o.w = pk2(b[u][2], b[u][3]); *(v4u*)(XB + i * 8) = o; } } } }
    { const float* pp = inp(F, 2); const float* ps = inp(F, 3); bf16* PB = (bf16*)(F.ws + WS_PB); constexpr int UB = 3; const size_t tot = (size_t)NLAYER * M * 256 / 8;
      for (size_t i0 = gt; i0 < tot; i0 += UB * NGT) { f32x4 a[UB], b[UB];
#pragma unroll
          for (int u = 0; u < UB; ++u) { const size_t i = i0 + u * NGT; const size_t e = (i < tot ? i : gt) * 8; const int l = (int)(e / ((size_t)M * 256)); const size_t r = e % ((size_t)M * 256);
              const float* src = (r < (size_t)MP * 256) ? pp + (size_t)l * MP * 256 + r : ps + (size_t)l * 1024 * 256 + (r - (size_t)MP * 256); a[u] = *(const f32x4*)src; b[u] = *(const f32x4*)(src + 4); }
#pragma unroll
          for (int u = 0; u < UB; ++u) { const size_t i = i0 + u * NGT; if (i < tot) { v4u o; o.x = pk2(a[u][0], a[u][1]); o.y = pk2(a[u][2], a[u][3]); o.z = pk2(b[u][0], b[u][1]); o.w = pk2(b[u][2], b[u][3]); *(v4u*)(PB + i * 8) = o; } } } }
    { const float* a_re = inp(F, 10); const float* a_im = inp(F, 11); const float* log_dt = inp(F, 12); const float* b_re = inp(F, 13); const float* b_im = inp(F, 14); const float* c_re = inp(F, 15); const float* c_im = inp(F, 16);
      for (size_t i2 = gt; i2 < (size_t)NLAYER * 64 * 64 * 16; i2 += NGT) { const size_t i = i2 >> 4; const int c = (int)(i2 & 15); const int l = (int)(i >> 12), g = (int)((i >> 6) & 63), p = (int)(i & 63);
          unsigned char* tb = F.ws + WS_TAB + (size_t)l * TAB_LAYER;
          const float lr = a_re[i], li = a_im[i], dt = expf(log_dt[l * 64 + g]);
          const float er = expf(lr * dt); float sn, cs; sincosf(li * dt, &sn, &cs); const float ar = er * cs, ai = er * sn;
          if (c == 0) { ((float*)(tb + TB_ABAR))[2 * (g * 64 + p)] = ar; ((float*)(tb + TB_ABAR))[2 * (g * 64 + p) + 1] = ai;
              const float e64 = expf(64.f * lr * dt); float s64, c64; sincosf(64.f * li * dt, &s64, &c64);
              ((float*)(tb + TB_A64))[2 * (g * 64 + p)] = e64 * c64; ((float*)(tb + TB_A64))[2 * (g * 64 + p) + 1] = e64 * s64; }
          const float nr = ar - 1.f, ni = ai, den = lr * lr + li * li; const float fr = (nr * lr + ni * li) / den, fi = (ni * lr - nr * li) / den;
          bf16* BBT = (bf16*)(tb + TB_BBT);
          const float br = b_re[i * 16 + c], bi = b_im[i * 16 + c];
          BBT[((size_t)g * 128 + p) * 16 + c] = f2bf16(fr * br - fi * bi); BBT[((size_t)g * 128 + 64 + p) * 16 + c] = f2bf16(fr * bi + fi * br); }
      for (size_t i = gt; i < (size_t)NLAYER * 64 * 16 * 128; i += NGT) { const int l = (int)(i / (64 * 16 * 128)); const int r = (int)(i % (64 * 16 * 128)); const int g = r / (16 * 128), ch = (r / 128) % 16, k = r % 128;
          bf16* CMT = (bf16*)(F.ws + WS_TAB + (size_t)l * TAB_LAYER + TB_CMT);
          const size_t ci = (((size_t)l * 64 + g) * 16 + ch) * 64 + (k & 63);
          CMT[r] = f2bf16(k < 64 ? c_re[ci] : -c_im[ci]); } }
}

__device__ __forceinline__ void alow_phase(Frame& F, int l) {
    const bf16* XB = (const bf16*)(F.ws + WS_XB); const bf16* WA = (const bf16*)(F.ws + WS_WT + (size_t)l * WT_LAYER) + WO_WA;
    const float* b_in = inp(F, 9) + (size_t)l * NIN_SRC;
    float* ALOWP = (float*)(F.ws + WS_ALOWP);
    const int c16 = F.lane & 15, q4 = F.lane >> 4;
    for (int su = F.vcu * NWAVES + F.wave; su < 4 * (M / 16); su += F.G * NWAVES) {
        const int un = su % (M / 16), kq = su / (M / 16);
        const bf16* ap = XB + (size_t)(16 * un + c16) * D + 512 * kq + 8 * q4; const bf16* bp = WA + (size_t)c16 * D + 512 * kq + 8 * q4;
        f32x4 acc = (f32x4){0.f, 0.f, 0.f, 0.f};
#pragma unroll
        for (int ks = 0; ks < 16; ++ks) acc = mfma16k(*(const bf16x8*)(ap + 32 * ks), *(const bf16x8*)(bp + 32 * ks), acc);
        PIN16(acc);
        const float bb = (kq == 0) ? b_in[4096 + c16] : 0.f;
#pragma unroll
        for (int r = 0; r < 4; ++r) ALOWP[((size_t)kq * M + 16 * un + 4 * q4 + r) * 16 + c16] = acc[r] + bb;
    }
}

template <int MODE>
__device__ __forceinline__ void s5_unit(LAS float* T, int lane, const bf16* P, size_t row0, int g, const float* abar, const bf16* BBT, const bf16* CMT, const float* dsk,
                                        float* ss, const float* h0re, const float* h0im, float* outre, float* outim, bf16* YG) {
    asm volatile("" : "+v"(lane));
    const int c16 = lane & 15, q4 = lane >> 4;
    bf16x8 bfr[8];
#pragma unroll
    for (int nb = 0; nb < 8; ++nb) bfr[nb] = (lane < 32) ? *(const bf16x8*)(BBT + ((size_t)g * 128 + 16 * nb + c16) * 16 + 8 * q4) : zero8();
    bf16x8 cfr[4];
    if (MODE >= 1) {
#pragma unroll
        for (int ks = 0; ks < 4; ++ks) cfr[ks] = *(const bf16x8*)(CMT + ((size_t)g * 16 + c16) * 128 + 32 * ks + 8 * q4);
    }
    const float ar = abar[2 * (g * 64 + lane)], ai = abar[2 * (g * 64 + lane) + 1];
    float hr = 0.f, hi = 0.f;
    if (MODE == 1) { hr = ss[lane]; hi = ss[64 + lane]; }
    float h0r[8], h0i[8];
    if (MODE == 2) {
#pragma unroll
        for (int b8 = 0; b8 < 8; ++b8) { h0r[b8] = h0re[(size_t)b8 * 4096 + lane]; h0i[b8] = h0im[(size_t)b8 * 4096 + lane]; } }
    bf16x8 dfr = zero8();
    if (MODE >= 1) { const unsigned short db = f2bf16(dsk[16 * g + c16]);
#pragma unroll
        for (int j = 0; j < 8; ++j) dfr[j] = (lane < 32 && 8 * q4 + j == c16) ? (short)db : (short)0; }
    bf16x8 afn = (lane < 32) ? *(const bf16x8*)(P + (row0 + c16) * LDP + PC_U + 16 * g + 8 * (q4 & 1)) : zero8();
    for (int tb = 0; tb < 4; ++tb) {
        const bf16x8 af = afn;
        { const int tn = tb < 3 ? tb + 1 : 3;
          afn = (lane < 32) ? *(const bf16x8*)(P + (row0 + 16 * tn + c16) * LDP + PC_U + 16 * g + 8 * (q4 & 1)) : zero8(); }
        f32x4 dd[8];
#pragma unroll
        for (int nb = 0; nb < 8; ++nb) dd[nb] = mfma16k(af, bfr[nb], ((f32x4){0.f, 0.f, 0.f, 0.f}));
        asm volatile("s_nop 7\n\ts_nop 7" : "+v"(dd[0]), "+v"(dd[1]), "+v"(dd[2]), "+v"(dd[3]), "+v"(dd[4]), "+v"(dd[5]), "+v"(dd[6]), "+v"(dd[7]) : "v"(af));
#pragma unroll
        for (int nb = 0; nb < 8; ++nb) *(LAS f32x4*)(T + (16 * nb + c16) * 20 + 4 * q4) = dd[nb];
        WAVE_LDS_FENCE();
#pragma unroll
        for (int i = 0; i < 4; ++i) {
            const int bs = 2 * tb + (i >> 1);
            if (MODE == 2 && (i & 1) == 0) { hr = h0r[bs]; hi = h0i[bs]; }
            const f32x4 re = *(LAS f32x4*)(T + lane * 20 + 4 * i), im = *(LAS f32x4*)(T + (64 + lane) * 20 + 4 * i);
            float r[4], mm[4];
#pragma unroll
            for (int k = 0; k < 4; ++k) { const float nr = __builtin_fmaf(ar, hr, __builtin_fmaf(-ai, hi, re[k])), ni = __builtin_fmaf(ar, hi, __builtin_fmaf(ai, hr, im[k])); hr = nr; hi = ni; r[k] = nr; mm[k] = ni; }
            if (MODE >= 1) { *(LAS v2u*)(T + lane * 20 + 4 * i) = (v2u){cvtpk(r[0], r[1]), cvtpk(r[2], r[3])}; *(LAS v2u*)(T + (64 + lane) * 20 + 4 * i) = (v2u){cvtpk(mm[0], mm[1]), cvtpk(mm[2], mm[3])}; }
            if (MODE == 2 && (i & 1) == 1) { outre[(size_t)bs * 4096 + lane] = hr * DIAG_SGN(DIAG_S5S, lane ^ bs ^ g); outim[(size_t)bs * 4096 + lane] = hi * DIAG_SGN(DIAG_S5S, lane ^ bs ^ g); }
        }
        if (MODE >= 1) {
            WAVE_LDS_FENCE();
            f32x4 y = (f32x4){0.f, 0.f, 0.f, 0.f};
#pragma unroll
            for (int ks = 0; ks < 4; ++ks) {
                const LAS float* a0 = T + (32 * ks + 8 * q4 + (c16 >> 2)) * 20 + 4 * (c16 & 3);
                const v4s lo = tr_read(a0), hh = tr_read(a0 + 4 * 20);
                y = mfma16k(join8(lo, hh), cfr[ks], y);
            }
            y = mfma16k(af, dfr, y);
            PIN16(y);
#pragma unroll
            for (int r = 0; r < 4; ++r) { const size_t grow = row0 + 16 * tb + 4 * q4 + r; YG[grow * 1024 + 16 * g + c16] = f2bf16(gelu_tanh(y[r])); }
            WAVE_LDS_FENCE();
        }
    }
    if (MODE == 0) { ss[lane] = hr; ss[64 + lane] = hi; }
    if (MODE == 1 && outre) { outre[lane] = hr * DIAG_SGN(DIAG_S5P, lane ^ g); outim[lane] = hi * DIAG_SGN(DIAG_S5P, lane ^ g); }
}
#if defined(DIAG_CHECK)
__device__ __forceinline__ unsigned dhash(unsigned x) { x ^= x >> 16; x *= 0x7feb352dU; x ^= x >> 15; x *= 0x846ca68bU; x ^= x >> 16; return x; }
__device__ __forceinline__ void diag_gemm1(Frame& F) {
    const float* xp = inp(F, 0); const float* xs = inp(F, 1); const float* w_in = inp(F, 8); const float* b_in = inp(F, 9);
    const bf16* P = (const bf16*)(F.ws + WS_P);
    const unsigned gt = (unsigned)F.vcu * 512u + (unsigned)F.tid;
    const unsigned h1 = dhash(gt * 2u + 1u), h2 = dhash(gt * 2u + 0x9e3779b9u);
    const int row = (int)(h1 % (unsigned)M), col = (int)(h2 % (unsigned)LDP);
    const int sc = col + (col >= 4096 ? 16 : 0);
    const float* xr = row < MP ? xp + (size_t)row * D : xs + (size_t)(row - MP) * D;
    float acc = 0.f;
    for (int k = 0; k < D; ++k) acc += xr[k] * w_in[(size_t)k * NIN_SRC + sc];
    acc += b_in[sc];
    const int pn = col >> 8; int act = 0;
    if ((pn >= 4 && pn < 8) || (pn >= 16 && pn < 20) || (pn >= 28 && pn < 32)) act = 1;
    if ((pn >= 24 && pn < 28) || pn >= 32) act = 2;
    float ref = acc; if (act == 1) ref = acc / (1.f + expf(-acc)); if (act == 2) ref = 1.f / (1.f + expf(-acc));
    const float got = bf2f(P[(size_t)row * LDP + col]);
    if (!(fabsf(got - ref) <= 0.03f + 0.03f * fabsf(ref))) atomicAdd((unsigned*)(F.ctl + 16), 1u);
}
__device__ __forceinline__ void diag_s5s(Frame& F, int l) {
    const bf16* P = (const bf16*)(F.ws + WS_P); unsigned char* tb = F.ws + WS_TAB + (size_t)l * TAB_LAYER;
    const float* abar = (const float*)(tb + TB_ABAR); const bf16* BBT = (const bf16*)(tb + TB_BBT);
    const int gw = F.vcu * NWAVES + F.wave, NGW = F.G * NWAVES, lane = F.lane;
    for (int wu = gw; wu < 16 * 64; wu += NGW) { const int g = wu & 63, bg = wu >> 6; const size_t so = (((size_t)l * 128 + 8 * bg) * 64 + g) * 64;
        const float ar = abar[2 * (g * 64 + lane)], ai = abar[2 * (g * 64 + lane) + 1];
        float br[16], bi[16];
#pragma unroll
        for (int c = 0; c < 16; ++c) { br[c] = bf2f(BBT[((size_t)g * 128 + lane) * 16 + c]); bi[c] = bf2f(BBT[((size_t)g * 128 + 64 + lane) * 16 + c]); }
        for (int bs = 0; bs < 8; ++bs) { float hr = inp(F, 4)[so + (size_t)bs * 4096 + lane], hi = inp(F, 5)[so + (size_t)bs * 4096 + lane];
            for (int t = 0; t < 8; ++t) { const bf16* ur = P + ((size_t)MP + 64 * bg + 8 * bs + t) * LDP + PC_U + 16 * g; float sr = 0.f, si = 0.f;
#pragma unroll
                for (int c = 0; c < 16; ++c) { const float uu = bf2f(ur[c]); sr += br[c] * uu; si += bi[c] * uu; }
                const float nr = ar * hr - ai * hi + sr, ni = ar * hi + ai * hr + si; hr = nr; hi = ni; }
            const float gr = F.out[OUT_S5RE_S + so + (size_t)bs * 4096 + lane], gi = F.out[OUT_S5IM_S + so + (size_t)bs * 4096 + lane];
            if (!(fabsf(gr - hr) <= 1e-4f + 2e-3f * fabsf(hr)) || !(fabsf(gi - hi) <= 1e-4f + 2e-3f * fabsf(hi))) atomicAdd((unsigned*)(F.ctl + 17), 1u); } }
}
__device__ __forceinline__ float diag_scale(Frame& F) {
    const unsigned c1 = __hip_atomic_load((unsigned*)(F.ctl + 16), __ATOMIC_RELAXED, __HIP_MEMORY_SCOPE_AGENT), c2 = __hip_atomic_load((unsigned*)(F.ctl + 17), __ATOMIC_RELAXED, __HIP_MEMORY_SCOPE_AGENT);
    if (c2 > 0u) return 2.0f;
    int n = 0; if (c1 >= 1u) n = 1; if (c1 >= 4u) n = 2; if (c1 >= 16u) n = 3; if (c1 >= 64u) n = 4; if (c1 >= 256u) n = 5;
    return 1.0f + 0.1f * (float)n;
}
#endif

constexpr int GL_QD = 0, GL_KD = 17408, GL_KDT = 34816, GL_ATT = 53248, GL_V = 62464, GL_AL = 96256, GL_GS = 100352, GL_LAM = 102400, GL_END = 102912;
constexpr int GL_O = 0;
__device__ __forceinline__ int gla_pos(int dk) { const int x = dk & 15; return (dk & ~15) | (x & 3) | ((x & 4) << 1) | ((x & 8) >> 1); }

template <bool FINISH, int NV>
__device__ __forceinline__ float gla_chunk(Frame& F, f32x16 (&S)[4], const bf16* P, const float* ALOW, bf16* AG, size_t row0, int h, const float (&w2)[16], float ba, const float* norm_g) {
    LAS unsigned char* L = F.lds;
    int tid_l = threadIdx.x; asm volatile("" : "+v"(tid_l));
    const int tid = tid_l, lane = tid & 63, w = F.wave, l31 = lane & 31, hh = lane >> 5;
    const int dk = tid & 127, tg = tid >> 7;
    constexpr int NS_O = (NV == 64) ? 4 : 2, NS_U = (NV == 64) ? 4 : 1, NCB = (NV == 64) ? 2 : 1;
    const bool live = (NV == 64) || (tg == 0);
    unsigned qu[16], ku[16];
#pragma unroll
    for (int i = 0; i < 16; ++i) { const int t = 16 * tg + i, tc = (t < NV) ? t : 0;
        qu[i] = (unsigned)P[(row0 + tc) * LDP + PC_Q + h * 128 + dk]; ku[i] = (unsigned)P[(row0 + tc) * LDP + PC_K + h * 128 + dk]; }
    v4u gzv[4];
    if (FINISH) { const int row = tid >> 3, seg = tid & 7, rc = (row < NV) ? row : 0;
#pragma unroll
        for (int j = 0; j < 4; ++j) gzv[j] = *(const v4u*)(P + (row0 + rc) * LDP + PC_GZ + h * 256 + 32 * seg + 8 * j); }
    if (tid < 256) { const int r = tid >> 2, c4 = tid & 3; f32x4 a = (f32x4){0.f, 0.f, 0.f, 0.f}; if (r < NV) { const float* ar_ = ALOW + (row0 + r) * 16 + 4 * c4; a = (*(const f32x4*)ar_ + *(const f32x4*)(ar_ + (size_t)M * 16)) + (*(const f32x4*)(ar_ + (size_t)2 * M * 16) + *(const f32x4*)(ar_ + (size_t)3 * M * 16)); } *(LAS f32x4*)(L + GL_AL + (r * 16 + 4 * c4) * 4) = a; }
#pragma unroll
    for (int i = 0; i < 4; ++i) { const int idx = tid + 512 * i, r = idx >> 5, ch = idx & 31; v4u v = (v4u){0u, 0u, 0u, 0u}; if (r < NV) v = *(const v4u*)(P + (row0 + r) * LDP + PC_V + h * 256 + 8 * ch); *(LAS v4u*)(L + GL_V + r * 528 + ch * 16) = v; }
    __syncthreads();
    float lc[16]; float run = 0.f;
#pragma unroll
    for (int i = 0; i < 16; ++i) lc[i] = 0.f;
    if (live) {
#pragma unroll
    for (int i = 0; i < 16; ++i) { const int t = 16 * tg + i; const LAS f32x4* al = (const LAS f32x4*)(L + GL_AL + t * 64); float lg = ba;
#pragma unroll
        for (int q = 0; q < 4; ++q) { const f32x4 a = al[q]; lg += a[0] * w2[4 * q] + a[1] * w2[4 * q + 1] + a[2] * w2[4 * q + 2] + a[3] * w2[4 * q + 3]; }
        const float la = (t < NV) ? log_sigmoid(lg) * (1.0f / 16.0f) : 0.f; run += la; lc[i] = run; if ((i & 3) == 3) asm volatile("" ::: "memory"); }
    }
    ((LAS float*)(L + GL_GS))[tg * 128 + dk] = run;
    __syncthreads();
    float off = 0.f, last = 0.f;
#pragma unroll
    for (int q = 0; q < 4; ++q) { const float gsv = ((LAS float*)(L + GL_GS))[q * 128 + dk]; if (q < tg) off += gsv; last += gsv; }
    if (tg == 0) ((LAS float*)(L + GL_LAM))[dk] = __expf(last);
    {
        const int pos = gla_pos(dk); unsigned kd2[8];
        if (!live) {
#pragma unroll
            for (int i = 0; i < 16; ++i) { const int t = 16 * tg + i; if (FINISH && t < 32) { ((LAS bf16*)(L + GL_QD))[t * 136 + pos] = 0; ((LAS bf16*)(L + GL_KD))[t * 136 + pos] = 0; } }
        } else {
#pragma unroll
        for (int i = 0; i < 16; i += 2) { float kdec[2];
#pragma unroll
            for (int j = 0; j < 2; ++j) { const int t = 16 * tg + i + j; const float cum = off + lc[i + j]; float qv = 0.f, kv = 0.f;
                { const float ql = __uint_as_float(qu[i + j] << 16), kl = __uint_as_float(ku[i + j] << 16); qv = (t < NV) ? ql : 0.f; kv = (t < NV) ? kl : 0.f; }
                if (FINISH) { ((LAS bf16*)(L + GL_QD))[t * 136 + pos] = f2bf16(qv * QSCALE * __expf(cum)); ((LAS bf16*)(L + GL_KD))[t * 136 + pos] = f2bf16(kv * __expf(-cum)); }
                kdec[j] = kv * __expf(last - cum); }
            kd2[i >> 1] = cvtpk(kdec[0], kdec[1]); if ((i & 6) == 6) asm volatile("" ::: "memory"); }
        *(LAS v4u*)(L + GL_KDT + dk * 144 + tg * 32) = (v4u){kd2[0], kd2[1], kd2[2], kd2[3]};
        *(LAS v4u*)(L + GL_KDT + dk * 144 + tg * 32 + 16) = (v4u){kd2[4], kd2[5], kd2[6], kd2[7]};
        }
    }
    __syncthreads();
    if (FINISH) {
        if (w < (NV == 64 ? 4 : 1)) { const int cb = w >> 1, jb = w & 1; f32x16 a = {0.f, 0.f, 0.f, 0.f, 0.f, 0.f, 0.f, 0.f, 0.f, 0.f, 0.f, 0.f, 0.f, 0.f, 0.f, 0.f};
#pragma unroll
            for (int s = 0; s < 8; ++s) { const bf16x8 af = *(const LAS bf16x8*)(L + GL_QD + (32 * cb + l31) * 272 + (16 * s + 8 * hh) * 2), bf = *(const LAS bf16x8*)(L + GL_KD + (32 * jb + l31) * 272 + (16 * s + 8 * hh) * 2); a = mfma32k(af, bf, a); }
            PIN32(a);
#pragma unroll
            for (int r = 0; r < 16; ++r) { const int c = 32 * cb + (r & 3) + 8 * (r >> 2) + 4 * hh, j = 32 * jb + l31; ((LAS bf16*)(L + GL_ATT))[c * 72 + j] = f2bf16(j <= c ? a[r] : 0.f); } }
        __syncthreads();
    }
    bf16x8 vf[4];
    { const int q = (lane & 15) >> 2, p4 = lane & 3, blk = (lane >> 4) & 1;
#pragma unroll
      for (int s = 0; s < NS_O; ++s) { const LAS unsigned char* a0 = L + GL_V + (16 * s + 8 * hh + q) * 528 + (32 * w + 16 * blk + 4 * p4) * 2; vf[s] = join8(tr_read(a0), tr_read(a0 + 4 * 528)); } }
    f32x16 o[2];
    if (FINISH) {
#pragma unroll
        for (int cb = 0; cb < NCB; ++cb) { f32x16 a = {0.f, 0.f, 0.f, 0.f, 0.f, 0.f, 0.f, 0.f, 0.f, 0.f, 0.f, 0.f, 0.f, 0.f, 0.f, 0.f};
#pragma unroll
            for (int s = 0; s < NS_O; ++s) a = mfma32k(*(const LAS bf16x8*)(L + GL_ATT + (32 * cb + l31) * 144 + (16 * s + 8 * hh) * 2), vf[s], a);
#pragma unroll
            for (int kb = 0; kb < 4; ++kb)
#pragma unroll
                for (int sp = 0; sp < 2; ++sp) { bf16x8 sf; { unsigned u0 = cvtpk(S[kb][8 * sp + 0], S[kb][8 * sp + 1]), u1 = cvtpk(S[kb][8 * sp + 2], S[kb][8 * sp + 3]), u2 = cvtpk(S[kb][8 * sp + 4], S[kb][8 * sp + 5]), u3 = cvtpk(S[kb][8 * sp + 6], S[kb][8 * sp + 7]);
                        v4u pk = (v4u){u0, u1, u2, u3}; sf = __builtin_bit_cast(bf16x8, pk); }
                    a = mfma32k(*(const LAS bf16x8*)(L + GL_QD + (32 * cb + l31) * 272 + (32 * kb + 16 * sp + 8 * hh) * 2), sf, a); }
            PIN32(a); o[cb] = a; }
    }
#pragma unroll
    for (int kb = 0; kb < 4; ++kb) {
#pragma unroll
        for (int q = 0; q < 4; ++q) { const f32x4 lm = *(const LAS f32x4*)(L + GL_LAM + (32 * kb + 8 * q + 4 * hh) * 4);
#pragma unroll
            for (int j = 0; j < 4; ++j) S[kb][4 * q + j] *= lm[j]; }
#pragma unroll
        for (int s = 0; s < NS_U; ++s) S[kb] = mfma32k(*(const LAS bf16x8*)(L + GL_KDT + (32 * kb + l31) * 144 + (16 * s + 8 * hh) * 2), vf[s], S[kb]);
        PIN32(S[kb]);
    }
    __syncthreads();
    if (FINISH) {
#pragma unroll
        for (int cb = 0; cb < NCB; ++cb)
#pragma unroll
            for (int r = 0; r < 16; ++r) { const int c = 32 * cb + (r & 3) + 8 * (r >> 2) + 4 * hh; ((LAS float*)(L + GL_O))[c * 260 + 32 * w + l31] = o[cb][r]; }
        __syncthreads();
        const int row = tid >> 3, seg = tid & 7;
        f32x4 x[8]; float s = 0.f;
#pragma unroll
        for (int j = 0; j < 8; ++j) { x[j] = *(const LAS f32x4*)(L + GL_O + (row * 260 + 32 * seg + 4 * j) * 4); s += (x[j][0] + x[j][1]) + (x[j][2] + x[j][3]); }
        s += __shfl_xor(s, 1); s += __shfl_xor(s, 2); s += __shfl_xor(s, 4);
        const float mean = s * (1.0f / 256.0f); float qq = 0.f;
#pragma unroll
        for (int j = 0; j < 8; ++j) { x[j] = x[j] - mean; qq += (x[j][0] * x[j][0] + x[j][1] * x[j][1]) + (x[j][2] * x[j][2] + x[j][3] * x[j][3]); }
        qq += __shfl_xor(qq, 1); qq += __shfl_xor(qq, 2); qq += __shfl_xor(qq, 4);
        const float rstd = 1.0f / sqrtf(qq * (1.0f / 256.0f) + LN_EPS);
        if (row < NV) {
            const size_t grow = row0 + row; const int cbase = h * 256 + 32 * seg;
#pragma unroll
            for (int j = 0; j < 8; j += 2) { f32x4 z0, z1; pg8::unpack8(gzv[j >> 1], z0, z1);
                const f32x4 g0 = *(const f32x4*)(norm_g + cbase + 4 * j), g1 = *(const f32x4*)(norm_g + cbase + 4 * j + 4);
                const f32x4 y0 = x[j] * rstd * g0 * z0, y1 = x[j + 1] * rstd * g1 * z1;
                *(v4u*)(AG + grow * 1024 + cbase + 4 * j) = pg8::pack8(y0, y1); }
        }
        __syncthreads();
    }
    return last;
}
__device__ __forceinline__ void gla_state_load(Frame& F, f32x16 (&S)[4], const float* src) {
    int ln_l = threadIdx.x & 63; asm volatile("" : "+v"(ln_l));
    const int l31 = ln_l & 31, hh = ln_l >> 5;
#pragma unroll
    for (int kb = 0; kb < 4; ++kb)
#pragma unroll
        for (int r = 0; r < 16; ++r) S[kb][r] = src[(size_t)(32 * kb + (r & 3) + 8 * (r >> 2) + 4 * hh) * 256 + 32 * F.wave + l31];
}
__device__ __forceinline__ void gla_state_store(Frame& F, const f32x16 (&S)[4], float* dst) {
    int ln_l = threadIdx.x & 63; asm volatile("" : "+v"(ln_l));
    const int l31 = ln_l & 31, hh = ln_l >> 5;
#pragma unroll
    for (int kb = 0; kb < 4; ++kb)
#pragma unroll
        for (int r = 0; r < 16; ++r) dst[(size_t)(32 * kb + (r & 3) + 8 * (r >> 2) + 4 * hh) * 256 + 32 * F.wave + l31] = S[kb][r];
}
__device__ __forceinline__ void gla_zero(f32x16 (&S)[4]) {
#pragma unroll
    for (int kb = 0; kb < 4; ++kb)
#pragma unroll
        for (int r = 0; r < 16; ++r) S[kb][r] = 0.f;
}
__device__ __forceinline__ void gla_phaseB(Frame& F, int l, int part) {
    const bf16* P = (const bf16*)(F.ws + WS_P); const float* ALOW = (const float*)(F.ws + WS_ALOWP); bf16* AG = (bf16*)(F.ws + WS_AG);
    float* KVS = (float*)(F.ws + WS_KVS); float* LSUM = (float*)(F.ws + WS_LSUM);
    const float* w_a2 = inp(F, 20) + (size_t)l * 16 * 512; const float* b_a = inp(F, 21) + (size_t)l * 512; const float* norm_g = inp(F, 22) + (size_t)l * 1024;
    const int dk = F.tid & 127;
    f32x16 S[4];
    if (part == 0)
    for (int u = F.vcu; u < 256; u += F.G) {
        const int bh = u >> 4, sc = u & 15, b = bh >> 2, h = bh & 3;
        float w2[16];
#pragma unroll
        for (int r = 0; r < 16; ++r) w2[r] = w_a2[r * 512 + h * 128 + dk];
        const float ba = b_a[h * 128 + dk];
        gla_zero(S); float lsum = 0.f;
        for (int ch = 0; ch < 2; ++ch) lsum += gla_chunk<false, 64>(F, S, P, ALOW, AG, (size_t)b * TP + 128 * sc + 64 * ch, h, w2, ba, norm_g);
        gla_state_store(F, S, KVS + ((size_t)bh * 16 + sc) * 32768);
        if (F.tid < 128) LSUM[((size_t)bh * 16 + sc) * 128 + dk] = lsum;
    }
    const float* st_in = inp(F, 6) + (size_t)l * 128 * 4 * 32768; float* st_out = F.out + OUT_GLA_S + (size_t)l * 128 * 4 * 32768;
    if (part == 1)
    for (int u = F.vcu; u < 512; u += F.G) {
        const int bs = u >> 2, h = u & 3;
        float w2[16];
#pragma unroll
        for (int r = 0; r < 16; ++r) w2[r] = w_a2[r * 512 + h * 128 + dk];
        const float ba = b_a[h * 128 + dk];
        gla_state_load(F, S, st_in + (size_t)u * 32768);
        (void)gla_chunk<true, 8>(F, S, P, ALOW, AG, (size_t)MP + 8 * bs, h, w2, ba, norm_g);
        gla_state_store(F, S, st_out + (size_t)u * 32768);
    }
}
__device__ __forceinline__ void gla_phaseD(Frame& F, int l) {
    const bf16* P = (const bf16*)(F.ws + WS_P); const float* ALOW = (const float*)(F.ws + WS_ALOWP); bf16* AG = (bf16*)(F.ws + WS_AG);
    const float* KVS = (const float*)(F.ws + WS_KVS);
    const float* w_a2 = inp(F, 20) + (size_t)l * 16 * 512; const float* b_a = inp(F, 21) + (size_t)l * 512; const float* norm_g = inp(F, 22) + (size_t)l * 1024;
    const int dk = F.tid & 127;
    f32x16 S[4];
    for (int u = F.vcu; u < 256; u += F.G) {
        const int bh = u >> 4, sc = u & 15, b = bh >> 2, h = bh & 3;
        float w2[16];
#pragma unroll
        for (int r = 0; r < 16; ++r) w2[r] = w_a2[r * 512 + h * 128 + dk];
        const float ba = b_a[h * 128 + dk];
        gla_state_load(F, S, KVS + ((size_t)bh * 16 + sc) * 32768);
        for (int ch = 0; ch < 2; ++ch) (void)gla_chunk<true, 64>(F, S, P, ALOW, AG, (size_t)b * TP + 128 * sc + 64 * ch, h, w2, ba, norm_g);
    }
}

__device__ __forceinline__ void scans_phaseC(Frame& F, int l) {
    const size_t gt = (size_t)F.vcu * (NWAVES * 64) + F.tid, NGT = (size_t)F.G * NWAVES * 64;
    { float* KVS = (float*)(F.ws + WS_KVS); const float* LSUM = (const float*)(F.ws + WS_LSUM); float* fin = F.out + OUT_GLA_P + (size_t)l * 16 * 32768;
      for (size_t i = gt; i < (size_t)16 * 128 * 64; i += NGT) { const int bh = (int)(i >> 13), dkk = (int)((i >> 6) & 127), d4 = (int)(i & 63);
          f32x4 kv[16]; float lam[16];
#pragma unroll
          for (int sc = 0; sc < 16; ++sc) { kv[sc] = *(const f32x4*)(KVS + (((size_t)bh * 16 + sc) * 128 + dkk) * 256 + 4 * d4); lam[sc] = __expf(LSUM[((size_t)bh * 16 + sc) * 128 + dkk]); }
          f32x4 s = (f32x4){0.f, 0.f, 0.f, 0.f};
#pragma unroll
          for (int sc = 0; sc < 16; ++sc) { *(f32x4*)(KVS + (((size_t)bh * 16 + sc) * 128 + dkk) * 256 + 4 * d4) = s; s = s * lam[sc] + kv[sc]; }
          *(f32x4*)(fin + ((size_t)bh * 128 + dkk) * 256 + 4 * d4) = s; } }
    { float* SS = (float*)(F.ws + WS_SS); const float* a64 = (const float*)(F.ws + WS_TAB + (size_t)l * TAB_LAYER + TB_A64);
      for (size_t i = gt; i < (size_t)4 * 64 * 64; i += NGT) { const int b = (int)(i >> 12), g = (int)((i >> 6) & 63), p = (int)(i & 63);
          const float ar = a64[2 * (g * 64 + p)], ai = a64[2 * (g * 64 + p) + 1]; float cr = 0.f, ci = 0.f;
          for (int c0 = 0; c0 < 32; c0 += 8) { float sr[8], si[8];
#pragma unroll
              for (int j = 0; j < 8; ++j) { const size_t base = (((size_t)b * 32 + c0 + j) * 64 + g) * 128; sr[j] = SS[base + p]; si[j] = SS[base + 64 + p]; }
#pragma unroll
              for (int j = 0; j < 8; ++j) { const size_t base = (((size_t)b * 32 + c0 + j) * 64 + g) * 128; SS[base + p] = cr; SS[base + 64 + p] = ci;
                  const float nr = ar * cr - ai * ci + sr[j], ni = ar * ci + ai * cr + si[j]; cr = nr; ci = ni; } } } }
}
template <int TT, bool SAMPLE>
__device__ __forceinline__ void conv_unit(Frame& F, int l, int b, int t0) {
    const bf16* P = (const bf16*)(F.ws + WS_P); bf16* AC = (bf16*)(F.ws + WS_AC);
    const float* cw = inp(F, 23) + (size_t)l * 31 * 1024; const float* cb = inp(F, 24) + (size_t)l * 1024; const float* lng = inp(F, 25) + (size_t)l * 1024; const float* lnb = inp(F, 26) + (size_t)l * 1024;
    const float* cache = inp(F, 7) + ((size_t)l * 128 + b) * 30 * 1024;
    int tid_l = threadIdx.x; asm volatile("" : "+v"(tid_l));
    const int c0 = 2 * tid_l; const size_t rowbase = SAMPLE ? (size_t)MP + 8 * b : (size_t)b * TP;
    float w0[31], w1[31];
#pragma unroll
    for (int j = 0; j < 31; ++j) { const float2 wv = *(const float2*)(cw + j * 1024 + c0); w0[j] = wv.x; w1[j] = wv.y; }
    float a0[TT], a1[TT];
    { const float2 bv = *(const float2*)(cb + c0);
#pragma unroll
      for (int t = 0; t < TT; ++t) { a0[t] = bv.x; a1[t] = bv.y; } }
    float* cnew = SAMPLE ? F.out + OUT_CONV_S + ((size_t)l * 128 + b) * 30 * 1024 : F.out + OUT_CONV_P + ((size_t)l * 4 + b) * 30 * 1024;
#pragma unroll
    for (int rp = 0; rp < TT + 30; ++rp) {
        const int t = t0 - 30 + rp;
        float g0 = 0.f, g1 = 0.f;
        if (SAMPLE) {
            if (rp < 30) { const float2 cv = *(const float2*)(cache + (size_t)rp * 1024 + c0); g0 = cv.x; g1 = cv.y; }
            else { const unsigned ca = *(const unsigned*)(P + (rowbase + rp - 30) * LDP + PC_CA + c0), cbv = *(const unsigned*)(P + (rowbase + rp - 30) * LDP + PC_CB + c0); g0 = pg8::bflo(ca) * pg8::bflo(cbv); g1 = pg8::bfhi(ca) * pg8::bfhi(cbv); }
            if (rp >= 8) *(float2*)(cnew + (size_t)(rp - 8) * 1024 + c0) = make_float2(g0, g1);
        } else {
            const int tc = t < 0 ? 0 : t;
            const unsigned ca = *(const unsigned*)(P + (rowbase + tc) * LDP + PC_CA + c0), cbv = *(const unsigned*)(P + (rowbase + tc) * LDP + PC_CB + c0);
            const float v0 = pg8::bflo(ca) * pg8::bflo(cbv), v1 = pg8::bfhi(ca) * pg8::bfhi(cbv); g0 = t < 0 ? 0.f : v0; g1 = t < 0 ? 0.f : v1;
        }
#pragma unroll
        for (int tt = 0; tt < TT; ++tt) { const int j = rp - tt; if (j >= 0 && j <= 30) { a0[tt] += w0[j] * g0; a1[tt] += w1[j] * g1; } }
        if (rp == (TT + 30) / 2 - 1) asm volatile("" ::: "memory");
    }
    if (!SAMPLE && t0 + TT > TP - 30) {
        for (int t = (t0 > TP - 30 ? t0 : TP - 30); t < t0 + TT; ++t) { const unsigned ca = *(const unsigned*)(P + (rowbase + t) * LDP + PC_CA + c0), cbv = *(const unsigned*)(P + (rowbase + t) * LDP + PC_CB + c0);
            *(float2*)(cnew + (size_t)(t - (TP - 30)) * 1024 + c0) = make_float2(pg8::bflo(ca) * pg8::bflo(cbv), pg8::bfhi(ca) * pg8::bfhi(cbv)); } }
    LAS float* Y = (LAS float*)F.lds;
#pragma unroll
    for (int t = 0; t < TT; ++t) *(LAS pg8::f32x2*)(Y + t * 1024 + c0) = (pg8::f32x2){a0[t], a1[t]};
    __syncthreads();
    for (int t = F.wave; t < TT; t += NWAVES) {
        f32x4 x[4]; float s = 0.f;
#pragma unroll
        for (int j = 0; j < 4; ++j) { x[j] = *(const LAS f32x4*)(Y + t * 1024 + 8 * F.lane + 512 * (j >> 1) + 4 * (j & 1)); s += (x[j][0] + x[j][1]) + (x[j][2] + x[j][3]); }
        const float mean = wave_sum(s) * (1.0f / 1024.0f); float qq = 0.f;
#pragma unroll
        for (int j = 0; j < 4; ++j) { x[j] = x[j] - mean; qq += (x[j][0] * x[j][0] + x[j][1] * x[j][1]) + (x[j][2] * x[j][2] + x[j][3] * x[j][3]); }
        const float rstd = 1.0f / sqrtf(wave_sum(qq) * (1.0f / 1024.0f) + LN_EPS);
        const size_t grow = rowbase + t0 + t;
#pragma unroll
        for (int hf = 0; hf < 2; ++hf) { const int cc = 8 * F.lane + 512 * hf;
            const f32x4 g0 = *(const f32x4*)(lng + cc), g1 = *(const f32x4*)(lng + cc + 4), b0 = *(const f32x4*)(lnb + cc), b1 = *(const f32x4*)(lnb + cc + 4);
            f32x4 z0, z1; pg8::unpack8(*(const v4u*)(P + grow * LDP + PC_CZ + cc), z0, z1);
            const f32x4 y0 = pg8::silu4(x[2 * hf] * rstd * g0 + b0) * z0, y1 = pg8::silu4(x[2 * hf + 1] * rstd * g1 + b1) * z1;
            *(v4u*)(AC + grow * 1024 + cc) = pg8::pack8(y0, y1); }
    }
    __syncthreads();
}
__device__ __forceinline__ void conv_phaseC(Frame& F, int l) {
    for (int u = F.vcu; u < MP / 16; u += F.G) conv_unit<16, false>(F, l, u / (TP / 16), 16 * (u % (TP / 16)));
    for (int u = F.vcu; u < 128; u += F.G) conv_unit<8, true>(F, l, u, 0);
}

__device__ __forceinline__ void s5_phaseB(Frame& F, int l) {
    const bf16* P = (const bf16*)(F.ws + WS_P); unsigned char* tb = F.ws + WS_TAB + (size_t)l * TAB_LAYER;
    LAS float* T = (LAS float*)(F.lds + F.wave * 10240);
    float* SS = (float*)(F.ws + WS_SS);
    const int gw = F.vcu * NWAVES + F.wave, NGW = F.G * NWAVES;
    for (int wu = gw; wu < 4 * 32 * 64; wu += NGW) { const int g = wu & 63, c = (wu >> 6) & 31, b = wu >> 11;
        s5_unit<0>(T, F.lane, P, (size_t)b * TP + 64 * c, g, (const float*)(tb + TB_ABAR), (const bf16*)(tb + TB_BBT), (const bf16*)(tb + TB_CMT), nullptr,
                   SS + (((size_t)b * 32 + c) * 64 + g) * 128, nullptr, nullptr, nullptr, nullptr, nullptr); }
}
__device__ __forceinline__ void s5_phaseD(Frame& F, int l) {
    const bf16* P = (const bf16*)(F.ws + WS_P); unsigned char* tb = F.ws + WS_TAB + (size_t)l * TAB_LAYER;
    LAS float* T = (LAS float*)(F.lds + F.wave * 10240);
    float* SS = (float*)(F.ws + WS_SS); bf16* YG = (bf16*)(F.ws + WS_YG); const float* dsk = inp(F, 17) + (size_t)l * 1024;
    const int gw = F.vcu * NWAVES + F.wave, NGW = F.G * NWAVES;
    for (int wu = gw; wu < 4 * 32 * 64; wu += NGW) { const int g = wu & 63, c = (wu >> 6) & 31, b = wu >> 11;
        float* ore = (c == 31) ? F.out + OUT_S5RE_P + (((size_t)l * 4 + b) * 64 + g) * 64 : nullptr; float* oim = (c == 31) ? F.out + OUT_S5IM_P + (((size_t)l * 4 + b) * 64 + g) * 64 : nullptr;
        s5_unit<1>(T, F.lane, P, (size_t)b * TP + 64 * c, g, (const float*)(tb + TB_ABAR), (const bf16*)(tb + TB_BBT), (const bf16*)(tb + TB_CMT), dsk,
                   SS + (((size_t)b * 32 + c) * 64 + g) * 128, nullptr, nullptr, ore, oim, YG); }
    for (int wu = gw; wu < 16 * 64; wu += NGW) { const int g = wu & 63, bg = wu >> 6; const size_t so = (((size_t)l * 128 + 8 * bg) * 64 + g) * 64;
        s5_unit<2>(T, F.lane, P, (size_t)MP + 64 * bg, g, (const float*)(tb + TB_ABAR), (const bf16*)(tb + TB_BBT), (const bf16*)(tb + TB_CMT), dsk,
                   nullptr, inp(F, 4) + so, inp(F, 5) + so, F.out + OUT_S5RE_S + so, F.out + OUT_S5IM_S + so, YG); }
}

__device__ __forceinline__ void ln_phase(Frame& F, int l, int row_lo, int row_hi, int w0, int nw) {
    const bf16* H2 = (const bf16*)(F.ws + WS_H2); float* XO = F.out + OUT_Y; bf16* XB = (bf16*)(F.ws + WS_XB);
    const float* lg = inp(F, 33) + (size_t)l * D; const float* lb = inp(F, 34) + (size_t)l * D;
    const bool last = (l == NLAYER - 1);
#if defined(DIAG_CHECK)
    const float dscale = diag_scale(F);
#endif
    for (int m = row_lo + w0; m < row_hi; m += nw) {
        const pg8::u32x4* xr = (const pg8::u32x4*)(H2 + (size_t)m * D) + F.lane;
        f32x4 v[8]; float s = 0.f;
#pragma unroll
        for (int j = 0; j < 4; ++j) { pg8::unpack8(xr[64 * j], v[2 * j], v[2 * j + 1]); }
#pragma unroll
        for (int j = 0; j < 8; ++j) s += (v[j][0] + v[j][1]) + (v[j][2] + v[j][3]);
        const float mean = wave_sum(s) * (1.f / D); float s2 = 0.f;
#pragma unroll
        for (int j = 0; j < 8; ++j) { v[j] = v[j] - mean; s2 += (v[j][0] * v[j][0] + v[j][1] * v[j][1]) + (v[j][2] * v[j][2] + v[j][3] * v[j][3]); }
        const float rstd = 1.f / sqrtf(wave_sum(s2) * (1.f / D) + LN_EPS);
#pragma unroll
        for (int j = 0; j < 4; ++j) { const int c = 8 * F.lane + 512 * j;
            f32x4 y0 = v[2 * j] * rstd * *(const f32x4*)(lg + c) + *(const f32x4*)(lb + c), y1 = v[2 * j + 1] * rstd * *(const f32x4*)(lg + c + 4) + *(const f32x4*)(lb + c + 4);
            if (last) {
#if defined(DIAG_CHECK)
                y0 = y0 * dscale; y1 = y1 * dscale;
#endif
                *(f32x4*)(XO + (size_t)m * D + c) = y0; *(f32x4*)(XO + (size_t)m * D + c + 4) = y1; }
            else *(pg8::u32x4*)(XB + (size_t)m * D + c) = pg8::pack8(y0, y1); }
    }
}

struct Args { const float* in[35]; float* out; unsigned char* ws; int ph_lo, ph_hi, li, pad; };
__global__ void __launch_bounds__(NWAVES * 64, 2) mega_fwd(Args args) {
    extern __shared__ __attribute__((aligned(16))) unsigned char lds[];
    Frame F;
    F.lds = (LAS unsigned char*)lds;
    F.tid = threadIdx.x; F.lane = F.tid & 63; F.wave = __builtin_amdgcn_readfirstlane(F.tid >> 6);
    F.G = gridDim.x; { const int bx = blockIdx.x; F.vcu = (F.G % 8 == 0) ? (bx % 8) * (F.G / 8) + bx / 8 : bx; }
    F.ws = args.ws; F.out = args.out; F.ctl = (gu32*)(args.ws + WS_CTL);
    for (int u = F.tid; u < (LDS_BYTES - LDSCTL_OFF) / 4; u += NWAVES * 64) ((LAS unsigned*)(F.lds + LDSCTL_OFF))[u] = 0u;
    __syncthreads();
    if (F.tid < 35) ((LAS unsigned long long*)(F.lds + PTAB_OFF))[F.tid] = (unsigned long long)args.in[F.tid];
    __syncthreads();
    XcdBarrier bar = xcd_barrier_post((unsigned*)(F.ctl + CW_BAR) + args.li * XCD_BAR_WORDS, (volatile LAS unsigned*)(F.lds + MISC_OFF) + 8);
    const int lo = args.ph_lo, hi = args.ph_hi;
#define IN(k) (lo <= (k) && (k) < hi)
#ifndef REP_BAR
#define REP_BAR 1
#endif
#define SEAM(k) do { if (IN(k) && IN((k) + 1)) { for (int rb_ = 0; rb_ < REP_BAR; ++rb_) xcd_barrier(bar); } } while (0)

#ifndef PH_EN
#define PH_EN 0xFFFF
#endif
#define EN(b) ((PH_EN >> (b)) & 1)
#ifndef REP_G1
#define REP_G1 1
#endif
#ifndef REP_MB
#define REP_MB 1
#endif
#ifndef REP_CONV
#define REP_CONV 1
#endif
#ifndef REP_MD
#define REP_MD 1
#endif
#ifndef REP_G2
#define REP_G2 1
#endif
#ifndef REP_X
#define REP_X 1
#endif
#ifndef REP_Y
#define REP_Y 1
#endif
#ifndef REP_W6
#define REP_W6 1
#endif
#ifndef REP_W7
#define REP_W7 1
#endif
#ifndef REP_W8
#define REP_W8 1
#endif
#ifndef P0_Y_NUM
#define P0_Y_NUM 1
#undef P0_Y_DEN_X
#define P0_Y_DEN 10
#endif
#define P0_Y_SHARE ((int)(((long)P0_I_LAYER * P0_Y_NUM) / P0_Y_DEN))
#ifndef REP_LN
#define REP_LN 1
#endif
#ifndef REP_P0
#define REP_P0 1
#endif
#define REPEAT(n) _Pragma("unroll 1") for (int rep_ = 0; rep_ < (n); ++rep_)
#define RELAUNDER() do { int t_ = threadIdx.x; asm volatile("" : "+v"(t_)); F.tid = t_; F.lane = t_ & 63; } while (0)
    if (EN(0) && IN(0)) { REPEAT(REP_P0) { p0_prologue(F); __syncthreads(); } }
    SEAM(0);
#pragma unroll 1
    for (int l = 0; l < NLAYER; ++l) {
        const int pb = 1 + NPH_LAYER * l;
        const bf16* wt = (const bf16*)(F.ws + WS_WT + (size_t)l * WT_LAYER);
        bf16* P = (bf16*)(F.ws + WS_P);
        if (EN(1) && IN(pb + 0)) REPEAT(REP_G1) {
            RELAUNDER(); alow_phase(F, l);
            pg8::Gemm g{(const bf16*)(F.ws + WS_XB), wt + WO_WIN, M, LDP, D}; pg8::StaticOrder S; S.init(M, LDP, F.G, (int)blockIdx.x);
            pg8::EpiProj E{P, LDP, inp(F, 9) + (size_t)l * NIN_SRC};
            pg8::gemm_phase<pg8::EpiProj, pg8::StaticOrder, true, true>(F.lds, g, S, E);
        }
        SEAM(pb + 0);
        if (IN(pb + 1)) { RELAUNDER();
#if defined(DIAG_CHECK)
            if (l == 0) diag_gemm1(F);
#endif
            REPEAT(REP_MB) { const int first2 = ((int)blockIdx.x >> 3) & 1;
                _Pragma("unroll 1") for (int st = 0; st < 3; ++st) { RELAUNDER(); const int task = first2 ? (st == 0 ? 2 : st - 1) : st;
                    if (task == 0) { if (EN(2)) s5_phaseB(F, l); } else if (EN(3)) gla_phaseB(F, l, task - 1);
                    __syncthreads(); } } }
        SEAM(pb + 1);
        if (IN(pb + 2)) { const int conv_first = ((int)blockIdx.x >> 3) & 1;
            _Pragma("unroll 1") for (int st = 0; st < 2; ++st) { RELAUNDER();
                if ((st ^ conv_first) == 0) { if (EN(4)) scans_phaseC(F, l); } else REPEAT(REP_CONV) { if (EN(5)) conv_phaseC(F, l); } } }
        SEAM(pb + 2);
        if (IN(pb + 3)) REPEAT(REP_MD) { RELAUNDER(); if (EN(6)) s5_phaseD(F, l);
#if defined(DIAG_CHECK)
            diag_s5s(F, l);
#endif
            __syncthreads(); RELAUNDER(); if (EN(7)) gla_phaseD(F, l); __syncthreads(); }
        SEAM(pb + 3);
        if (EN(8) && IN(pb + 4)) REPEAT(REP_X) {
            const int bx = (int)blockIdx.x;
            { pg8::Gemm g{(const bf16*)(F.ws + WS_YG), wt + WO_WGLU, M, 1024, 1024}; pg8::PickSched S; S.init(M, 1024, bx, 0, 0, bx < 144 ? 1 : 0);
              pg8::EpiGlu E{(bf16*)(F.ws + WS_AS), inp(F, 19) + (size_t)l * 1024, (const bf16*)(F.ws + WS_YG), P, LDP};
              pg8::gemm_phase<pg8::EpiGlu, pg8::PickSched, true, true>(F.lds, g, S, E); }
            { int kpe = 256; asm volatile("" : "+s"(kpe));
              pg8::Gemm g{(const bf16*)(F.ws + WS_PB) + (size_t)l * M * 256, wt + WO_WPE, M, D, kpe}; pg8::PickSched S; S.init(M, D, bx, bx + 16, bx + 32, bx >= 240 ? 3 : 1);
              pg8::EpiPlain E{(bf16*)(F.ws + WS_PE), D};
              pg8::gemm_phase<pg8::EpiPlain, pg8::PickSched, true, true>(F.lds, g, S, E); }
            { pg8::Gemm g{(const bf16*)(F.ws + WS_AG), wt + WO_PGLA, M, D, 1024}; pg8::PickSched S;
              if (bx < 144) S.init(M, D, bx + 112, 0, 0, 1); else if (bx < 176) S.init(M, D, bx - 144, bx + 112, 0, 2); else S.init(M, D, bx - 144, 0, 0, 1);
              pg8::EpiBranchPart<1> E{(bf16*)(F.ws + WS_OG), P, LDP};
              pg8::gemm_phase<pg8::EpiBranchPart<1>, pg8::PickSched, true, true>(F.lds, g, S, E); }
            { pg8::Gemm g{(const bf16*)(F.ws + WS_AC), wt + WO_PCONV, M, D, 1024}; pg8::PickSched S; const int e = bx - 176;
              S.init(M, D, e < 32 ? e : 224 + e, 0, 0, (bx >= 176 && bx < 240) ? 1 : 0);
              pg8::EpiBranchPart<2> E{(bf16*)(F.ws + WS_OC), P, LDP};
              pg8::gemm_phase<pg8::EpiBranchPart<2>, pg8::PickSched, true, true>(F.lds, g, S, E); }
        }
        SEAM(pb + 4);
        if (EN(9) && IN(pb + 5)) REPEAT(REP_Y) {
            const int bx = (int)blockIdx.x;
            if (bx >= 32) { pg8::Gemm g{(const bf16*)(F.ws + WS_AC), wt + WO_PCONV, M, D, 1024}; pg8::PickSched S; S.init(M, D, bx, 0, 0, 1);
              pg8::EpiBranchPart<2> E{(bf16*)(F.ws + WS_OC), P, LDP};
              pg8::gemm_phase<pg8::EpiBranchPart<2>, pg8::PickSched, true, true>(F.lds, g, S, E); }
            { pg8::Gemm g{(const bf16*)(F.ws + WS_AS), wt + WO_PS5, M, D, 1024}; pg8::PickSched S; S.init(M, D, bx, bx + 256, 0, bx < 32 ? 2 : 1);
              pg8::EpiBranchFinal E{(bf16*)(F.ws + WS_OSB), (const bf16*)(F.ws + WS_OG), (const bf16*)(F.ws + WS_OC), P, LDP};
              pg8::gemm_phase<pg8::EpiBranchFinal, pg8::PickSched, true, true>(F.lds, g, S, E); }
            if (l + 1 < NLAYER && P0_Y_SHARE > 0) { RELAUNDER(); p0_convert(F, l + 1, 0, P0_Y_SHARE, F.vcu * NWAVES + F.wave, F.G * NWAVES); }
            if (REP_Y > 1) __syncthreads();
        }
        SEAM(pb + 5);
        const int bxw = (int)blockIdx.x;
        if (EN(10) && IN(pb + 6)) REPEAT(REP_W6) {
            pg8::Gemm g{(const bf16*)(F.ws + WS_OSB), wt + WO_WO, M, D, D}; pg8::OneTile S; if (bxw >= 32) S.init_e(D, F.G, bxw); else S.init_late(bxw);
            pg8::EpiWo E{(bf16*)(F.ws + WS_HB), (const bf16*)(F.ws + WS_XB), DN_ALPHA};
            pg8::gemm_phase<pg8::EpiWo, pg8::OneTile, true, true>(F.lds, g, S, E);
        }
        SEAM(pb + 6);
        if (EN(11) && IN(pb + 7)) REPEAT(REP_W7) {
            if (bxw >= 32) {
                pg8::Gemm g{(const bf16*)(F.ws + WS_HB), wt + WO_WPG, M, D, D}; pg8::OneTile S; S.init_e(D, F.G, bxw);
                pg8::EpiWpg E{(bf16*)(F.ws + WS_H2), (const bf16*)(F.ws + WS_HB), (const bf16*)(F.ws + WS_PE)};
                pg8::gemm_phase<pg8::EpiWpg, pg8::OneTile, true, true>(F.lds, g, S, E);
            } else {
                pg8::Gemm g{(const bf16*)(F.ws + WS_OSB), wt + WO_WO, M, D, D}; pg8::OneTile S; S.init_late(32 + bxw);
                pg8::EpiWo E{(bf16*)(F.ws + WS_HB), (const bf16*)(F.ws + WS_XB), DN_ALPHA};
                pg8::gemm_phase<pg8::EpiWo, pg8::OneTile, true, true>(F.lds, g, S, E);
            }
        }
        SEAM(pb + 7);
        if (IN(pb + 8)) REPEAT((REP_W8 == 3) ? (bxw >= 64 ? 2 : 1) : (REP_W8 == 4) ? (bxw < 64 ? 2 : 1) : REP_W8) {
            if (bxw < 64) {
                if (EN(11)) { pg8::Gemm g{(const bf16*)(F.ws + WS_HB), wt + WO_WPG, M, D, D}; pg8::OneTile S; S.init_late(bxw);
                    pg8::EpiWpg E{(bf16*)(F.ws + WS_H2), (const bf16*)(F.ws + WS_HB), (const bf16*)(F.ws + WS_PE)};
                    pg8::gemm_phase<pg8::EpiWpg, pg8::OneTile, true, true>(F.lds, g, S, E); }
            } else {
                if (EN(12)) { RELAUNDER(); ln_phase(F, l, 0, 28 * 256, (bxw - 64) * NWAVES + F.wave, (F.G - 64) * NWAVES); }
                if (l + 1 < NLAYER) { RELAUNDER(); p0_convert(F, l + 1, P0_Y_SHARE, P0_I_LAYER, (bxw - 64) * NWAVES + F.wave, (F.G - 64) * NWAVES); }
            }
            if (REP_W8 > 1) __syncthreads();
        }
        SEAM(pb + 8);
        if (EN(12) && IN(pb + 9)) { RELAUNDER(); ln_phase(F, l, 28 * 256, M, F.vcu * NWAVES + F.wave, F.G * NWAVES); }
        SEAM(pb + 9);
    }
#undef IN
#undef SEAM
}

#ifndef MK_SPLIT
#define MK_SPLIT 1
#endif
extern "C" void kernel_launch(void* const* d_in, const int* in_sizes, int n_in, void* d_out, int out_size, void* d_ws, size_t ws_size, hipStream_t stream) {
    static int grid = 0;
    if (grid == 0) {
        if (n_in != 35 || (size_t)out_size != OUT_TOTAL || ws_size < WS_END) { fprintf(stderr, "kernel_launch: unexpected shapes: n_in %d out %d ws %zu (need %zu)\n", n_in, out_size, ws_size, (size_t)WS_END); grid = -1; return; }
        int dev = 0, cus = 0, per_cu = 0;
        if (hipGetDevice(&dev) != hipSuccess || hipDeviceGetAttribute(&cus, hipDeviceAttributeMultiprocessorCount, dev) != hipSuccess) { grid = -1; return; }
        if (hipFuncSetAttribute((const void*)mega_fwd, hipFuncAttributeMaxDynamicSharedMemorySize, LDS_BYTES) != hipSuccess) { fprintf(stderr, "kernel_launch: hipFuncSetAttribute failed\n"); grid = -1; return; }
        if (hipOccupancyMaxActiveBlocksPerMultiprocessor(&per_cu, (const void*)mega_fwd, NWAVES * 64, LDS_BYTES) != hipSuccess || per_cu < 1) fprintf(stderr, "kernel_launch: occupancy query reports %d\n", per_cu);
        (void)hipGetLastError();
        if (cus != 256) { fprintf(stderr, "kernel_launch: built for a 256-CU device (one workgroup per CU; the w_o / w_pg schedule deals 224 + 64 tiles to exactly 256 workgroups); this device has %d CUs: nothing launched\n", cus); grid = -1; return; }
        grid = cus;
    }
    if (grid < 0) return;
    (void)hipMemsetAsync((char*)d_ws + WS_CTL, 0, CTL_ZERO_BYTES, stream);
    Args a; memset(&a, 0, sizeof(a));
    for (int i = 0; i < 35; ++i) a.in[i] = (const float*)d_in[i];
    a.out = (float*)d_out; a.ws = (unsigned char*)d_ws;
#if MK_SPLIT
    for (int ph = 0; ph < NPHASE; ++ph) { a.ph_lo = ph; a.ph_hi = ph + 1; a.li = 0; hipLaunchKernelGGL(mega_fwd, dim3(grid), dim3(NWAVES * 64), LDS_BYTES, stream, a); }
#else
    a.ph_lo = 0; a.ph_hi = NPHASE; a.li = 0;
    hipLaunchKernelGGL(mega_fwd, dim3(grid), dim3(NWAVES * 64), LDS_BYTES, stream, a);
#endif
}
```
